# Optimizing an MI355X kernel written in HIP

```python
import math
import jax, jax.numpy as jnp
from jax import lax
import numpy as np

D_MODEL = 1024
BATCH = 8
SEQ = 4096
DEPTH = 2

HYENA_WIDTH = D_MODEL // 2
HYENA_ORDER = 2
SHORT_CONV = 3
FILTER_EMB = 33
FILTER_HIDDEN = 64
HYENA_TARGET = 1e-2
FAST_DECAY_PCT = 0.3
SLOW_DECAY_PCT = 1.5
N_DIFF_HEADS = 4
DIFF_HEAD_DIM = 64
DIFF_V_DIM = 2 * DIFF_HEAD_DIM
QK_WIDTH = N_DIFF_HEADS * 2 * DIFF_HEAD_DIM
ATTN_WIDTH = N_DIFF_HEADS * DIFF_V_DIM
ROPE_THETA = 10000.0
Q_BLOCK = 128
N_BRANCHES = 2
IN_WIDTH = 3 * HYENA_WIDTH + 2 * QK_WIDTH + ATTN_WIDTH + N_BRANCHES * D_MODEL
D_FF = 2752
N_EXPERTS = 8
TOP_K = 2
MOE_BLOCK = 128
N_DENSE = (DEPTH + 1) // 2
N_MOE = DEPTH // 2
RMS_EPS = 1e-6

kernel_name = "hybrid_hyena_diffattn_moe_encoder"

F32 = jnp.float32


def rms_norm(x, g):
    xf = x.astype(F32)
    y = xf * lax.rsqrt(jnp.mean(xf * xf, axis=-1, keepdims=True) + RMS_EPS)
    return (y * g.astype(F32)).astype(x.dtype)


def rope_tables(L, dim):
    inv = 1.0 / (ROPE_THETA ** (jnp.arange(0, dim, 2, dtype=F32) / dim))
    ang = jnp.arange(L, dtype=F32)[:, None] * inv[None, :]
    return jnp.cos(ang), jnp.sin(ang)


def apply_rope(x, cos, sin):
    xf = x.astype(F32)
    x1, x2 = jnp.split(xf, 2, axis=-1)
    c = cos[None, :, None, None, :]
    s = sin[None, :, None, None, :]
    return jnp.concatenate([x1 * c - x2 * s, x1 * s + x2 * c], axis=-1).astype(x.dtype)


def centred_short_conv(u, w):
    L = u.shape[1]
    pad = SHORT_CONV // 2
    up = jnp.pad(u, ((0, 0), (pad, SHORT_CONV - 1 - pad), (0, 0)))
    out = up[:, 0:L] * w[0]
    for i in range(1, SHORT_CONV):
        out = out + up[:, i:i + L] * w[i]
    return out


def hyena_filters(L, w_f1, b_f1, freq1, w_f2, b_f2, freq2, w_f3):
    bands = (FILTER_EMB - 1) // 2
    t = jnp.linspace(0.0, 1.0, L, dtype=F32)[:, None]
    w = 2.0 * math.pi * jnp.arange(L, dtype=F32)[:, None] / L
    f = jnp.linspace(1e-4, bands - 1, bands, dtype=F32)[None, :]
    z = jnp.concatenate([t, jnp.cos(f * w), -jnp.sin(f * w)], axis=-1)
    hdn = jnp.sin(freq1.astype(F32) * (z @ w_f1.astype(F32) + b_f1.astype(F32)))
    hdn = jnp.sin(freq2.astype(F32) * (hdn @ w_f2.astype(F32) + b_f2.astype(F32)))
    hf = hdn @ w_f3.astype(F32)
    max_decay = math.log(HYENA_TARGET) / FAST_DECAY_PCT
    min_decay = math.log(HYENA_TARGET) / SLOW_DECAY_PCT
    deltas = jnp.linspace(min_decay, max_decay, HYENA_WIDTH, dtype=F32)
    decay = jnp.exp(-t * jnp.abs(deltas)[None, :])
    hf = hf.reshape(L, HYENA_ORDER, 2, HYENA_WIDTH) * decay[:, None, None, :]
    fwd = hf[:, :, 0]
    bwd = hf[:, :, 1]
    kern = jnp.concatenate([fwd, jnp.zeros_like(fwd[:1]), bwd[1:][::-1]], axis=0)
    return jnp.fft.rfft(kern, axis=0)


def bidir_long_conv(z, kf, bias):
    L = z.shape[1]
    zf32 = z.astype(F32)
    zf = jnp.fft.rfft(zf32, n=2 * L, axis=1)
    y = jnp.fft.irfft(zf * kf[None], n=2 * L, axis=1)[:, :L]
    return (y + zf32 * bias.astype(F32)).astype(z.dtype)


def hyena_mixer(u, conv_w, filt, hy_bias):
    u = centred_short_conv(u, conv_w)
    x1, x2, v = jnp.split(u, 3, axis=-1)
    z = x1 * bidir_long_conv(v, filt[:, 0], hy_bias[0])
    return x2 * bidir_long_conv(z, filt[:, 1], hy_bias[1])


def diff_attention(q, k, v, lam, lambda_init, subln_g):
    B, L = q.shape[0], q.shape[1]
    nb = L // Q_BLOCK
    qb = q.reshape(B, nb, Q_BLOCK, N_DIFF_HEADS, 2, DIFF_HEAD_DIM).transpose(1, 0, 2, 3, 4, 5)
    scale = DIFF_HEAD_DIM ** -0.5

    def block(qblk):
        s = jnp.einsum('bqhcd,bkhcd->bhcqk', qblk, k, preferred_element_type=F32) * scale
        p = jax.nn.softmax(s, axis=-1)
        a = p[:, :, 0] - lam * p[:, :, 1]
        return jnp.einsum('bhqk,bkhe->bqhe', a.astype(v.dtype), v)

    o = lax.map(block, qb)
    o = o.transpose(1, 0, 2, 3, 4).reshape(B, L, N_DIFF_HEADS, DIFF_V_DIM)
    o = rms_norm(o, subln_g) * (1.0 - lambda_init)
    return o.reshape(B, L, ATTN_WIDTH)


def hybrid_mixer(x, norm_g, w_in, conv_w, w_f1, b_f1, freq1, w_f2, b_f2, freq2, w_f3, hy_bias,
                 q_norm, k_norm, lam_q1, lam_k1, lam_q2, lam_k2, subln_g, w_hy_o, w_at_o, w_out,
                 lambda_init, cos, sin):
    B, L, _ = x.shape
    h = rms_norm(x, norm_g)
    proj = h @ w_in
    s1 = 3 * HYENA_WIDTH
    s2 = s1 + QK_WIDTH
    s3 = s2 + QK_WIDTH
    s4 = s3 + ATTN_WIDTH
    hy_in = proj[..., :s1]
    q = proj[..., s1:s2].reshape(B, L, N_DIFF_HEADS, 2, DIFF_HEAD_DIM)
    k = proj[..., s2:s3].reshape(B, L, N_DIFF_HEADS, 2, DIFF_HEAD_DIM)
    v = proj[..., s3:s4].reshape(B, L, N_DIFF_HEADS, DIFF_V_DIM)
    gates = jax.nn.sigmoid(proj[..., s4:].astype(F32)).reshape(B, L, N_BRANCHES, D_MODEL)
    filt = hyena_filters(L, w_f1, b_f1, freq1, w_f2, b_f2, freq2, w_f3)
    y_h = hyena_mixer(hy_in, conv_w, filt, hy_bias)
    q = apply_rope(rms_norm(q, q_norm), cos, sin)
    k = apply_rope(rms_norm(k, k_norm), cos, sin)
    lam = (jnp.exp(jnp.sum(lam_q1.astype(F32) * lam_k1.astype(F32)))
           - jnp.exp(jnp.sum(lam_q2.astype(F32) * lam_k2.astype(F32))) + lambda_init)
    y_a = diff_attention(q, k, v, lam, lambda_init, subln_g)
    merged = (gates[..., 0, :] * (y_h @ w_hy_o).astype(F32)
              + gates[..., 1, :] * (y_a @ w_at_o).astype(F32))
    return merged.astype(x.dtype) @ w_out


def swiglu(x, w_gate, w_up, w_down):
    return (jax.nn.silu(x @ w_gate) * (x @ w_up)) @ w_down


def moe_ffn(x, w_router, w_gate, w_up, w_down):
    B, L, D = x.shape
    T = B * L
    xt = x.reshape(T, D)
    logits = (xt @ w_router).astype(F32)
    top_val, top_idx = lax.top_k(logits, TOP_K)
    top_w = jax.nn.softmax(top_val, axis=-1)
    A = T * TOP_K
    e_flat = top_idx.reshape(A).astype(jnp.int32)
    tok = jnp.arange(A, dtype=jnp.int32) // TOP_K
    order = jnp.argsort(e_flat)
    e_s = e_flat[order]
    tok_s = tok[order]
    w_s = top_w.reshape(A)[order]
    counts = jnp.bincount(e_flat, length=N_EXPERTS).astype(jnp.int32)
    starts = jnp.cumsum(counts) - counts
    padded = (counts + MOE_BLOCK - 1) // MOE_BLOCK * MOE_BLOCK
    pad_end = jnp.cumsum(padded)
    pad_start = pad_end - padded
    dest = pad_start[e_s] + (jnp.arange(A, dtype=jnp.int32) - starts[e_s])
    n_blocks = -(-A // MOE_BLOCK) + N_EXPERTS
    P = n_blocks * MOE_BLOCK
    xp = jnp.zeros((P, D), x.dtype).at[dest].set(xt[tok_s])
    block_start = jnp.arange(n_blocks, dtype=jnp.int32) * MOE_BLOCK
    block_e = jnp.minimum(jnp.searchsorted(pad_end, block_start, side='right'), N_EXPERTS - 1)

    def run(args):
        xb, e = args
        return swiglu(xb, w_gate[e], w_up[e], w_down[e])

    yp = lax.map(run, (xp.reshape(n_blocks, MOE_BLOCK, D), block_e)).reshape(P, D)
    contrib = yp[dest] * w_s[:, None].astype(x.dtype)
    out = jnp.zeros((T, D), x.dtype).at[tok_s].add(contrib)
    return out.reshape(B, L, D)


def setup_inputs(seed: int = 0) -> dict:
    key = jax.random.key(seed)
    ks = jax.random.split(key, 32)
    n = lambda k, shape, s: jax.random.normal(k, shape, F32) * s
    gain = lambda k, shape: 1.0 + 0.02 * jax.random.normal(k, shape, F32)
    HW = HYENA_WIDTH
    return {
        'x': jax.random.normal(ks[0], (BATCH, SEQ, D_MODEL), F32),
        'norm_mix': gain(ks[1], (DEPTH, D_MODEL)),
        'w_in': n(ks[2], (DEPTH, D_MODEL, IN_WIDTH), D_MODEL ** -0.5),
        'conv_w': n(ks[3], (DEPTH, SHORT_CONV, 3 * HW), SHORT_CONV ** -0.5),
        'w_f1': n(ks[4], (DEPTH, FILTER_EMB, FILTER_HIDDEN), FILTER_EMB ** -0.5),
        'b_f1': n(ks[5], (DEPTH, FILTER_HIDDEN), 0.1),
        'freq1': gain(ks[6], (DEPTH, FILTER_HIDDEN)),
        'w_f2': n(ks[7], (DEPTH, FILTER_HIDDEN, FILTER_HIDDEN), FILTER_HIDDEN ** -0.5),
        'b_f2': n(ks[8], (DEPTH, FILTER_HIDDEN), 0.1),
        'freq2': gain(ks[9], (DEPTH, FILTER_HIDDEN)),
        'w_f3': n(ks[10], (DEPTH, FILTER_HIDDEN, HYENA_ORDER * 2 * HW), (FILTER_HIDDEN * SEQ / 8.0) ** -0.5),
        'hy_bias': n(ks[11], (DEPTH, HYENA_ORDER, HW), 0.3),
        'q_norm': gain(ks[12], (DEPTH, DIFF_HEAD_DIM)),
        'k_norm': gain(ks[13], (DEPTH, DIFF_HEAD_DIM)),
        'lam_q1': n(ks[14], (DEPTH, DIFF_HEAD_DIM), 0.1),
        'lam_k1': n(ks[15], (DEPTH, DIFF_HEAD_DIM), 0.1),
        'lam_q2': n(ks[16], (DEPTH, DIFF_HEAD_DIM), 0.1),
        'lam_k2': n(ks[17], (DEPTH, DIFF_HEAD_DIM), 0.1),
        'subln_g': gain(ks[18], (DEPTH, DIFF_V_DIM)),
        'w_hy_o': n(ks[19], (DEPTH, HW, D_MODEL), HW ** -0.5),
        'w_at_o': n(ks[20], (DEPTH, ATTN_WIDTH, D_MODEL), ATTN_WIDTH ** -0.5),
        'w_out': n(ks[21], (DEPTH, D_MODEL, D_MODEL), D_MODEL ** -0.5),
        'norm_ffn': gain(ks[22], (DEPTH, D_MODEL)),
        'w_dense_gate': n(ks[23], (N_DENSE, D_MODEL, D_FF), D_MODEL ** -0.5),
        'w_dense_up': n(ks[24], (N_DENSE, D_MODEL, D_FF), D_MODEL ** -0.5),
        'w_dense_down': n(ks[25], (N_DENSE, D_FF, D_MODEL), D_FF ** -0.5),
        'w_router': n(ks[26], (N_MOE, D_MODEL, N_EXPERTS), D_MODEL ** -0.5),
        'w_moe_gate': n(ks[27], (N_MOE, N_EXPERTS, D_MODEL, D_FF), D_MODEL ** -0.5),
        'w_moe_up': n(ks[28], (N_MOE, N_EXPERTS, D_MODEL, D_FF), D_MODEL ** -0.5),
        'w_moe_down': n(ks[29], (N_MOE, N_EXPERTS, D_FF, D_MODEL), D_FF ** -0.5),
    }


def reference(x, norm_mix, w_in, conv_w, w_f1, b_f1, freq1, w_f2, b_f2, freq2, w_f3, hy_bias,
              q_norm, k_norm, lam_q1, lam_k1, lam_q2, lam_k2, subln_g, w_hy_o, w_at_o, w_out,
              norm_ffn, w_dense_gate, w_dense_up, w_dense_down, w_router, w_moe_gate, w_moe_up,
              w_moe_down):
    L = x.shape[1]
    cos, sin = rope_tables(L, DIFF_HEAD_DIM)
    for layer in range(DEPTH):
        lambda_init = 0.8 - 0.6 * math.exp(-0.3 * layer)
        x = x + hybrid_mixer(
            x, norm_mix[layer], w_in[layer], conv_w[layer], w_f1[layer], b_f1[layer], freq1[layer],
            w_f2[layer], b_f2[layer], freq2[layer], w_f3[layer], hy_bias[layer], q_norm[layer],
            k_norm[layer], lam_q1[layer], lam_k1[layer], lam_q2[layer], lam_k2[layer], subln_g[layer],
            w_hy_o[layer], w_at_o[layer], w_out[layer], lambda_init, cos, sin)
        h = rms_norm(x, norm_ffn[layer])
        i = layer // 2
        if layer % 2 == 0:
            x = x + swiglu(h, w_dense_gate[i], w_dense_up[i], w_dense_down[i])
        else:
            x = x + moe_ffn(h, w_router[i], w_moe_gate[i], w_moe_up[i], w_moe_down[i])
    return x
```

```cpp
#include <hip/hip_runtime.h>
#include <cstdio>
#include <cstdint>

#define GAS __attribute__((address_space(1)))
#define LAS __attribute__((address_space(3)))
typedef unsigned short bf16_t;
typedef unsigned char uchar;
typedef short bf16x8 __attribute__((ext_vector_type(8)));
typedef short bf16x4 __attribute__((ext_vector_type(4)));
typedef float f32x2 __attribute__((ext_vector_type(2)));
typedef float f32x4 __attribute__((ext_vector_type(4)));
typedef float f32x16 __attribute__((ext_vector_type(16)));
typedef unsigned u32x4 __attribute__((ext_vector_type(4)));
typedef unsigned u32x2 __attribute__((ext_vector_type(2)));

#if defined(__HIP_DEVICE_COMPILE__)
#define ASSUME_GLOBAL(p) __builtin_assume(!__builtin_amdgcn_is_shared((const __attribute__((address_space(0))) void*)(p)) && !__builtin_amdgcn_is_private((const __attribute__((address_space(0))) void*)(p)))
#else
#define ASSUME_GLOBAL(p) ((void)0)
#endif
#ifndef DBG_CHECKS
#define DBG_CHECKS 0
#endif

constexpr int NB = 8, SEQ = 4096, DM = 1024, NTOK = NB * SEQ;
constexpr int HW = 512, INW = 5120, NHEAD = 4, HD = 64, DV = 128;
constexpr int DFF = 2752, FFP = 2816, NEXP = 8;
constexpr int FEMB = 33, FHID = 64;
constexpr int XR_LD = 2048;
constexpr int NPANEL_MAX = 264, PSLOTS = NPANEL_MAX * 256;
constexpr float RMS_EPS = 1e-6f;
constexpr int NWAVES = 8, NTHR = 512;
constexpr int FIMG_LEN = 8200, FIMG_BYTES = 4 * FIMG_LEN * 2;
constexpr int GIMG_LEN = 8320;

constexpr size_t MiB = 1u << 20, KiB = 1u << 10;
constexpr size_t WS_CTL = 0, CTL_ZERO_BYTES = 256 * KiB;
constexpr size_t WS_COUNTS = 512 * KiB;
constexpr size_t WS_ROPE = 1 * MiB;
constexpr size_t WS_HDN = 2 * MiB;
constexpr size_t WS_TOPI = 4 * MiB, WS_TOPW = WS_TOPI + 256 * KiB, WS_SLOT = WS_TOPW + 256 * KiB, WS_TOKOF = WS_SLOT + 256 * KiB;
constexpr size_t WS_WSMALL = 6 * MiB, WSMALL_STRIDE = 14 * MiB;
constexpr size_t OFF_WTOK = 0, OFF_WCH = 6 * MiB, OFF_PH = 10 * MiB, OFF_PA = 11 * MiB, OFF_WOUT = 12 * MiB;
constexpr size_t WS_WGU = 34 * MiB, WS_WD = 45 * MiB;
constexpr size_t WS_H = 51 * MiB;
constexpr size_t WS_YCAT = 51 * MiB, WS_YT = 452 * MiB;
constexpr size_t WS_QK = 115 * MiB;
constexpr size_t WS_GATES = 179 * MiB;
constexpr size_t WS_CHT = 307 * MiB;
constexpr size_t WS_MERGED = 307 * MiB;
constexpr size_t WS_FIMG = 435 * MiB;
constexpr size_t WS_ACT_DENSE = 115 * MiB;
constexpr size_t WS_MOE_WGU = 51 * MiB, WS_MOE_WD = 139 * MiB;
constexpr size_t WS_XP = 183 * MiB;
constexpr size_t WS_ACT_MOE = 315 * MiB;
constexpr size_t WS_H2_MOE = 251 * MiB;
constexpr size_t WS_SH = 5 * MiB + 512 * KiB;
constexpr size_t WS_SW = 5 * MiB + 640 * KiB;
constexpr size_t WS_I8W = 484 * MiB;
constexpr int SW_LAYER = 5120, SW_DENSE = 2 * SW_LAYER;
constexpr int P8 = 1152;
constexpr size_t I8W_LAYER = 6 * MiB, I8W_CH = 3 * MiB + 512 * KiB, I8W_DENSE = 2 * I8W_LAYER;
static_assert((size_t)3072 * P8 <= I8W_CH && I8W_CH + (size_t)2048 * P8 <= I8W_LAYER && WS_I8W + I8W_DENSE + (size_t)5632 * P8 <= 512 * MiB && WS_SW + (size_t)(SW_DENSE + 5632) * 4 <= 6 * MiB, "int8 weights / scales");
constexpr size_t WS_NEED = 512 * MiB;
static_assert(WS_FIMG + (size_t)2 * 512 * GIMG_LEN * 2 <= 512 * MiB, "fimg");
static_assert(WS_ACT_MOE + (size_t)136 * 256 * FFP * 2 <= 512 * MiB, "act moe");
static_assert(WS_MOE_WD + (size_t)8 * 1024 * FFP * 2 <= WS_XP, "moe wd");

constexpr int CW_DBG = 64;
constexpr int CW_BAR = 4096;

constexpr int LDS_BYTES = 163840;
constexpr int LDS_MISC = 160 * 1024 - 256;

__device__ __forceinline__ unsigned f2bf(float f) { unsigned u = __builtin_bit_cast(unsigned, f); return (u + 0x7fffu + ((u >> 16) & 1u)) >> 16; }
typedef __bf16 bf16x2v __attribute__((ext_vector_type(2)));
__device__ __forceinline__ unsigned pk2(float lo, float hi) { const f32x2 v = {lo, hi}; return __builtin_bit_cast(unsigned, __builtin_convertvector(v, bf16x2v)); }
__device__ __forceinline__ float bf2f(unsigned short b) { return __builtin_bit_cast(float, ((unsigned)b) << 16); }
__device__ __forceinline__ float bflo(unsigned w) { return __builtin_bit_cast(float, w << 16); }
__device__ __forceinline__ float bfhi(unsigned w) { return __builtin_bit_cast(float, w & 0xffff0000u); }
template <int M> __device__ __forceinline__ float xor_swz(float v) { return __builtin_bit_cast(float, __builtin_amdgcn_ds_swizzle(__builtin_bit_cast(int, v), (M << 10) | 0x1f)); }
__device__ __forceinline__ float xor32(float v) { const unsigned u = __builtin_bit_cast(unsigned, v);
    const auto r = __builtin_amdgcn_permlane32_swap(u, u, false, false);
    return __builtin_bit_cast(float, r[0] ^ r[1] ^ u); }
__device__ __forceinline__ float wave_sum(float v) {
    v += xor_swz<1>(v); v += xor_swz<2>(v); v += xor_swz<4>(v); v += xor_swz<8>(v); v += xor_swz<16>(v); v += xor32(v);
    return v;
}
__device__ __forceinline__ float fast_sin(float x) { return __builtin_amdgcn_sinf(x * 0.15915494309f); }
__device__ __forceinline__ float sin_rev(float r) { return __builtin_amdgcn_sinf(__builtin_amdgcn_fractf(r)); }
__device__ __forceinline__ float cos_rev(float r) { return __builtin_amdgcn_cosf(__builtin_amdgcn_fractf(r)); }
__device__ __forceinline__ float fast_exp(float x) { return __builtin_amdgcn_exp2f(x * 1.44269504089f); }
__device__ __forceinline__ float fast_sigmoid(float x) { return __builtin_amdgcn_rcpf(1.0f + __builtin_amdgcn_exp2f(-1.44269504089f * x)); }
#ifndef FP8_MOE
#define FP8_MOE 1
#endif
#ifndef FP8_DENSE
#define FP8_DENSE 0
#endif
typedef int i32x4 __attribute__((ext_vector_type(4)));
typedef int i32x8 __attribute__((ext_vector_type(8)));
constexpr float F8_SH = 16.0f, F8_SWGU = 64.0f, F8_SACT = 8.0f, F8_SWD = 128.0f;
constexpr float F8_UP_INV = 1.0f / (F8_SH * F8_SWGU), F8_DN_INV = 1.0f / (F8_SACT * F8_SWD);
__device__ __forceinline__ unsigned pk4_f8(float a, float b, float c, float d) { const int w = __builtin_amdgcn_cvt_pk_fp8_f32(a, b, 0, false); return (unsigned)__builtin_amdgcn_cvt_pk_fp8_f32(c, d, w, true); }
__device__ __forceinline__ float clamp_f8(float x) { return __builtin_amdgcn_fmed3f(x, -448.0f, 448.0f); }
__device__ __forceinline__ void mfma_f8(f32x4& c, const i32x8 a, const i32x8 b) { asm volatile("v_mfma_f32_16x16x128_f8f6f4 %0, %1, %2, %0" : "+v"(c) : "v"(a), "v"(b)); }
#define F8_ACC_SETTLE() asm volatile("s_nop 15\n\ts_nop 15" ::: "memory")
#ifndef I8_INPROJ
#define I8_INPROJ 1
#endif
#ifndef I8_DENSE_UP
#define I8_DENSE_UP 1
#endif
__device__ __forceinline__ float wave_max(float v) {
    v = fmaxf(v, xor_swz<1>(v)); v = fmaxf(v, xor_swz<2>(v)); v = fmaxf(v, xor_swz<4>(v)); v = fmaxf(v, xor_swz<8>(v)); v = fmaxf(v, xor_swz<16>(v)); v = fmaxf(v, xor32(v));
    return v;
}
__device__ __forceinline__ unsigned pk4_i8(float a, float b, float c, float d) {
    const int ia = (int)__builtin_rintf(a), ib = (int)__builtin_rintf(b), ic = (int)__builtin_rintf(c), id = (int)__builtin_rintf(d);
    return ((unsigned)ia & 255u) | (((unsigned)ib & 255u) << 8) | (((unsigned)ic & 255u) << 16) | ((unsigned)id << 24);
}
template <bool F8> struct OutT { typedef bf16_t t; };
template <> struct OutT<true> { typedef uchar t; };

#define XB_TMO      128
#define XB_XCNT(j)  (256  + 64 * (j))
#define XB_XSUB(j)  (1280 + 64 * (j))
#define XB_XGEN(j)  (2304 + 64 * (j))
#define XB_TOP      3328
#define XB_TOPGEN   3392
#define XCD_BAR_WORDS 3456
#define XB_SPIN_CAP (1u << 18)

__device__ __forceinline__ unsigned xb_ld(unsigned* p)              { return __hip_atomic_load(p, __ATOMIC_RELAXED, __HIP_MEMORY_SCOPE_AGENT); }
__device__ __forceinline__ unsigned xb_add(unsigned* p, unsigned v) { return __hip_atomic_fetch_add(p, v, __ATOMIC_RELAXED, __HIP_MEMORY_SCOPE_AGENT); }
__device__ __forceinline__ unsigned xb_xcc_id() { return (unsigned)__builtin_amdgcn_s_getreg((3 << 11) | 20) & 0xFu; }
#define XB_SPIN(cond, bar) do { unsigned _sp = 0; while (cond) { __builtin_amdgcn_s_sleep(1); \
    if ((++_sp & 255u) == 0u) { if (xb_ld(&(bar)[XB_TMO])) break; if (_sp > XB_SPIN_CAP) { atomicAdd(&(bar)[XB_TMO], 1u); break; } } } } while (0)

struct XcdBarrier {
    unsigned* bar; unsigned x;
    volatile LAS unsigned* st;
};

__device__ __forceinline__ XcdBarrier xcd_barrier_post(unsigned* bar, volatile LAS unsigned* st) {
    XcdBarrier b; b.bar = bar; b.x = xb_xcc_id(); b.st = st;
    if (threadIdx.x == 0) (void)xb_add(&bar[XB_XCNT(b.x)], 1u);
    return b;
}
__device__ __forceinline__ void xcd_barrier_complete(unsigned* bar, unsigned x, unsigned& nloc, unsigned& nx) {
    const unsigned G = gridDim.x * gridDim.y * gridDim.z;
    unsigned sum, cnt, mine, sp = 0u;
    for (;;) {
        sum = 0u; cnt = 0u; mine = 0u;
#pragma unroll
        for (unsigned j = 0; j < 16; ++j) { const unsigned c = xb_ld(&bar[XB_XCNT(j)]); sum += c; cnt += (c > 0u) ? 1u : 0u; mine = (j == x) ? c : mine; }
        if (sum == G) break;
        __builtin_amdgcn_s_sleep(1);
        if ((++sp & 255u) == 0u) { if (xb_ld(&bar[XB_TMO])) break; if (sp > XB_SPIN_CAP) { atomicAdd(&bar[XB_TMO], 1u); break; } }
    }
    nloc = mine > 0u ? mine : 1u; nx = cnt > 0u ? cnt : 1u;
}

__device__ __forceinline__ void xcd_barrier(const XcdBarrier& b) {
    asm volatile("s_waitcnt vmcnt(0)" ::: "memory");
    __syncthreads();
    if (threadIdx.x == 0) {
        unsigned* bar = b.bar;
        __builtin_amdgcn_s_waitcnt(0);
        unsigned nloc = b.st[0], nx = b.st[1];
        if (nloc == 0u) { xcd_barrier_complete(bar, b.x, nloc, nx); b.st[0] = nloc; b.st[1] = nx; }
        const unsigned old = xb_add(&bar[XB_XSUB(b.x)], 1u);
        const unsigned gen = old / nloc;
        if (old + 1u == (gen + 1u) * nloc) {
            __builtin_amdgcn_fence(__ATOMIC_RELEASE, "agent");
            asm volatile("s_waitcnt vmcnt(0)" ::: "memory");
            const unsigned og = xb_add(&bar[XB_TOP], 1u);
            const unsigned tg = og / nx;
            if (og + 1u == (tg + 1u) * nx) xb_add(&bar[XB_TOPGEN], 1u);
            else XB_SPIN(xb_ld(&bar[XB_TOPGEN]) == tg, bar);
            __builtin_amdgcn_fence(__ATOMIC_ACQUIRE, "agent");
            xb_add(&bar[XB_XGEN(b.x)], 1u);
            asm volatile("s_waitcnt vmcnt(0)" ::: "memory");
        } else {
            XB_SPIN(xb_ld(&bar[XB_XGEN(b.x)]) == gen, bar);
            __builtin_amdgcn_fence(__ATOMIC_ACQUIRE, "agent");
            asm volatile("s_waitcnt vmcnt(0)" ::: "memory");
        }
    }
    __syncthreads();
}

namespace pg8 {
constexpr int BM = 256, BK = 64, HALF = 128, HTB = HALF * BK * 2  , STAGE_BYTES = 8 * HTB, NXCD = 8, WGM = 8;
__host__ __device__ __forceinline__ int lds_byte(int r, int c) { const int st = (r >> 4) * 2 + (c >> 5), rr = r & 15, cc = c & 31, ob = rr * 64 + cc * 2; return st * 1024 + (ob ^ (((ob >> 9) & 1) << 5)); }
__host__ __device__ __forceinline__ void stage_rc(int b, int& R, int& C) { const int st = b / 1024, sb = b % 1024, swz = sb ^ (((sb >> 9) & 1) << 5); R = (st >> 1) * 16 + swz / 64; C = (st & 1) * 32 + (swz % 64) / 2; }
__host__ __device__ __forceinline__ int perm32(int rho) { const int n = rho >> 4, i = rho & 15; return 8 * (i >> 2) + 4 * n + (i & 3); }

struct Unit { int pm, pn; long boff; };
struct Gemm { const bf16_t* A; const bf16_t* Bt; int M, N, K; int lda = 0, ldb = 0; };

struct StaticOrder {
    static constexpr bool GATHER = false;
    int nM, nN, nwg, G, c;
    __device__ void init(int M, int N, int G_, int c_) { nM = M / BM; nN = N / BM; nwg = nM * nN; G = G_; c = c_; }
    __device__ bool next(int i, Unit& u) const {
        const long L = (long)i * G + c; if (L >= nwg) return false;
        int wgid = (int)L; { const int q = nwg / NXCD, r = nwg % NXCD, xcd = wgid % NXCD, off = wgid / NXCD; wgid = (xcd < r ? xcd * (q + 1) : r * (q + 1) + (xcd - r) * q) + off; }
        const int nig = WGM * nN, gid = wgid / nig, fm = gid * WGM, gsz = (nM - fm) < WGM ? (nM - fm) : WGM;
        u.pm = fm + ((wgid % nig) % gsz); u.pn = (wgid % nig) / gsz; u.boff = 0; return true;
    }
};
struct MoeOrder : StaticOrder {
    int p0; const LAS int* pexp; long estride;
    __device__ bool next(int i, Unit& u) const { if (!StaticOrder::next(i, u)) return false; u.pm += p0; u.boff = (long)pexp[u.pm] * estride; return true; }
};

struct MoeGatherOrder : MoeOrder {
    static constexpr bool GATHER = true;
    const int* tokof;
    const LAS int* tokl;
    __device__ __forceinline__ unsigned rowtok(int li, int r) const { return (unsigned)tokl[li * 256 + r]; }
    __device__ __forceinline__ void fill_tokl(LAS int* dst, int tid) { Unit u; for (int i = 0; next(i, u); ++i) if (tid < 256) { const int t = ((const GAS int*)tokof)[u.pm * BM + tid]; dst[i * 256 + tid] = t < 0 ? 0 : t; }
        tokl = dst; __syncthreads(); }
};

template <class Epi, class Sched>
__device__ __forceinline__ void gemm_phase(LAS unsigned char* lds, const Gemm g, const Sched& S, const Epi& E, const int tid) {
    const int wid = __builtin_amdgcn_readfirstlane(tid >> 6), lane = tid & 63, wr = wid >> 2, wc = wid & 3, fr = lane & 15, fq = lane >> 4;
    const int K = g.K, nt = K / BK, lda = g.lda ? g.lda : 2 * K, ldb = g.ldb ? g.ldb : 2 * K;
    unsigned voffA[2], voffB[2];
#pragma unroll
    for (int i = 0; i < 2; ++i) { int R, C; stage_rc(tid * 16 + i * 8192, R, C); const int Rb = Epi::PERM ? ((R & ~31) + perm32(R & 31)) : R;
        voffA[i] = (unsigned)(R * lda + C * 2); voffB[i] = (unsigned)(Rb * ldb + C * 2); }
    const size_t kstep = (size_t)(BK * 2);
    const size_t hstepA = (size_t)HALF * lda, hstepB = (size_t)HALF * ldb;
    const size_t tstepA = 2 * hstepA, tstepB = 2 * hstepB;
    const unsigned ldsw = (unsigned)wid * 1024u;
    const int aoff = lds_byte(wr * 64 + fr, fq * 8), boff = lds_byte(wc * 32 + fr, fq * 8);
#define PG8_SA(b, h) (((b) * 2 + (h)) * HTB)
#define PG8_SB(b, h) ((4 + (b) * 2 + (h)) * HTB)
#define PG8_STAGE(bufoff, gbase, voff) do { const char* gb_ = (const char*)(gbase); if constexpr (Epi::FP8) asm volatile("" : "+s"(gb_));     \
        _Pragma("unroll") for (int _i = 0; _i < 2; ++_i) \
        __builtin_amdgcn_global_load_lds((const unsigned*)(gb_ + (voff)[_i]), (LAS unsigned*)(lds + (bufoff) + ldsw + _i * 8192), 16, 0, 0); } while (0)
#define PG8_LDA(dst, b, h) do { _Pragma("unroll") for (int m = 0; m < 4; ++m) _Pragma("unroll") for (int k = 0; k < 2; ++k) dst[m][k] = *(const LAS bf16x8*)(lds + PG8_SA(b, h) + aoff + m * 2048 + k * 1024); } while (0)
#define PG8_LDB(dst, b, h) do { _Pragma("unroll") for (int n = 0; n < 2; ++n) _Pragma("unroll") for (int k = 0; k < 2; ++k) dst[n][k] = *(const LAS bf16x8*)(lds + PG8_SB(b, h) + boff + n * 2048 + k * 1024); } while (0)
#define PG8_CAT(x_, y_) __builtin_shufflevector(__builtin_bit_cast(i32x4, x_), __builtin_bit_cast(i32x4, y_), 0, 1, 2, 3, 4, 5, 6, 7)
#define PG8_MMA(ai, bj, At, Bt) do { __builtin_amdgcn_s_setprio(1); _Pragma("unroll") for (int m = 0; m < 4; ++m) _Pragma("unroll") for (int n = 0; n < 2; ++n) { \
        if constexpr (Epi::FP8) mfma_f8(acc[ai][bj][m][n], PG8_CAT(Bt[n][0], Bt[n][1]), PG8_CAT(At[m][0], At[m][1])); \
        else if constexpr (Epi::I8) { _Pragma("unroll") for (int k = 0; k < 2; ++k) acc[ai][bj][m][n] = __builtin_bit_cast(f32x4, __builtin_amdgcn_mfma_i32_16x16x64_i8(__builtin_bit_cast(i32x4, Bt[n][k]), __builtin_bit_cast(i32x4, At[m][k]), __builtin_bit_cast(i32x4, acc[ai][bj][m][n]), 0, 0, 0)); } \
        else { _Pragma("unroll") for (int k = 0; k < 2; ++k) acc[ai][bj][m][n] = __builtin_amdgcn_mfma_f32_16x16x32_bf16(Bt[n][k], At[m][k], acc[ai][bj][m][n], 0, 0, 0); } } \
        __builtin_amdgcn_s_setprio(0); } while (0)
#define PG8_WAIT_V(n) asm volatile("s_waitcnt vmcnt(" #n ")" ::: "memory")
#define PG8_WAIT_L(n) asm volatile("s_waitcnt lgkmcnt(" #n ")" ::: "memory")
#define PG8_BAR __builtin_amdgcn_s_barrier()
#define PG8_SCHED __builtin_amdgcn_sched_barrier(0)
#define PG8_KBODY \
            const bool last = (t == nt - 2); \
            const char* a1 = cA + (size_t)(t + 1) * kstep; \
            const char* a2 = last ? nA : cA + (size_t)(t + 2) * kstep; const char* b2 = last ? nB : cB + (size_t)(t + 2) * kstep; \
            const char* a3 = a2 + kstep; const char* b3 = b2 + kstep; const size_t k2b = last ? (size_t)0 : (size_t)(t + 2) * kstep; \
            PG8_LDB(B0, 0, 0); PG8_SCHED; PG8_LDA(At, 0, 0); PG8_STAGE_A(PG8_SA(1, 1), a1, 1, false, (size_t)(t + 1) * kstep); \
            PG8_WAIT_L(8); PG8_BAR; PG8_WAIT_L(0); PG8_MMA(0, 0, At, B0); PG8_BAR; PG8_SCHED; \
            PG8_LDB(B1, 0, 1); PG8_STAGE(PG8_SB(0, 0), b2, voffB); \
            PG8_BAR; PG8_WAIT_L(0); PG8_MMA(0, 1, At, B1); PG8_BAR; \
            PG8_LDA(At, 0, 1); PG8_STAGE_A(PG8_SA(0, 0), a2, 0, last, k2b); \
            PG8_BAR; PG8_WAIT_L(0); PG8_MMA(1, 0, At, B0); PG8_BAR; PG8_SCHED; \
            PG8_STAGE(PG8_SB(0, 1), b2 + hstepB, voffB); \
            PG8_WAIT_V(6); PG8_BAR; PG8_MMA(1, 1, At, B1); PG8_BAR; \
            PG8_LDB(B0, 1, 0); PG8_SCHED; PG8_LDA(At, 1, 0); PG8_STAGE_A(PG8_SA(0, 1), a2, 1, last, k2b); \
            PG8_WAIT_L(8); PG8_BAR; PG8_WAIT_L(0); PG8_MMA(0, 0, At, B0); PG8_BAR; PG8_SCHED; \
            PG8_LDB(B1, 1, 1); PG8_STAGE(PG8_SB(1, 0), b3, voffB); \
            PG8_BAR; PG8_WAIT_L(0); PG8_MMA(0, 1, At, B1); PG8_BAR; \
            PG8_LDA(At, 1, 1); PG8_STAGE_A(PG8_SA(1, 0), a3, 0, last, k2b + kstep); \
            PG8_BAR; PG8_WAIT_L(0); PG8_MMA(1, 0, At, B0); PG8_BAR; PG8_SCHED; \
            PG8_STAGE(PG8_SB(1, 1), b3 + hstepB, voffB); \
            PG8_WAIT_V(6); PG8_BAR; PG8_MMA(1, 1, At, B1); PG8_BAR;
    constexpr bool GATHER = Sched::GATHER;
    unsigned vgC[2][2], vgN[2][2];
#define PG8_GOFFS(dst, unit_, li_) do { if constexpr (GATHER) { _Pragma("unroll") for (int h_ = 0; h_ < 2; ++h_) _Pragma("unroll") for (int i_ = 0; i_ < 2; ++i_) { int R_, C_; stage_rc(tid * 16 + i_ * 8192, R_, C_); \
        dst[h_][i_] = S.rowtok(li_, h_ * HALF + R_) * (unsigned)lda + (unsigned)C_ * 2u; } } } while (0)
#define PG8_STAGE_A(bufoff, ptr_, h_, use_next_, kbyte_) do { if constexpr (GATHER) { _Pragma("unroll") for (int _i = 0; _i < 2; ++_i) \
        __builtin_amdgcn_global_load_lds((const unsigned*)((const char*)g.A + (kbyte_) + ((use_next_) ? vgN[h_][_i] : vgC[h_][_i])), (LAS unsigned*)(lds + (bufoff) + ldsw + _i * 8192), 16, 0, 0); } \
        else { PG8_STAGE(bufoff, (ptr_) + (h_) * hstepA, voffA); } } while (0)
    Unit cur, nxt; int ui = 0;
    if (!S.next(0, cur)) return;
    f32x4 acc[2][2][4][2];
#pragma unroll
    for (int a = 0; a < 2; ++a)
#pragma unroll
        for (int b = 0; b < 2; ++b)
#pragma unroll
            for (int m = 0; m < 4; ++m)
#pragma unroll
                for (int n = 0; n < 2; ++n) acc[a][b][m][n] = (f32x4){0.f, 0.f, 0.f, 0.f};
    bf16x8 At[4][2], B0[2][2], B1[2][2];
    const char* cA = (const char*)g.A + (size_t)cur.pm * tstepA; const char* cB = (const char*)g.Bt + cur.boff + (size_t)cur.pn * tstepB;
    PG8_GOFFS(vgC, cur, 0);
    PG8_STAGE(PG8_SB(0, 0), cB, voffB); PG8_STAGE_A(PG8_SA(0, 0), cA, 0, false, (size_t)0); PG8_STAGE(PG8_SB(0, 1), cB + hstepB, voffB); PG8_STAGE_A(PG8_SA(0, 1), cA, 1, false, (size_t)0);
    if (wr == 1) PG8_BAR;
    PG8_WAIT_V(4); PG8_BAR;
    PG8_STAGE(PG8_SB(1, 0), cB + kstep, voffB); PG8_STAGE_A(PG8_SA(1, 0), cA + kstep, 0, false, kstep); PG8_STAGE(PG8_SB(1, 1), cB + hstepB + kstep, voffB);
    PG8_WAIT_V(6); PG8_BAR;
    for (;;) {
        const bool has_next = S.next(ui + 1, nxt);
        if (has_next) PG8_GOFFS(vgN, nxt, ui + 1); else { if constexpr (GATHER) { _Pragma("unroll") for (int h_ = 0; h_ < 2; ++h_) _Pragma("unroll") for (int i_ = 0; i_ < 2; ++i_) vgN[h_][i_] = vgC[h_][i_]; } }
        const char* nA = has_next ? (const char*)g.A + (size_t)nxt.pm * tstepA : cA; const char* nB = has_next ? (const char*)g.Bt + nxt.boff + (size_t)nxt.pn * tstepB : cB;
        if constexpr (Epi::MID_T > 0) {
#pragma clang loop unroll(disable)
            for (int part = 0; part < 2; ++part) { const int t1 = part ? nt : Epi::MID_T;
#pragma clang loop unroll(disable)
                for (int t = part ? Epi::MID_T : 0; t < t1; t += 2) { PG8_KBODY }
                if (part == 0) E.mid(acc, cur, wr, wc, fr, fq); }
        } else if constexpr (Epi::FP8 || Epi::I8) {
#pragma clang loop unroll(disable)
            for (int t = 0; t < nt; t += 2) { PG8_KBODY }
        } else {
            for (int t = 0; t < nt; t += 2) { PG8_KBODY }
        }
        if constexpr (Epi::FP8) { F8_ACC_SETTLE();
#pragma unroll
            for (int a = 0; a < 2; ++a)
#pragma unroll
                for (int b = 0; b < 2; ++b)
#pragma unroll
                    for (int m = 0; m < 4; ++m)
#pragma unroll
                        for (int n = 0; n < 2; ++n) asm volatile("" : "+v"(acc[a][b][m][n])); }
        E(acc, cur, wr, wc, fr, fq);
        if (!has_next) break;
#pragma unroll
        for (int a = 0; a < 2; ++a)
#pragma unroll
            for (int b = 0; b < 2; ++b)
#pragma unroll
                for (int m = 0; m < 4; ++m)
#pragma unroll
                    for (int n = 0; n < 2; ++n) acc[a][b][m][n] = (f32x4){0.f, 0.f, 0.f, 0.f};
        cur = nxt; cA = nA; cB = nB; ++ui;
        if constexpr (GATHER) { _Pragma("unroll") for (int h_ = 0; h_ < 2; ++h_) _Pragma("unroll") for (int i_ = 0; i_ < 2; ++i_) vgC[h_][i_] = vgN[h_][i_]; }
    }
    PG8_WAIT_V(0);
    if (wr == 0) PG8_BAR;
    PG8_BAR;
#undef PG8_KBODY
#undef PG8_GOFFS
#undef PG8_STAGE_A
#undef PG8_SA
#undef PG8_SB
#undef PG8_STAGE
#undef PG8_LDA
#undef PG8_LDB
#undef PG8_MMA
#undef PG8_CAT
#undef PG8_WAIT_V
#undef PG8_WAIT_L
#undef PG8_BAR
#undef PG8_SCHED
}

typedef f32x4 Acc[2][2][4][2];

template <int IN> __device__ __forceinline__ f32x4 accv(const f32x4 a, const float rsv, const f32x4 c) {
    if constexpr (IN == 2) { const i32x4 q = __builtin_bit_cast(i32x4, a); return (f32x4){(float)q[0] * (rsv * c[0]), (float)q[1] * (rsv * c[1]), (float)q[2] * (rsv * c[2]), (float)q[3] * (rsv * c[3])}; }
    else return a;
}
template <int IN> __device__ __forceinline__ void col_scales(const float* cs, const Unit& u, int wc, int fq, f32x4 (&c)[2][2]) {
    if constexpr (IN == 2) { const GAS f32x4* p = (const GAS f32x4*)(cs + u.pn * BM + wc * 32 + 8 * fq);
        c[0][0] = p[0]; c[0][1] = p[1]; c[1][0] = p[HALF / 4]; c[1][1] = p[HALF / 4 + 1]; }
    else { c[0][0] = c[0][1] = c[1][0] = c[1][1] = (f32x4){1.f, 1.f, 1.f, 1.f}; }
}
template <int IN> struct EpiBf16 {
    static constexpr bool PERM = true; static constexpr int MID_T = 0; static constexpr bool FP8 = IN == 1, I8 = IN == 2;
    bf16_t* O; int ldc; int prow0; float sc; const float* rs; const float* cs;
    __device__ __forceinline__ void operator()(const Acc& acc, const Unit& u, int wr, int wc, int fr, int fq) const {
        const int row0 = (u.pm - prow0) * BM + wr * 64 + fr, col0 = u.pn * BM + wc * 32 + 8 * fq;
        f32x4 cv[2][2]; col_scales<IN>(cs, u, wc, fq, cv);
        float rsa[2][4];
#pragma unroll
        for (int ai = 0; ai < 2; ++ai)
#pragma unroll
            for (int m = 0; m < 4; ++m) { rsa[ai][m] = 1.f; if constexpr (I8) rsa[ai][m] = ((const GAS float*)rs)[u.pm * BM + wr * 64 + fr + ai * HALF + m * 16]; }
        if constexpr (I8) __builtin_amdgcn_sched_barrier(0);
#pragma unroll
        for (int ai = 0; ai < 2; ++ai)
#pragma unroll
            for (int m = 0; m < 4; ++m) { bf16_t* rowp = O + (size_t)(row0 + ai * HALF + m * 16) * ldc + col0;
                const float rsv = rsa[ai][m];
#pragma unroll
                for (int bj = 0; bj < 2; ++bj) { f32x4 v0 = accv<IN>(acc[ai][bj][m][0], rsv, cv[bj][0]), v1 = accv<IN>(acc[ai][bj][m][1], rsv, cv[bj][1]);
                    if constexpr (FP8) { v0 *= sc; v1 *= sc; }
                    u32x4 w; w.x = pk2(v0[0], v0[1]); w.y = pk2(v0[2], v0[3]); w.z = pk2(v1[0], v1[1]); w.w = pk2(v1[2], v1[3]);
                    *(GAS u32x4*)(rowp + bj * HALF) = w; } }
    }
};
template <int IN> struct EpiTok {
    static constexpr bool PERM = true; static constexpr int MID_T = 0; static constexpr bool FP8 = false, I8 = IN == 2;
    bf16_t* qk; uchar* gates; const float* qn; const float* kn; const bf16_t* ct; const bf16_t* st; const float* rs; const float* cs;
    __device__ __forceinline__ void operator()(const Acc& acc, const Unit& u, int wr, int wc, int fr_in, int fq_in) const {
        int fr = fr_in, fq = fq_in; asm volatile("" : "+v"(fr), "+v"(fq));
        const int row0 = u.pm * BM + wr * 64 + fr;
        f32x4 cv[2][2]; col_scales<IN>(cs, u, wc, fq, cv);
        if (u.pn < 4) {
            const int G = 4 * u.pn + wc; const bool isq = G < 8; const GAS float* gn = (const GAS float*)(isq ? qn : kn);
            const float post = isq ? (0.125f * 1.44269504089f) : 1.0f;
            const int i0 = 8 * fq;
            unsigned gpa[4], gpb[4];
            { const f32x4 ga0 = *(const GAS f32x4*)(gn + i0), ga1 = *(const GAS f32x4*)(gn + i0 + 4), gb0 = *(const GAS f32x4*)(gn + 32 + i0), gb1 = *(const GAS f32x4*)(gn + 36 + i0);
              gpa[0] = pk2(ga0[0], ga0[1]); gpa[1] = pk2(ga0[2], ga0[3]); gpa[2] = pk2(ga1[0], ga1[1]); gpa[3] = pk2(ga1[2], ga1[3]);
              gpb[0] = pk2(gb0[0], gb0[1]); gpb[1] = pk2(gb0[2], gb0[3]); gpb[2] = pk2(gb1[0], gb1[1]); gpb[3] = pk2(gb1[2], gb1[3]);
#pragma unroll
              for (int e = 0; e < 4; ++e) asm volatile("" : "+v"(gpa[e]), "+v"(gpb[e])); }
#pragma unroll
            for (int ai = 0; ai < 2; ++ai)
#pragma unroll
                for (int mb = 0; mb < 4; mb += 2) {
                    u32x4 cc[2], sn[2]; float rsb[2];
#pragma unroll
                    for (int mm = 0; mm < 2; ++mm) { const int row = row0 + ai * HALF + (mb + mm) * 16, l = row & (SEQ - 1);
                        cc[mm] = *(const GAS u32x4*)(ct + l * 32 + i0); sn[mm] = *(const GAS u32x4*)(st + l * 32 + i0);
                        rsb[mm] = 1.f; if constexpr (I8) rsb[mm] = ((const GAS float*)rs)[row]; }
                    __builtin_amdgcn_sched_barrier(0);
#pragma unroll
                    for (int mm = 0; mm < 2; ++mm) { const int m = mb + mm, row = row0 + ai * HALF + m * 16;
                        f32x4 xa[2][2];
#pragma unroll
                        for (int bj = 0; bj < 2; ++bj)
#pragma unroll
                            for (int n = 0; n < 2; ++n) xa[bj][n] = accv<IN>(acc[ai][bj][m][n], rsb[mm], cv[bj][n]);
                        float ss = 0.f;
#pragma unroll
                        for (int bj = 0; bj < 2; ++bj)
#pragma unroll
                            for (int n = 0; n < 2; ++n) { const f32x4 x = xa[bj][n]; ss += (x[0] * x[0] + x[1] * x[1]) + (x[2] * x[2] + x[3] * x[3]); }
                        ss += xor_swz<16>(ss); ss += xor32(ss);
                        const float r = __builtin_amdgcn_rsqf(ss * (1.0f / 64.0f) + RMS_EPS) * post;
                        float oa[8], ob[8];
#pragma unroll
                        for (int e = 0; e < 8; ++e) { const float a = xa[0][e >> 2][e & 3] * ((e & 1) ? bfhi(gpa[e >> 1]) : bflo(gpa[e >> 1])), b = xa[1][e >> 2][e & 3] * ((e & 1) ? bfhi(gpb[e >> 1]) : bflo(gpb[e >> 1]));
                            const float c = (e & 1) ? bfhi(cc[mm][e >> 1]) : bflo(cc[mm][e >> 1]), sv = (e & 1) ? bfhi(sn[mm][e >> 1]) : bflo(sn[mm][e >> 1]);
                            oa[e] = (a * c - b * sv) * r; ob[e] = (a * sv + b * c) * r; }
                        GAS bf16_t* rowp = (GAS bf16_t*)qk + (size_t)row * 1024 + 64 * G + i0;
                        *(GAS u32x4*)(rowp) = (u32x4){pk2(oa[0], oa[1]), pk2(oa[2], oa[3]), pk2(oa[4], oa[5]), pk2(oa[6], oa[7])};
                        *(GAS u32x4*)(rowp + 32) = (u32x4){pk2(ob[0], ob[1]), pk2(ob[2], ob[3]), pk2(ob[4], ob[5]), pk2(ob[6], ob[7])}; }
                    __builtin_amdgcn_sched_barrier(0);
                }
        } else {
            const int col0 = (u.pn - 4) * HALF + wc * 32 + 8 * fq;
            float rsa[2][4];
#pragma unroll
            for (int ai = 0; ai < 2; ++ai)
#pragma unroll
                for (int m = 0; m < 4; ++m) { rsa[ai][m] = 1.f; if constexpr (I8) rsa[ai][m] = ((const GAS float*)rs)[row0 + ai * HALF + m * 16]; }
            if constexpr (I8) __builtin_amdgcn_sched_barrier(0);
#pragma unroll
            for (int ai = 0; ai < 2; ++ai)
#pragma unroll
                for (int m = 0; m < 4; ++m) {
                    const float rsv = rsa[ai][m];
                    f32x4 xa[2][2];
#pragma unroll
                    for (int bj = 0; bj < 2; ++bj)
#pragma unroll
                        for (int n = 0; n < 2; ++n) xa[bj][n] = accv<IN>(acc[ai][bj][m][n], rsv, cv[bj][n]);
                    unsigned qh[8], qa[8];
#pragma unroll
                    for (int e = 0; e < 8; ++e) { qh[e] = (unsigned)(fast_sigmoid(xa[0][e >> 2][e & 3]) * 255.0f + 0.5f); qa[e] = (unsigned)(fast_sigmoid(xa[1][e >> 2][e & 3]) * 255.0f + 0.5f); }
                    u32x4 w; w.x = qh[0] | (qh[1] << 8) | (qh[2] << 16) | (qh[3] << 24); w.y = qh[4] | (qh[5] << 8) | (qh[6] << 16) | (qh[7] << 24);
                    w.z = qa[0] | (qa[1] << 8) | (qa[2] << 16) | (qa[3] << 24); w.w = qa[4] | (qa[5] << 8) | (qa[6] << 16) | (qa[7] << 24);
                    *(GAS u32x4*)((GAS uchar*)gates + (size_t)(row0 + ai * HALF + m * 16) * 2048 + (size_t)col0 * 2) = w; }
        }
    }
};
__device__ __forceinline__ float ub0(unsigned w) { return (float)(w & 0xffu); }
__device__ __forceinline__ float ub1(unsigned w) { return (float)((w >> 8) & 0xffu); }
__device__ __forceinline__ float ub2(unsigned w) { return (float)((w >> 16) & 0xffu); }
__device__ __forceinline__ float ub3(unsigned w) { return (float)(w >> 24); }
struct EpiMergeF {
    static constexpr bool PERM = true; static constexpr int MID_T = 8; static constexpr bool FP8 = false, I8 = false;
    bf16_t* merged; const uchar* gates;
    __device__ __forceinline__ void mid(Acc& acc, const Unit& u, int wr, int wc, int fr_in, int fq_in) const {
        int fr = fr_in, fq = fq_in; asm volatile("" : "+v"(fr), "+v"(fq));
        const int row0 = u.pm * BM + wr * 64 + fr, col0 = u.pn * BM + wc * 32 + 8 * fq;
#pragma unroll
        for (int ai = 0; ai < 2; ++ai)
#pragma unroll
            for (int mp = 0; mp < 2; ++mp) {
                u32x4 gw[2][2];
#pragma unroll
                for (int mm = 0; mm < 2; ++mm)
#pragma unroll
                    for (int bj = 0; bj < 2; ++bj) gw[mm][bj] = *(const GAS u32x4*)((const GAS uchar*)gates + (size_t)(row0 + ai * HALF + (2 * mp + mm) * 16) * 2048 + (size_t)(col0 + bj * HALF) * 2);
                __builtin_amdgcn_sched_barrier(0);
#pragma unroll
                for (int mm = 0; mm < 2; ++mm)
#pragma unroll
                    for (int bj = 0; bj < 2; ++bj) { const int m = 2 * mp + mm; const u32x4 g = gw[mm][bj];
                        acc[ai][bj][m][0][0] *= ub0(g.x) * __builtin_amdgcn_rcpf(fmaxf(ub0(g.z), 1.0f)); acc[ai][bj][m][0][1] *= ub1(g.x) * __builtin_amdgcn_rcpf(fmaxf(ub1(g.z), 1.0f));
                        acc[ai][bj][m][0][2] *= ub2(g.x) * __builtin_amdgcn_rcpf(fmaxf(ub2(g.z), 1.0f)); acc[ai][bj][m][0][3] *= ub3(g.x) * __builtin_amdgcn_rcpf(fmaxf(ub3(g.z), 1.0f));
                        acc[ai][bj][m][1][0] *= ub0(g.y) * __builtin_amdgcn_rcpf(fmaxf(ub0(g.w), 1.0f)); acc[ai][bj][m][1][1] *= ub1(g.y) * __builtin_amdgcn_rcpf(fmaxf(ub1(g.w), 1.0f));
                        acc[ai][bj][m][1][2] *= ub2(g.y) * __builtin_amdgcn_rcpf(fmaxf(ub2(g.w), 1.0f)); acc[ai][bj][m][1][3] *= ub3(g.y) * __builtin_amdgcn_rcpf(fmaxf(ub3(g.w), 1.0f)); }
                __builtin_amdgcn_sched_barrier(0);
            }
    }
    __device__ __forceinline__ void operator()(const Acc& acc, const Unit& u, int wr, int wc, int fr, int fq) const {
        const int row0 = u.pm * BM + wr * 64 + fr, col0 = u.pn * BM + wc * 32 + 8 * fq;
        const float k = 1.0f / 255.0f;
        u32x2 gwv[2][4][2];
#pragma unroll
        for (int ai = 0; ai < 2; ++ai)
#pragma unroll
            for (int m = 0; m < 4; ++m)
#pragma unroll
                for (int bj = 0; bj < 2; ++bj) gwv[ai][m][bj] = *(const GAS u32x2*)((const GAS uchar*)gates + (size_t)(row0 + ai * HALF + m * 16) * 2048 + (size_t)(col0 + bj * HALF) * 2 + 8);
        __builtin_amdgcn_sched_barrier(0);
#pragma unroll
        for (int ai = 0; ai < 2; ++ai)
#pragma unroll
            for (int m = 0; m < 4; ++m) { const size_t row = (size_t)(row0 + ai * HALF + m * 16);
#pragma unroll
                for (int bj = 0; bj < 2; ++bj) { f32x4 v0 = acc[ai][bj][m][0], v1 = acc[ai][bj][m][1];
                    const u32x2 gw = gwv[ai][m][bj];
                    v0[0] *= fmaxf(ub0(gw.x), 1.0f) * k; v0[1] *= fmaxf(ub1(gw.x), 1.0f) * k; v0[2] *= fmaxf(ub2(gw.x), 1.0f) * k; v0[3] *= fmaxf(ub3(gw.x), 1.0f) * k;
                    v1[0] *= fmaxf(ub0(gw.y), 1.0f) * k; v1[1] *= fmaxf(ub1(gw.y), 1.0f) * k; v1[2] *= fmaxf(ub2(gw.y), 1.0f) * k; v1[3] *= fmaxf(ub3(gw.y), 1.0f) * k;
                    u32x4 w; w.x = pk2(v0[0], v0[1]); w.y = pk2(v0[2], v0[3]); w.z = pk2(v1[0], v1[1]); w.w = pk2(v1[2], v1[3]);
                    *(GAS u32x4*)(merged + row * 1024 + col0 + bj * HALF) = w; } }
    }
};
template <bool IN_F32, bool F8 = false> struct EpiRes {
    static constexpr bool PERM = true; static constexpr int MID_T = 0; static constexpr bool FP8 = F8, I8 = false;
    const float* xin; bf16_t* xr; float sc;
    __device__ __forceinline__ void operator()(const Acc& acc, const Unit& u, int wr, int wc, int fr, int fq) const {
        const int row0 = u.pm * BM + wr * 64 + fr, col0 = u.pn * BM + wc * 32 + 8 * fq;
        constexpr int MB = IN_F32 ? 2 : 4;
#pragma unroll
        for (int ai = 0; ai < 2; ++ai)
#pragma unroll
            for (int mb = 0; mb < 4; mb += MB) {
                f32x4 xa[IN_F32 ? MB : 1][2][2]; u32x4 pw[IN_F32 ? 1 : MB][2];
#pragma unroll
                for (int mm = 0; mm < MB; ++mm)
#pragma unroll
                    for (int bj = 0; bj < 2; ++bj) { const size_t row = (size_t)(row0 + ai * HALF + (mb + mm) * 16);
                        if constexpr (IN_F32) { const GAS f32x4* ip = (const GAS f32x4*)(xin + row * 1024 + col0 + bj * HALF); xa[mm][bj][0] = ip[0]; xa[mm][bj][1] = ip[1]; }
                        else pw[mm][bj] = *(const GAS u32x4*)((const GAS bf16_t*)xr + row * XR_LD + col0 + bj * HALF); }
                __builtin_amdgcn_sched_barrier(0);
#pragma unroll
                for (int mm = 0; mm < MB; ++mm)
#pragma unroll
                    for (int bj = 0; bj < 2; ++bj) { const int m = mb + mm; const size_t row = (size_t)(row0 + ai * HALF + m * 16);
                        f32x4 v0 = acc[ai][bj][m][0], v1 = acc[ai][bj][m][1];
                        if constexpr (F8) { v0 *= sc; v1 *= sc; }
                        GAS bf16_t* op = (GAS bf16_t*)xr + row * XR_LD + col0 + bj * HALF;
                        if constexpr (IN_F32) { v0 += xa[mm][bj][0]; v1 += xa[mm][bj][1]; }
                        else { const u32x4 q = pw[mm][bj];
                            v0[0] += bflo(q.x); v0[1] += bfhi(q.x); v0[2] += bflo(q.y); v0[3] += bfhi(q.y);
                            v1[0] += bflo(q.z); v1[1] += bfhi(q.z); v1[2] += bflo(q.w); v1[3] += bfhi(q.w); }
                        *(GAS u32x4*)op = (u32x4){pk2(v0[0], v0[1]), pk2(v0[2], v0[3]), pk2(v1[0], v1[1]), pk2(v1[2], v1[3])}; }
                __builtin_amdgcn_sched_barrier(0);
            }
    }
};
template <int IN, bool OUT8> struct EpiSwiglu {
    static constexpr bool PERM = true; static constexpr int MID_T = 0; static constexpr bool FP8 = IN == 1, I8 = IN == 2;
    bf16_t* act; int prow0; const float* rs; const float* cs;
    __device__ __forceinline__ void operator()(const Acc& acc, const Unit& u, int wr, int wc, int fr, int fq) const {
        const int row0 = (u.pm - prow0) * BM + wr * 64 + fr, col0 = u.pn * HALF + wc * 32 + 8 * fq;
        f32x4 cv[2][2]; col_scales<IN>(cs, u, wc, fq, cv);
        constexpr float kg = FP8 ? F8_UP_INV : 1.0f, ku = kg * (OUT8 ? F8_SACT : 1.0f);
        float rsa[2][4];
#pragma unroll
        for (int ai = 0; ai < 2; ++ai)
#pragma unroll
            for (int m = 0; m < 4; ++m) { rsa[ai][m] = 1.f; if constexpr (I8) rsa[ai][m] = ((const GAS float*)rs)[u.pm * BM + wr * 64 + fr + ai * HALF + m * 16]; }
        if constexpr (I8) __builtin_amdgcn_sched_barrier(0);
#pragma unroll
        for (int ai = 0; ai < 2; ++ai)
#pragma unroll
            for (int m = 0; m < 4; ++m) {
                const float rsv = rsa[ai][m];
                float g[8], up[8], e[8], o[8];
#pragma unroll
                for (int n = 0; n < 2; ++n) { const f32x4 g4 = accv<IN>(acc[ai][0][m][n], rsv, cv[0][n]), u4 = accv<IN>(acc[ai][1][m][n], rsv, cv[1][n]);
#pragma unroll
                    for (int j = 0; j < 4; ++j) { g[n * 4 + j] = g4[j] * kg; up[n * 4 + j] = u4[j] * ku; } }
#pragma unroll
                for (int j = 0; j < 8; ++j) e[j] = __builtin_amdgcn_exp2f(g[j] * -1.44269504089f);
#pragma unroll
                for (int j = 0; j < 8; ++j) asm volatile("" : "+v"(e[j]));
#pragma unroll
                for (int j = 0; j < 8; ++j) e[j] = __builtin_amdgcn_rcpf(1.0f + e[j]);
#pragma unroll
                for (int j = 0; j < 8; ++j) asm volatile("" : "+v"(e[j]));
#pragma unroll
                for (int j = 0; j < 8; ++j) { o[j] = (g[j] * up[j]) * e[j]; if constexpr (OUT8) o[j] = clamp_f8(o[j]); }
                if constexpr (OUT8) { u32x2 w; w.x = pk4_f8(o[0], o[1], o[2], o[3]); w.y = pk4_f8(o[4], o[5], o[6], o[7]);
                    *(GAS u32x2*)((GAS uchar*)act + (size_t)(row0 + ai * HALF + m * 16) * FFP + col0) = w; }
                else { u32x4 w; w.x = pk2(o[0], o[1]); w.y = pk2(o[2], o[3]); w.z = pk2(o[4], o[5]); w.w = pk2(o[6], o[7]);
                    *(GAS u32x4*)(act + (size_t)(row0 + ai * HALF + m * 16) * FFP + col0) = w; } }
    }
};
}
struct Frame {
    LAS uchar* lds;
    int tid, lane, wave, G, bid;
    uchar* ws; unsigned* ctl;
    float* out;
};
#define CAS __attribute__((address_space(4)))
typedef const float* cfptr_t;
__device__ __forceinline__ const float* argp(int k) { const CAS char* kp = (const CAS char*)__builtin_amdgcn_kernarg_segment_ptr(); asm volatile("" : "+s"(kp)); const float* p_ = *(const CAS cfptr_t*)(kp + 8 * k); ASSUME_GLOBAL(p_); return p_; }

template <bool F8 = false> __device__ __forceinline__ void xpose64w(const float* src, int N, int k0, int n0, typename OutT<F8>::t* dst, int ldd, LAS float* scr, int lane, int hi_off = 0, float sc = 1.0f) {
    const GAS char* base = (const GAS char*)(src + (size_t)k0 * N + n0);
    unsigned voff = (unsigned)lane * 4u; const unsigned rstep = (unsigned)N * 4u;
    float v[64];
#pragma unroll
    for (int k = 0; k < 64; ++k) { asm volatile("" : "+v"(voff)); v[k] = *(const GAS float*)(base + voff); voff += rstep; }
#pragma unroll
    for (int k = 0; k < 64; ++k) scr[k * 65 + lane] = v[k];
    asm volatile("s_waitcnt lgkmcnt(0)" ::: "memory"); __builtin_amdgcn_wave_barrier();
    const int kc = lane & 7;
#pragma unroll
    for (int i = 0; i < 8; ++i) { const int n = (lane >> 3) + 8 * i; const LAS float* s = scr + (8 * kc) * 65 + n;
        if constexpr (F8) { u32x2 o; o.x = pk4_f8(s[0] * sc, s[65] * sc, s[2 * 65] * sc, s[3 * 65] * sc); o.y = pk4_f8(s[4 * 65] * sc, s[5 * 65] * sc, s[6 * 65] * sc, s[7 * 65] * sc);
            *(GAS u32x2*)(dst + (size_t)n * ldd + 8 * kc + (n >= 32 ? hi_off : 0)) = o; }
        else { u32x4 o; o.x = pk2(s[0], s[65]); o.y = pk2(s[2 * 65], s[3 * 65]); o.z = pk2(s[4 * 65], s[5 * 65]); o.w = pk2(s[6 * 65], s[7 * 65]);
            *(GAS u32x4*)(dst + (size_t)n * ldd + 8 * kc + (n >= 32 ? hi_off : 0)) = o; } }
    asm volatile("s_waitcnt lgkmcnt(0)" ::: "memory"); __builtin_amdgcn_wave_barrier();
}
#define WAVE_SCR(F) ((LAS float*)((F).lds) + (F).wave * (64 * 65))
__device__ __forceinline__ void conv_win(Frame& F, const float* w, bf16_t* wtok, bf16_t* wch) {
    LAS float* scr = WAVE_SCR(F);
    for (int t = F.bid * NWAVES + F.wave; t < 16 * 80; t += F.G * NWAVES) {
        const int kb = t / 80, nb = t % 80, n0 = nb * 64;
        bf16_t* dst; int hi = 0;
        if (n0 < 1536) dst = wch + (size_t)n0 * 1024;
        else if (n0 < 2560) { const int G = (n0 - 1536) >> 6; dst = wtok + (size_t)(256 * (G >> 2) + 32 * (G & 3)) * 1024; hi = (128 - 32) * 1024; }
        else if (n0 < 3072) dst = wch + (size_t)(1536 + n0 - 2560) * 1024;
        else if (n0 < 4096) { const int c = n0 - 3072; dst = wtok + (size_t)(256 * (4 + (c >> 7)) + (c & 127)) * 1024; }
        else { const int c = n0 - 4096; dst = wtok + (size_t)(256 * (4 + (c >> 7)) + 128 + (c & 127)) * 1024; }
        xpose64w(w, INW, kb * 64, n0, dst + kb * 64, 1024, scr, F.lane, hi);
    }
}
__device__ __forceinline__ void conv_plain(Frame& F, const float* w, int K, int N, bf16_t* dst, int ldd) {
    LAS float* scr = WAVE_SCR(F);
    const int nkb = K / 64, nnb = N / 64;
    for (int t = F.bid * NWAVES + F.wave; t < nkb * nnb; t += F.G * NWAVES) { const int kb = t / nnb, nb = t % nnb;
        xpose64w(w, N, kb * 64, nb * 64, dst + (size_t)(nb * 64) * ldd + kb * 64, ldd, scr, F.lane); }
}
template <bool F8, bool F8DN = F8> __device__ __forceinline__ void conv_ffn(Frame& F, const float* wg, const float* wu, const float* wd, typename OutT<F8>::t* wgu, typename OutT<F8DN>::t* wdt, int nexp) {
    LAS float* scr = WAVE_SCR(F);
    constexpr int GUP = F8 ? P8 : 1024;
    const int per = 16 * 43;
    for (int t = F.bid * NWAVES + F.wave; t < nexp * 3 * per; t += F.G * NWAVES) {
        const int e = t / (3 * per), r = t % (3 * per), which = r / per, q = r % per;
        if (which < 2) { const int kb = q / 43, nb = q % 43, n0 = nb * 64; const float* src = (which ? wu : wg) + (size_t)e * 1024 * DFF;
            const int drow = (n0 / 128) * 256 + which * 128 + (n0 % 128);
            xpose64w<F8>(src, DFF, kb * 64, n0, wgu + (size_t)e * 5632 * GUP + (size_t)drow * GUP + kb * 64, GUP, scr, F.lane, 0, F8_SWGU);
        } else { const int kb = q / 16, nb = q % 16; const float* src = wd + (size_t)e * DFF * 1024;
            xpose64w<F8DN>(src, 1024, kb * 64, nb * 64, wdt + (size_t)e * 1024 * FFP + (size_t)(nb * 64) * FFP + kb * 64, FFP, scr, F.lane, 0, F8_SWD); }
    }
    constexpr int EPC = F8 ? 16 : 8, CR = 1024 / EPC, EPD = F8DN ? 16 : 8, CD = 64 / EPD;
    const int gt = F.bid * NTHR + F.tid, GT = F.G * NTHR;
    for (int i = gt; i < nexp * 128 * CR; i += GT) { const int e = i / (128 * CR), r = (i / CR) % 128, c8 = i % CR;
        const int row = 256 * 21 + (r < 64 ? 64 + r : 192 + (r - 64));
        *(GAS u32x4*)(wgu + (size_t)e * 5632 * GUP + (size_t)row * GUP + c8 * EPC) = (u32x4){0u, 0u, 0u, 0u}; }
    for (int i = gt; i < nexp * 1024 * CD; i += GT) { const int e = i / (1024 * CD), n = (i / CD) % 1024, c8 = i % CD;
        *(GAS u32x4*)(wdt + (size_t)e * 1024 * FFP + (size_t)n * FFP + DFF + c8 * EPD) = (u32x4){0u, 0u, 0u, 0u}; }
}

__device__ __forceinline__ void rope_tables(Frame& F) {
    GAS bf16_t* ct = (GAS bf16_t*)(F.ws + WS_ROPE); GAS bf16_t* st = ct + SEQ * 32;
    const int gt = F.bid * NTHR + F.tid, GT = F.G * NTHR;
    for (int i = gt; i < SEQ * 32; i += GT) { const int l = i >> 5, j = i & 31;
        const float inv_rev = __builtin_amdgcn_exp2f(-(float)j * (13.287712379549449f / 32.0f)) * 0.15915494309f;
        const float rev = (float)l * inv_rev;
        ct[i] = (bf16_t)f2bf(cos_rev(rev)); st[i] = (bf16_t)f2bf(sin_rev(rev)); }
}

__device__ __forceinline__ void norm_row_load(const float* xrow, int lane, f32x4 (&v)[4]) {
    const GAS f32x4* xr = (const GAS f32x4*)xrow + lane;
#pragma unroll
    for (int j = 0; j < 4; ++j) v[j] = xr[64 * j];
}
template <int OM> __device__ __forceinline__ void norm_row(f32x4 (&v)[4], const float* g, typename OutT<(OM != 0)>::t* orow, float* srow, int lane) {
    const GAS f32x4* gr = (const GAS f32x4*)g + lane;
    float s = 0.f;
#pragma unroll
    for (int j = 0; j < 4; ++j) s += (v[j].x * v[j].x + v[j].y * v[j].y) + (v[j].z * v[j].z + v[j].w * v[j].w);
    const float r = __builtin_amdgcn_rsqf(wave_sum(s) * (1.0f / DM) + RMS_EPS);
    if constexpr (OM == 2) {
        float mx = 0.f;
#pragma unroll
        for (int j = 0; j < 4; ++j) { const f32x4 gg = gr[64 * j]; v[j].x *= r * gg.x; v[j].y *= r * gg.y; v[j].z *= r * gg.z; v[j].w *= r * gg.w;
            mx = fmaxf(fmaxf(mx, fmaxf(fabsf(v[j].x), fabsf(v[j].y))), fmaxf(fabsf(v[j].z), fabsf(v[j].w))); }
        mx = fmaxf(wave_max(mx), 1e-30f); const float inv = 127.0f * __builtin_amdgcn_rcpf(mx);
#pragma unroll
        for (int j = 0; j < 4; ++j) ((GAS unsigned*)orow + lane)[64 * j] = pk4_i8(v[j].x * inv, v[j].y * inv, v[j].z * inv, v[j].w * inv);
        if (lane == 0) *(GAS float*)srow = mx * (1.0f / 127.0f);
    } else {
        GAS u32x2* o8 = (GAS u32x2*)orow + lane;
#pragma unroll
        for (int j = 0; j < 4; ++j) { const f32x4 gg = gr[64 * j]; u32x2 w; w.x = pk2(v[j].x * r * gg.x, v[j].y * r * gg.y); w.y = pk2(v[j].z * r * gg.z, v[j].w * r * gg.w); o8[64 * j] = w; }
    }
}
template <int OM> __device__ __forceinline__ void norm_row_bf(const u32x4 (&xw)[2], const float* g, typename OutT<(OM != 0)>::t* orow, float* srow, int lane) {
    const GAS f32x4* gr = (const GAS f32x4*)g + 2 * lane;
    float v[2][8]; float s = 0.f;
#pragma unroll
    for (int j = 0; j < 2; ++j) { const u32x4 w = xw[j]; v[j][0] = bflo(w.x); v[j][1] = bfhi(w.x); v[j][2] = bflo(w.y); v[j][3] = bfhi(w.y); v[j][4] = bflo(w.z); v[j][5] = bfhi(w.z); v[j][6] = bflo(w.w); v[j][7] = bfhi(w.w);
#pragma unroll
        for (int e = 0; e < 8; ++e) s += v[j][e] * v[j][e]; }
    const float r = __builtin_amdgcn_rsqf(wave_sum(s) * (1.0f / DM) + RMS_EPS) * (OM == 1 ? F8_SH : 1.0f);
    if constexpr (OM == 2) {
        float mx = 0.f;
#pragma unroll
        for (int j = 0; j < 2; ++j) { const f32x4 ga = gr[128 * j], gb = gr[128 * j + 1];
            v[j][0] *= r * ga.x; v[j][1] *= r * ga.y; v[j][2] *= r * ga.z; v[j][3] *= r * ga.w; v[j][4] *= r * gb.x; v[j][5] *= r * gb.y; v[j][6] *= r * gb.z; v[j][7] *= r * gb.w;
#pragma unroll
            for (int e = 0; e < 8; ++e) mx = fmaxf(mx, fabsf(v[j][e])); }
        mx = fmaxf(wave_max(mx), 1e-30f); const float inv = 127.0f * __builtin_amdgcn_rcpf(mx);
#pragma unroll
        for (int j = 0; j < 2; ++j) ((GAS u32x2*)orow + lane)[64 * j] = (u32x2){pk4_i8(v[j][0] * inv, v[j][1] * inv, v[j][2] * inv, v[j][3] * inv), pk4_i8(v[j][4] * inv, v[j][5] * inv, v[j][6] * inv, v[j][7] * inv)};
        if (lane == 0) *(GAS float*)srow = mx * (1.0f / 127.0f);
    } else {
#pragma unroll
        for (int j = 0; j < 2; ++j) { const f32x4 ga = gr[128 * j], gb = gr[128 * j + 1];
            if constexpr (OM == 1) ((GAS u32x2*)orow + lane)[64 * j] = (u32x2){pk4_f8(v[j][0] * r * ga.x, v[j][1] * r * ga.y, v[j][2] * r * ga.z, v[j][3] * r * ga.w), pk4_f8(v[j][4] * r * gb.x, v[j][5] * r * gb.y, v[j][6] * r * gb.z, v[j][7] * r * gb.w)};
            else ((GAS u32x4*)orow + lane)[64 * j] = (u32x4){pk2(v[j][0] * r * ga.x, v[j][1] * r * ga.y), pk2(v[j][2] * r * ga.z, v[j][3] * r * ga.w), pk2(v[j][4] * r * gb.x, v[j][5] * r * gb.y), pk2(v[j][6] * r * gb.z, v[j][7] * r * gb.w)}; }
    }
}
template <int OM> __device__ __forceinline__ void phase_norm_bf(Frame& F, const bf16_t* xr, const float* g, typename OutT<(OM != 0)>::t* h, float* hs) {
    const int gw = F.bid * NWAVES + F.wave, NGW = F.G * NWAVES;
    u32x4 xw[2], nw[2];
    if (gw < NTOK) { xw[0] = ((const GAS u32x4*)(xr + (size_t)gw * XR_LD) + F.lane)[0]; xw[1] = ((const GAS u32x4*)(xr + (size_t)gw * XR_LD) + F.lane)[64]; }
    for (int m = gw; m < NTOK; m += NGW) { const int mn = m + NGW < NTOK ? m + NGW : m;
        nw[0] = ((const GAS u32x4*)(xr + (size_t)mn * XR_LD) + F.lane)[0]; nw[1] = ((const GAS u32x4*)(xr + (size_t)mn * XR_LD) + F.lane)[64];
        norm_row_bf<OM>(xw, g, h + (size_t)m * (OM == 2 ? P8 : DM), hs + m, F.lane);
        xw[0] = nw[0]; xw[1] = nw[1]; }
}
template <int OM> __device__ __forceinline__ void phase_norm(Frame& F, const float* x, const float* g, typename OutT<(OM != 0)>::t* h, float* hs) {
    const int gw = F.bid * NWAVES + F.wave, NGW = F.G * NWAVES;
    f32x4 v[4], nv[4];
    if (gw < NTOK) norm_row_load(x + (size_t)gw * DM, F.lane, v);
    for (int m = gw; m < NTOK; m += NGW) { const int mn = m + NGW < NTOK ? m + NGW : m;
        norm_row_load(x + (size_t)mn * DM, F.lane, nv);
        norm_row<OM>(v, g, h + (size_t)m * (OM == 2 ? P8 : DM), hs + m, F.lane);
#pragma unroll
        for (int j = 0; j < 4; ++j) v[j] = nv[j]; }
}
__device__ __forceinline__ void quant_rows(Frame& F, const bf16_t* src, uchar* dst, float* sc, int R) {
    const int gw = F.bid * NWAVES + F.wave, NGW = F.G * NWAVES;
    for (int r = gw; r < R; r += NGW) {
        const GAS u32x4* sp = (const GAS u32x4*)(src + (size_t)r * 1024) + 2 * F.lane;
        const u32x4 a = sp[0], b = sp[1];
        const unsigned w[8] = {a.x, a.y, a.z, a.w, b.x, b.y, b.z, b.w};
        float v[16]; float mx = 0.f;
#pragma unroll
        for (int e = 0; e < 8; ++e) { v[2 * e] = bflo(w[e]); v[2 * e + 1] = bfhi(w[e]); mx = fmaxf(mx, fmaxf(fabsf(v[2 * e]), fabsf(v[2 * e + 1]))); }
        mx = fmaxf(wave_max(mx), 1e-30f); const float inv = 127.0f * __builtin_amdgcn_rcpf(mx);
        *((GAS u32x4*)(dst + (size_t)r * P8) + F.lane) = (u32x4){pk4_i8(v[0] * inv, v[1] * inv, v[2] * inv, v[3] * inv), pk4_i8(v[4] * inv, v[5] * inv, v[6] * inv, v[7] * inv),
                                                                   pk4_i8(v[8] * inv, v[9] * inv, v[10] * inv, v[11] * inv), pk4_i8(v[12] * inv, v[13] * inv, v[14] * inv, v[15] * inv)};
        if (F.lane == 0) ((GAS float*)sc)[r] = mx * (1.0f / 127.0f);
    }
}

__device__ __forceinline__ void phase_hdn(Frame& F, int layer) {
    const GAS float* w1 = (const GAS float*)argp(4) + (size_t)layer * FEMB * FHID; const GAS float* b1 = (const GAS float*)argp(5) + layer * FHID; const GAS float* fr1 = (const GAS float*)argp(6) + layer * FHID;
    const GAS float* w2 = (const GAS float*)argp(7) + (size_t)layer * FHID * FHID; const GAS float* b2 = (const GAS float*)argp(8) + layer * FHID; const GAS float* fr2 = (const GAS float*)argp(9) + layer * FHID;
    GAS float* hdn = (GAS float*)(F.ws + WS_HDN) + (size_t)layer * SEQ * FHID;
    LAS float* scr = (LAS float*)(F.lds + 136 * 1024) + F.wave * 128;
    const int gw = F.bid * NWAVES + F.wave, NGW = F.G * NWAVES, j = F.lane;
    for (int l = gw; l < SEQ; l += NGW) {
        float z = 0.f;
        if (j == 0) z = (float)l * (1.0f / (float)(SEQ - 1));
        else if (j < FEMB) { const int i = (j - 1) & 15; const float f = 1e-4f + (float)i * ((15.0f - 1e-4f) / 15.0f);
            const float rev = f * ((float)l * (1.0f / (float)SEQ)); z = (j <= 16) ? cos_rev(rev) : -sin_rev(rev); }
        scr[j] = z;
        __builtin_amdgcn_wave_barrier(); asm volatile("s_waitcnt lgkmcnt(0)" ::: "memory");
        float a1 = b1[j];
        for (int i = 0; i < FEMB; ++i) a1 += scr[i] * w1[i * FHID + j];
        const float h1 = fast_sin(fr1[j] * a1);
        scr[64 + j] = h1;
        __builtin_amdgcn_wave_barrier(); asm volatile("s_waitcnt lgkmcnt(0)" ::: "memory");
        float a2 = b2[j];
        for (int i = 0; i < FHID; ++i) a2 += scr[64 + i] * w2[i * FHID + j];
        hdn[(size_t)l * FHID + j] = fast_sin(fr2[j] * a2);
        __builtin_amdgcn_wave_barrier(); asm volatile("s_waitcnt lgkmcnt(0)" ::: "memory");
    }
}

__device__ __forceinline__ void phase_fimg(Frame& F, int layer) {
    const GAS float* hdn = (const GAS float*)(F.ws + WS_HDN) + (size_t)layer * SEQ * FHID;
    const GAS float* w3 = (const GAS float*)argp(10) + (size_t)layer * FHID * 2048;
    GAS bf16_t* gimg = (GAS bf16_t*)(F.ws + WS_FIMG);
    const int gw = F.bid * NWAVES + F.wave, NGW = F.G * NWAVES;
    const float min_decay = -4.605170185988091f / 1.5f, max_decay = -4.605170185988091f / 0.3f;
    for (int it = gw; it < 32 * 64; it += NGW) {
        const int lbp = it >> 6, cb = it & 63;
        const int o = cb >> 5, dir = (cb >> 4) & 1;
        int l[2], u[2], lc[2];
#pragma unroll
        for (int h = 0; h < 2; ++h) { const int lb = 2 * lbp + h; l[h] = dir ? (64 * lb + 1 + F.lane) : (64 * lb + 63 - F.lane); u[h] = dir ? (4160 + 64 * lb + F.lane) : (4096 - 64 * lb + F.lane); lc[h] = l[h] < SEQ ? l[h] : SEQ - 1; }
        f32x2 hv[FHID];
        { const GAS f32x4* hp0 = (const GAS f32x4*)(hdn + (size_t)lc[0] * FHID); const GAS f32x4* hp1 = (const GAS f32x4*)(hdn + (size_t)lc[1] * FHID);
#pragma unroll
          for (int i = 0; i < 16; ++i) { const f32x4 a = hp0[i], b = hp1[i]; hv[4 * i] = (f32x2){a.x, b.x}; hv[4 * i + 1] = (f32x2){a.y, b.y}; hv[4 * i + 2] = (f32x2){a.z, b.z}; hv[4 * i + 3] = (f32x2){a.w, b.w}; } }
        LAS float* wt = (LAS float*)(F.lds) + F.wave * 2048;
        { const GAS f32x4* wp = (const GAS f32x4*)(w3 + (size_t)F.lane * 2048 + cb * 32);
#pragma unroll
          for (int q = 0; q < 8; ++q) { const f32x4 t = wp[q]; wt[(4 * q) * 64 + F.lane] = t.x; wt[(4 * q + 1) * 64 + F.lane] = t.y; wt[(4 * q + 2) * 64 + F.lane] = t.z; wt[(4 * q + 3) * 64 + F.lane] = t.w; } }
        asm volatile("s_waitcnt lgkmcnt(0)" ::: "memory"); __builtin_amdgcn_wave_barrier();
        const f32x2 tl = {(float)lc[0] * (1.0f / (float)(SEQ - 1)), (float)lc[1] * (1.0f / (float)(SEQ - 1))};
        for (int cc = 0; cc < 32; ++cc) {
            const int col = cb * 32 + cc, c = col & 511;
            f32x2 acc = {0.f, 0.f};
            const LAS f32x4* wc4 = (const LAS f32x4*)(wt + cc * 64);
#pragma unroll
            for (int i = 0; i < 16; ++i) { const f32x4 w4 = wc4[i];
                acc += hv[4 * i] * (f32x2){w4.x, w4.x}; acc += hv[4 * i + 1] * (f32x2){w4.y, w4.y}; acc += hv[4 * i + 2] * (f32x2){w4.z, w4.z}; acc += hv[4 * i + 3] * (f32x2){w4.w, w4.w}; }
            const float delta = fabsf(min_decay + (float)c * ((max_decay - min_decay) / 511.0f));
#pragma unroll
            for (int h = 0; h < 2; ++h) { const float val = l[h] < SEQ ? acc[h] * fast_exp(-tl[h] * delta) : 0.f;
                gimg[(size_t)(o * 512 + c) * GIMG_LEN + u[h]] = (unsigned short)f2bf(val); }
        }
        asm volatile("s_waitcnt lgkmcnt(0)" ::: "memory"); __builtin_amdgcn_wave_barrier();
    }
}

typedef short s16x4 __attribute__((ext_vector_type(4)));
__device__ __forceinline__ void phase_transpose_y(Frame& F) {
    const GAS bf16_t* yT = (const GAS bf16_t*)(F.ws + WS_YT); GAS bf16_t* yh = (GAS bf16_t*)(F.ws + WS_YCAT);
    constexpr int RB = 144;
    const int r = F.tid >> 3, c8 = F.tid & 7;
    const int w = F.wave, g = F.lane >> 4, i = F.lane & 15, q = i >> 2, p = i & 3;
    u32x4 nx = *(const GAS u32x4*)(yT + (size_t)((F.bid & 7) * 64 + r) * NTOK + (F.bid >> 3) * 64 + c8 * 8);
    int par = 0;
    for (int t = F.bid; t < 8 * 512; t += F.G) {
        const int cb = t & 7, tb = t >> 3;
        LAS uchar* buf = F.lds + par * (64 * RB); par ^= 1;
        *(LAS u32x4*)(buf + r * RB + c8 * 16) = nx;
        { const int tn = t + F.G < 8 * 512 ? t + F.G : t; nx = *(const GAS u32x4*)(yT + (size_t)((tn & 7) * 64 + r) * NTOK + (tn >> 3) * 64 + c8 * 8); }
        __syncthreads();
        const s16x4 va = __builtin_amdgcn_ds_read_tr16_b64_v4i16((LAS s16x4*)(buf + (8 * w + q) * RB + (16 * g + 4 * p) * 2));
        const s16x4 vb = __builtin_amdgcn_ds_read_tr16_b64_v4i16((LAS s16x4*)(buf + (8 * w + 4 + q) * RB + (16 * g + 4 * p) * 2));
        const bf16x8 o = __builtin_shufflevector(va, vb, 0, 1, 2, 3, 4, 5, 6, 7);
        *(GAS bf16x8*)(yh + (size_t)(tb * 64 + 16 * g + i) * 1024 + cb * 64 + 8 * w) = o;
    }
    __syncthreads();
}
constexpr int HY_F = 0, HY_V = FIMG_BYTES, HY_VROW = 144, HY_VROWS = 78 * 8;
static_assert(HY_V + HY_VROWS * HY_VROW <= LDS_MISC, "hyena LDS");

__device__ __forceinline__ void hy_load_fimg(Frame& F, const GAS bf16_t* g) {
    const GAS u32x4* src = (const GAS u32x4*)g;
    constexpr int NJ = FIMG_LEN / 8, NQ = (NJ + NTHR - 1) / NTHR;
    u32x4 av[NQ], bv[NQ];
#pragma unroll
    for (int q = 0; q < NQ; ++q) { const int j0 = F.tid + q * NTHR, j = j0 < NJ ? j0 : NJ - 1; av[q] = src[j + 7]; bv[q] = src[j + 8]; }
#pragma unroll
    for (int q = 0; q < NQ; ++q) { const int j = F.tid + q * NTHR; if (j < NJ) {
        const u32x4 a = av[q], b = bv[q];
        const unsigned d2 = a.z, d3 = a.w, d4 = b.x, d5 = b.y, d6 = b.z, d7 = b.w;
        LAS uchar* dst = F.lds + HY_F + j * 16;
        *(LAS u32x4*)(dst) = (u32x4){__builtin_amdgcn_alignbit(d4, d3, 16), __builtin_amdgcn_alignbit(d5, d4, 16), __builtin_amdgcn_alignbit(d6, d5, 16), __builtin_amdgcn_alignbit(d7, d6, 16)};
        *(LAS u32x4*)(dst + FIMG_LEN * 2) = (u32x4){d3, d4, d5, d6};
        *(LAS u32x4*)(dst + 2 * FIMG_LEN * 2) = (u32x4){__builtin_amdgcn_alignbit(d3, d2, 16), __builtin_amdgcn_alignbit(d4, d3, 16), __builtin_amdgcn_alignbit(d5, d4, 16), __builtin_amdgcn_alignbit(d6, d5, 16)};
        *(LAS u32x4*)(dst + 3 * FIMG_LEN * 2) = (u32x4){d2, d3, d4, d5}; } }
}
__device__ __forceinline__ bf16x8 hy_lda(const LAS uchar* p) { const bf16x4 lo = *(const volatile LAS bf16x4*)p; const bf16x4 hi = *(const volatile LAS bf16x4*)(p + 8); return __builtin_shufflevector(lo, hi, 0, 1, 2, 3, 4, 5, 6, 7); }
__device__ __forceinline__ void hy_conv(Frame& F, f32x4 (&acc)[4][4]) {
    const int q = F.wave, i = F.lane & 15, g = F.lane >> 4;
#pragma unroll
    for (int r = 0; r < 4; ++r)
#pragma unroll
        for (int nt = 0; nt < 4; ++nt) acc[r][nt] = (f32x4){0.f, 0.f, 0.f, 0.f};
    const int dhi = 8 * q + 7;
    const LAS uchar* pA = F.lds + (unsigned)(HY_F + 8192 - 8 * i + 16 * g - 128 * dhi);
    const LAS uchar* pB = F.lds + (unsigned)(HY_V + ((8 * q + (i >> 3) + 7) * 8 + (i & 7)) * HY_VROW + 16 * g - 8 * HY_VROW * dhi);
    bf16x8 a0[4], a1[4], b0[4], b1[4];
#pragma unroll
    for (int r = 0; r < 4; ++r) { a0[r] = hy_lda(pA + r * (FIMG_LEN * 2)); b0[r] = *(const LAS bf16x8*)(pB + r * (16 * HY_VROW)); }
    for (int m = 0; m < 71; ++m) {
#pragma unroll
        for (int r = 0; r < 4; ++r) { a1[r] = hy_lda(pA + r * (FIMG_LEN * 2) + 64); b1[r] = *(const LAS bf16x8*)(pB + r * (16 * HY_VROW) + 64);
#pragma unroll
            for (int nt = 0; nt < 4; ++nt) acc[r][nt] = __builtin_amdgcn_mfma_f32_16x16x32_bf16(a0[r], b0[nt], acc[r][nt], 0, 0, 0);
            __builtin_amdgcn_sched_barrier(0); }
#pragma unroll
        for (int r = 0; r < 4; ++r) { a0[r] = hy_lda(pA + r * (FIMG_LEN * 2) + 128); b0[r] = *(const LAS bf16x8*)(pB + r * (16 * HY_VROW) + 8 * HY_VROW);
#pragma unroll
            for (int nt = 0; nt < 4; ++nt) acc[r][nt] = __builtin_amdgcn_mfma_f32_16x16x32_bf16(a1[r], b1[nt], acc[r][nt], 0, 0, 0);
            __builtin_amdgcn_sched_barrier(0); }
        pA += 128; pB += 8 * HY_VROW;
    }
}
__device__ __forceinline__ void conv8(const u32x4 u, float left, float right, float w0, float w1, float w2, float (&y)[8]) {
    float x[10]; x[0] = left; x[1] = bflo(u.x); x[2] = bfhi(u.x); x[3] = bflo(u.y); x[4] = bfhi(u.y); x[5] = bflo(u.z); x[6] = bfhi(u.z); x[7] = bflo(u.w); x[8] = bfhi(u.w); x[9] = right;
#pragma unroll
    for (int e = 0; e < 8; ++e) y[e] = w0 * x[e] + w1 * x[e + 1] + w2 * x[e + 2];
}
struct Run16 { u32x4 a, b; unsigned short l, r; };
__device__ __forceinline__ Run16 run16_load(const GAS bf16_t* p, int t) { Run16 x; x.a = *(const GAS u32x4*)(p + t); x.b = *(const GAS u32x4*)(p + t + 8); x.l = p[t > 0 ? t - 1 : t]; x.r = p[t + 16 < SEQ ? t + 16 : t]; return x; }
__device__ __forceinline__ void run16_conv(const Run16& x, int t, float w0, float w1, float w2, float (&y)[16]) {
    const float left = t > 0 ? bf2f(x.l) : 0.f, right = t + 16 < SEQ ? bf2f(x.r) : 0.f;
    float ya[8], yb[8];
    conv8(x.a, left, bflo(x.b.x), w0, w1, w2, ya); conv8(x.b, bfhi(x.a.w), right, w0, w1, w2, yb);
#pragma unroll
    for (int e = 0; e < 8; ++e) { y[e] = ya[e]; y[8 + e] = yb[e]; }
}
__device__ __forceinline__ void phase_hyena(Frame& F, int layer) {
    const GAS bf16_t* hy = (const GAS bf16_t*)(F.ws + WS_CHT);
    GAS bf16_t* yT = (GAS bf16_t*)(F.ws + WS_YT);
    const GAS bf16_t* fimg = (const GAS bf16_t*)(F.ws + WS_FIMG);
    const GAS float* hb = (const GAS float*)argp(11) + (size_t)layer * 2 * HW;
    const GAS float* cw = (const GAS float*)argp(3) + (size_t)layer * 3 * 1536;
    const int q = F.wave, n = F.lane & 15, g = F.lane >> 4;
    for (int c = F.bid; c < HW; c += F.G) {
        for (int i = F.tid; i < 112 * (HY_VROW / 16); i += NTHR) { const int r = i / (HY_VROW / 16), k = i % (HY_VROW / 16); const int row = r < 56 ? r : (71 * 8 + r - 56);
            *(LAS u32x4*)(F.lds + HY_V + row * HY_VROW + k * 16) = (u32x4){0u, 0u, 0u, 0u}; }
        { const float w0 = cw[1024 + c], w1 = cw[1536 + 1024 + c], w2 = cw[2 * 1536 + 1024 + c];
          int tl = F.tid; asm volatile("" : "+v"(tl));
          const int k = tl & 7, b = (tl >> 3) & 7, sq = tl >> 6;
          const GAS char* pc = (const GAS char*)(hy + (size_t)(1024 + c) * NTOK); asm volatile("" : "+s"(pc));
          const unsigned ob = (unsigned)(b * SEQ + k * 8) * 2u;
#pragma unroll
          for (int jb = 0; jb < 8; jb += 4) {
          u32x4 uu[4]; unsigned short ll[4], rr[4];
#pragma unroll
          for (int j = 0; j < 4; ++j) { const int t = (sq + 8 * (jb + j)) * 64 + k * 8; const unsigned o = ob + (unsigned)(sq + 8 * (jb + j)) * 128u;
              uu[j] = *(const GAS u32x4*)(pc + o); ll[j] = *(const GAS unsigned short*)(pc + (t > 0 ? o - 2u : o)); rr[j] = *(const GAS unsigned short*)(pc + (t + 8 < SEQ ? o + 16u : o)); }
          __builtin_amdgcn_sched_barrier(0);
#pragma unroll
          for (int j = 0; j < 4; ++j) { const int s1 = sq + 8 * (jb + j), t = s1 * 64 + k * 8, r = s1 * 8 + b;
            const float left = t > 0 ? bf2f(ll[j]) : 0.f, right = t + 8 < SEQ ? bf2f(rr[j]) : 0.f;
            float y[8]; conv8(uu[j], left, right, w0, w1, w2, y);
            *(LAS u32x4*)(F.lds + HY_V + (r + 56) * HY_VROW + k * 16) = (u32x4){pk2(y[0], y[1]), pk2(y[2], y[3]), pk2(y[4], y[5]), pk2(y[6], y[7])}; }
          __builtin_amdgcn_sched_barrier(0);
          } }
        hy_load_fimg(F, fimg + (size_t)(0 * 512 + c) * GIMG_LEN);
        __syncthreads();
        f32x4 acc[4][4];
        Run16 xr[4];
        { const int b = n & 7;
#pragma unroll
          for (int nt = 0; nt < 4; ++nt) xr[nt] = run16_load(hy + (size_t)c * NTOK + b * SEQ, (8 * q + 2 * nt + (n >> 3)) * 64 + 16 * g); }
        hy_conv(F, acc);
        __syncthreads();
        {
            const float bias = hb[c]; const int b = n & 7;
            const float w0 = cw[c], w1 = cw[1536 + c], w2 = cw[2 * 1536 + c];
#pragma unroll
            for (int nt = 0; nt < 4; ++nt) {
                const int t1 = 8 * q + 2 * nt + (n >> 3), t0 = 16 * g;
                LAS u32x4* vp = (LAS u32x4*)(F.lds + HY_V + ((t1 + 7) * 8 + b) * HY_VROW + t0 * 2);
                float xv[16]; run16_conv(xr[nt], t1 * 64 + t0, w0, w1, w2, xv);
                const u32x4 v0 = vp[0], v1 = vp[1];
                const unsigned vw[8] = {v0.x, v0.y, v0.z, v0.w, v1.x, v1.y, v1.z, v1.w};
                unsigned ow[8];
#pragma unroll
                for (int p = 0; p < 8; ++p) {
                    const int e0 = 2 * p, e1 = 2 * p + 1;
                    const float z0 = xv[e0] * (acc[e0 & 3][nt][e0 >> 2] + bias * bflo(vw[p]));
                    const float z1 = xv[e1] * (acc[e1 & 3][nt][e1 >> 2] + bias * bfhi(vw[p]));
                    ow[p] = pk2(z0, z1); }
                vp[0] = (u32x4){ow[0], ow[1], ow[2], ow[3]}; vp[1] = (u32x4){ow[4], ow[5], ow[6], ow[7]};
            }
        }
        hy_load_fimg(F, fimg + (size_t)(1 * 512 + c) * GIMG_LEN);
        { const int b = n & 7;
#pragma unroll
          for (int nt = 0; nt < 4; ++nt) xr[nt] = run16_load(hy + (size_t)(512 + c) * NTOK + b * SEQ, (8 * q + 2 * nt + (n >> 3)) * 64 + 16 * g); }
        __syncthreads();
        hy_conv(F, acc);
        {
            const float bias = hb[HW + c]; const int b = n & 7;
            const float w0 = cw[512 + c], w1 = cw[1536 + 512 + c], w2 = cw[2 * 1536 + 512 + c];
#pragma unroll
            for (int nt = 0; nt < 4; ++nt) {
                const int t1 = 8 * q + 2 * nt + (n >> 3), t0 = 16 * g;
                const LAS u32x4* vp = (const LAS u32x4*)(F.lds + HY_V + ((t1 + 7) * 8 + b) * HY_VROW + t0 * 2);
                float xv[16]; run16_conv(xr[nt], t1 * 64 + t0, w0, w1, w2, xv);
                GAS u32x4* op = (GAS u32x4*)(yT + (size_t)c * NTOK + b * SEQ + t1 * 64 + t0);
                const u32x4 v0 = vp[0], v1 = vp[1];
                const unsigned vw[8] = {v0.x, v0.y, v0.z, v0.w, v1.x, v1.y, v1.z, v1.w};
                unsigned ow[8];
#pragma unroll
                for (int p = 0; p < 8; ++p) {
                    const int e0 = 2 * p, e1 = 2 * p + 1;
                    const float z0 = xv[e0] * (acc[e0 & 3][nt][e0 >> 2] + bias * bflo(vw[p]));
                    const float z1 = xv[e1] * (acc[e1 & 3][nt][e1 >> 2] + bias * bfhi(vw[p]));
                    ow[p] = pk2(z0, z1); }
                op[0] = (u32x4){ow[0], ow[1], ow[2], ow[3]}; op[1] = (u32x4){ow[4], ow[5], ow[6], ow[7]};
            }
        }
        __syncthreads();
    }
}

constexpr int AK_SLOT = 16384, AV_BASE = 65536, AV_SLOT = 16384;
constexpr int AT_X = 0, AT_XROW = 132 * 4, AT_Y = 4 * 32 * AT_XROW, AT_YROW = 272;
constexpr int AT_OFS = 131072;
static_assert(AT_Y + 128 * AT_YROW <= AT_OFS && AV_BASE + 4 * AV_SLOT <= AT_OFS && AT_OFS + 512 * 16 <= LDS_MISC, "attn LDS");
#define AT_SBAR() __builtin_amdgcn_sched_barrier(0)
#define AT_PIN(x) asm volatile("" : "+v"(x))
#define AT_MFMA(a_, b_, c_) __builtin_amdgcn_mfma_f32_32x32x16_bf16(a_, b_, c_, 0, 0, 0)
#define AT_LDK(slot_, mt_, kk_) (*(const LAS bf16x8*)(pk[kk_] + ((slot_) * AK_SLOT + (mt_) * 8192)))
#define AT_LDV(slot_, ks_, mv_) (*(const LAS bf16x8*)(pv[ks_] + ((slot_) * AV_SLOT + (mv_) * 4096)))
#define AT_QTR(SRC, SP, DST, KK0, CIN, KF0, KF1, VF0, VF1, VF2, VF3, PP, PC, NK0, NK1, NKS, NKM, NKK, NV0, NV1, NV2, NV3, NVS, NVK) do { \
        float e0_, e1_, e2_, e3_, e4_, e5_, e6_, e7_; unsigned w0_, w1_, w2_, w3_; \
        DST = AT_MFMA(KF0, qf[KK0], CIN); NK0 = AT_LDK(NKS, NKM, NKK); \
        e0_ = __builtin_amdgcn_exp2f(SRC[8 * (SP)]); e1_ = __builtin_amdgcn_exp2f(SRC[8 * (SP) + 1]); AT_PIN(e0_); AT_PIN(e1_); AT_SBAR(); \
        DST = AT_MFMA(KF1, qf[(KK0) + 1], DST); NK1 = AT_LDK(NKS, NKM, (NKK) + 1); \
        e2_ = __builtin_amdgcn_exp2f(SRC[8 * (SP) + 2]); e3_ = __builtin_amdgcn_exp2f(SRC[8 * (SP) + 3]); lsum += e0_; lsum += e1_; AT_PIN(e2_); AT_PIN(e3_); AT_PIN(lsum); AT_SBAR(); \
        o[0] = AT_MFMA(VF0, PP, o[0]); NV0 = AT_LDV(NVS, NVK, 0); \
        e4_ = __builtin_amdgcn_exp2f(SRC[8 * (SP) + 4]); e5_ = __builtin_amdgcn_exp2f(SRC[8 * (SP) + 5]); lsum += e2_; lsum += e3_; AT_PIN(e4_); AT_PIN(e5_); AT_PIN(lsum); AT_SBAR(); \
        o[1] = AT_MFMA(VF1, PP, o[1]); NV1 = AT_LDV(NVS, NVK, 1); \
        e6_ = __builtin_amdgcn_exp2f(SRC[8 * (SP) + 6]); e7_ = __builtin_amdgcn_exp2f(SRC[8 * (SP) + 7]); lsum += e4_; lsum += e5_; AT_PIN(e6_); AT_PIN(e7_); AT_PIN(lsum); AT_SBAR(); \
        o[2] = AT_MFMA(VF2, PP, o[2]); NV2 = AT_LDV(NVS, NVK, 2); \
        w0_ = pk2(e0_, e1_); w1_ = pk2(e2_, e3_); lsum += e6_; lsum += e7_; AT_PIN(w0_); AT_PIN(w1_); AT_PIN(lsum); AT_SBAR(); \
        o[3] = AT_MFMA(VF3, PP, o[3]); NV3 = AT_LDV(NVS, NVK, 3); \
        w2_ = pk2(e4_, e5_); w3_ = pk2(e6_, e7_); AT_PIN(w2_); AT_PIN(w3_); AT_SBAR(); \
        PC = __builtin_bit_cast(bf16x8, (u32x4){w0_, w1_, w2_, w3_}); } while (0)

__device__ __forceinline__ void phase_attn(Frame& F, int layer) {
    const GAS bf16_t* qk = (const GAS bf16_t*)(F.ws + WS_QK); const GAS bf16_t* vT = (const GAS bf16_t*)(F.ws + WS_CHT) + (size_t)1536 * NTOK;
    GAS bf16_t* ya = (GAS bf16_t*)(F.ws + WS_YCAT) + 512;
    const float lambda_init = 0.8f - 0.6f * fast_exp(-0.3f * (float)layer);
    float lam;
    {
        const GAS float* q1 = (const GAS float*)argp(14) + layer * HD; const GAS float* k1 = (const GAS float*)argp(15) + layer * HD; const GAS float* q2 = (const GAS float*)argp(16) + layer * HD; const GAS float* k2 = (const GAS float*)argp(17) + layer * HD;
        float s1 = 0.f, s2 = 0.f;
        for (int i = 0; i < HD; ++i) { s1 += q1[i] * k1[i]; s2 += q2[i] * k2[i]; }
        lam = fast_exp(s1) - fast_exp(s2) + lambda_init;
    }
    const GAS float* subg = (const GAS float*)argp(18) + layer * DV;
    const int w = F.wave, comp = w >> 2, qs = w & 3, i = F.lane & 31, hh = F.lane >> 5;
    const int pi_i = i ^ ((((i >> 2) ^ (i >> 3)) & 1) * 12);
    {
        u32x4 ofs;
        { const int key0 = 8 * w + (F.lane >> 4), key1 = key0 + 4; ofs.x = (unsigned)(key0 * 2048 + (((F.lane & 15) ^ (key0 & 15)) << 4)); ofs.y = (unsigned)(key1 * 2048 + (((F.lane & 15) ^ (key1 & 15)) << 4));
          const int dv0 = 16 * w + (F.lane >> 3), dv1 = dv0 + 8; ofs.z = (unsigned)dv0 * (unsigned)(NTOK * 2) + (unsigned)((((F.lane & 7) ^ ((dv0 >> 1) & 7))) << 4); ofs.w = (unsigned)dv1 * (unsigned)(NTOK * 2) + (unsigned)((((F.lane & 7) ^ ((dv1 >> 1) & 7))) << 4); }
        *(LAS u32x4*)(F.lds + AT_OFS + F.tid * 16) = ofs;
    }
    const LAS uchar* pk[4]; const LAS uchar* pv[4];
#pragma unroll
    for (int kk = 0; kk < 4; ++kk) { const int ch = comp * 8 + 2 * kk + hh; pk[kk] = F.lds + (unsigned)(pi_i * 256 + ((ch ^ (pi_i & 15)) << 4)); }
#pragma unroll
    for (int ks = 0; ks < 4; ++ks) { const int cv = 2 * ks + hh; pv[ks] = F.lds + (unsigned)(AV_BASE + i * 128 + ((cv ^ ((i >> 1) & 7)) << 4)); }
    const f32x16 negMv = {0.f, 0.f, 0.f, 0.f, 0.f, 0.f, 0.f, 0.f, 0.f, 0.f, 0.f, 0.f, 0.f, 0.f, 0.f, 0.f};
#define AT_ISSUE_KV(tk_, tv_) do { const int tk2_ = (tk_) < 64 ? (tk_) : 63, tv2_ = (tv_) < 64 ? (tv_) : 63; \
        const GAS char* kb_ = kbase + (size_t)tk2_ * 131072; const GAS char* vb_ = vbase + (size_t)tv2_ * 128; asm volatile("" : "+s"(kb_), "+s"(vb_));     \
        __builtin_amdgcn_global_load_lds((const GAS unsigned*)(kb_ + ofs.x), (LAS unsigned*)(F.lds + ((tk_) & 3) * AK_SLOT + (2 * w) * 1024), 16, 0, 0); \
        __builtin_amdgcn_global_load_lds((const GAS unsigned*)(kb_ + ofs.y), (LAS unsigned*)(F.lds + ((tk_) & 3) * AK_SLOT + (2 * w + 1) * 1024), 16, 0, 0); \
        __builtin_amdgcn_global_load_lds((const GAS unsigned*)(vb_ + ofs.z), (LAS unsigned*)(F.lds + AV_BASE + ((tv_) & 3) * AV_SLOT + (2 * w) * 1024), 16, 0, 0); \
        __builtin_amdgcn_global_load_lds((const GAS unsigned*)(vb_ + ofs.w), (LAS unsigned*)(F.lds + AV_BASE + ((tv_) & 3) * AV_SLOT + (2 * w + 1) * 1024), 16, 0, 0); } while (0)
#define AT_LOAD_OFS() (ofs = *(const LAS u32x4*)(F.lds + AT_OFS + F.tid * 16))
#define AT_ISSUE_K(t_) do { const int tt_ = (t_) < 64 ? (t_) : 63; const u32x2 ofs_ = *(const LAS u32x2*)(F.lds + AT_OFS + F.tid * 16); \
        __builtin_amdgcn_global_load_lds((const GAS unsigned*)(kbase + (size_t)tt_ * 131072 + ofs_.x), (LAS unsigned*)(F.lds + ((t_) & 3) * AK_SLOT + (2 * w) * 1024), 16, 0, 0); \
        __builtin_amdgcn_global_load_lds((const GAS unsigned*)(kbase + (size_t)tt_ * 131072 + ofs_.y), (LAS unsigned*)(F.lds + ((t_) & 3) * AK_SLOT + (2 * w + 1) * 1024), 16, 0, 0); } while (0)
#define AT_ISSUE_V(t_) do { const int tt_ = (t_) < 64 ? (t_) : 63; const u32x2 ofs_ = *(const LAS u32x2*)(F.lds + AT_OFS + F.tid * 16 + 8); \
        __builtin_amdgcn_global_load_lds((const GAS unsigned*)(vbase + (size_t)tt_ * 128 + ofs_.x), (LAS unsigned*)(F.lds + AV_BASE + ((t_) & 3) * AV_SLOT + (2 * w) * 1024), 16, 0, 0); \
        __builtin_amdgcn_global_load_lds((const GAS unsigned*)(vbase + (size_t)tt_ * 128 + ofs_.y), (LAS unsigned*)(F.lds + AV_BASE + ((t_) & 3) * AV_SLOT + (2 * w + 1) * 1024), 16, 0, 0); } while (0)
#define AT_TILE(t_, S_, N_) do { \
        if ((t_) > 0) { asm volatile("s_waitcnt vmcnt(4)\n\ts_barrier" ::: "memory"); } \
        AT_ISSUE_KV((t_) + 3, (t_) + 2); \
          \
        AT_QTR(sA, 0, sB, 0, negMv, kx0, kx1, vx0, vx1, vx2, vx3, pp, pc, ky0, ky1, S_, 1, 2, vy0, vy1, vy2, vy3, S_, 0); \
          \
        AT_QTR(sA, 1, sB, 2, sB, ky0, ky1, vy0, vy1, vy2, vy3, pc, pp, kx0, kx1, N_, 0, 0, vx0, vx1, vx2, vx3, S_, 1); \
          \
        AT_QTR(sB, 0, sA, 0, negMv, kx0, kx1, vx0, vx1, vx2, vx3, pp, pc, ky0, ky1, N_, 0, 2, vy0, vy1, vy2, vy3, S_, 2); \
          \
        AT_QTR(sB, 1, sA, 2, sA, ky0, ky1, vy0, vy1, vy2, vy3, pc, pp, kx0, kx1, N_, 1, 0, vx0, vx1, vx2, vx3, S_, 3); \
        AT_LOAD_OFS();        \
    } while (0)
    for (int r = 0; r < 4; ++r) {
        int bh, qb;
        if (F.G == 256) { bh = (F.bid & 7) + 8 * r; qb = F.bid >> 3; }
        else { const int u = F.bid + r * F.G; if (u >= 1024) break; bh = u >> 5; qb = u & 31; }
        const int b = bh >> 2, h = bh & 3;
        const size_t row0 = (size_t)b * SEQ;
        const GAS char* kbase = (const GAS char*)(qk + row0 * 1024 + 512 + h * 128);
        const GAS char* vbase = (const GAS char*)(vT + (size_t)(h * 128) * NTOK + row0);
        AT_ISSUE_K(0); AT_ISSUE_K(1); AT_ISSUE_V(0); AT_ISSUE_K(2); AT_ISSUE_V(1);
        bf16x8 qf[4];
        { const GAS bf16_t* qp = qk + (row0 + qb * 128 + qs * 32 + i) * 1024 + h * 128 + comp * 64 + 8 * hh;
#pragma unroll
          for (int kk = 0; kk < 4; ++kk) qf[kk] = *(const GAS bf16x8*)(qp + 16 * kk); }
        f32x16 o[4];
#pragma unroll
        for (int m = 0; m < 4; ++m)
#pragma unroll
            for (int e = 0; e < 16; ++e) o[m][e] = 0.f;
        float lsum = 0.f;
        asm volatile("s_waitcnt vmcnt(0)\n\ts_barrier" ::: "memory");
        f32x16 sA, sB;
        bf16x8 kx0, kx1, vx0, vx1, vx2, vx3, ky0, ky1, vy0, vy1, vy2, vy3, pp, pc;
        sA = negMv;
#pragma unroll
        for (int kk = 0; kk < 4; ++kk) sA = AT_MFMA(AT_LDK(0, 0, kk), qf[kk], sA);
        kx0 = AT_LDK(0, 1, 0); kx1 = AT_LDK(0, 1, 1);
        vx0 = AT_LDV(0, 3, 0); vx1 = AT_LDV(0, 3, 1); vx2 = AT_LDV(0, 3, 2); vx3 = AT_LDV(0, 3, 3);
        pp = (bf16x8){0, 0, 0, 0, 0, 0, 0, 0}; pc = pp; sB = negMv;
        u32x4 ofs; AT_LOAD_OFS();
        for (int t = 0; t < 64; t += 4) {
            AT_TILE(t, 0, 1); AT_TILE(t + 1, 1, 2); AT_TILE(t + 2, 2, 3); AT_TILE(t + 3, 3, 0);
        }
        o[0] = AT_MFMA(vx0, pp, o[0]); o[1] = AT_MFMA(vx1, pp, o[1]); o[2] = AT_MFMA(vx2, pp, o[2]); o[3] = AT_MFMA(vx3, pp, o[3]);
        asm volatile("s_waitcnt vmcnt(0)\n\ts_barrier" ::: "memory");
        const float ltot = lsum + xor32(lsum);
        const float inv = (comp ? lam : 1.0f) * __builtin_amdgcn_rcpf(ltot);
        if (comp == 1) {
#pragma unroll
            for (int mv = 0; mv < 4; ++mv)
#pragma unroll
                for (int g = 0; g < 4; ++g) { const int dv = 32 * mv + 8 * g + 4 * hh;
                    *(LAS f32x4*)(F.lds + AT_X + (qs * 32 + i) * AT_XROW + dv * 4) = (f32x4){o[mv][4 * g] * inv, o[mv][4 * g + 1] * inv, o[mv][4 * g + 2] * inv, o[mv][4 * g + 3] * inv}; }
        }
        __syncthreads();
        if (comp == 0) {
            float ss = 0.f;
#pragma unroll
            for (int mv = 0; mv < 4; ++mv)
#pragma unroll
                for (int g = 0; g < 4; ++g) { const int dv = 32 * mv + 8 * g + 4 * hh;
                    const f32x4 x = *(const LAS f32x4*)(F.lds + AT_X + (qs * 32 + i) * AT_XROW + dv * 4);
#pragma unroll
                    for (int j = 0; j < 4; ++j) { const float v = o[mv][4 * g + j] * inv - x[j]; o[mv][4 * g + j] = v; ss += v * v; } }
            ss += xor32(ss);
            const float rn = (1.0f - lambda_init) * __builtin_amdgcn_rsqf(ss * (1.0f / DV) + RMS_EPS);
#pragma unroll
            for (int mv = 0; mv < 4; ++mv)
#pragma unroll
                for (int g = 0; g < 4; ++g) { const int dv = 32 * mv + 8 * g + 4 * hh; const f32x4 gg = *(const GAS f32x4*)(subg + dv);
                    u32x2 wv; wv.x = pk2(o[mv][4 * g] * rn * gg.x, o[mv][4 * g + 1] * rn * gg.y); wv.y = pk2(o[mv][4 * g + 2] * rn * gg.z, o[mv][4 * g + 3] * rn * gg.w);
                    *(LAS u32x2*)(F.lds + AT_Y + (qs * 32 + i) * AT_YROW + dv * 2) = wv; }
        }
        __syncthreads();
#pragma unroll
        for (int p2 = 0; p2 < 4; ++p2) { const int p = F.tid + 512 * p2, qq = p >> 4, c8 = p & 15;
            *(GAS u32x4*)(ya + (row0 + qb * 128 + qq) * 1024 + h * 128 + c8 * 8) = *(const LAS u32x4*)(F.lds + AT_Y + qq * AT_YROW + c8 * 16); }
        __syncthreads();
    }
#undef AT_ISSUE_K
#undef AT_ISSUE_KV
#undef AT_LOAD_OFS
#undef AT_ISSUE_V
#undef AT_TILE
}
template <bool F8> __device__ __forceinline__ void phase_norm_router(Frame& F, const bf16_t* x, const float* g, typename OutT<F8>::t* h2) {
    const GAS float* wr = (const GAS float*)argp(26);
    GAS int* topi = (GAS int*)(F.ws + WS_TOPI); GAS float* topw = (GAS float*)(F.ws + WS_TOPW); GAS int* counts = (GAS int*)(F.ws + WS_COUNTS);
    LAS int* hist = (LAS int*)(F.lds + 65536);
    for (int rb = F.bid; rb < 256; rb += F.G) {
        if (F.tid < 8) hist[F.tid] = 0;
        __syncthreads();
        int ln = F.lane; asm volatile("" : "+v"(ln));
        f32x4 wreg[2][8][2], gg[2][2];
#pragma unroll
        for (int j = 0; j < 2; ++j) { gg[j][0] = ((const GAS f32x4*)g)[2 * ln + 128 * j]; gg[j][1] = ((const GAS f32x4*)g)[2 * ln + 128 * j + 1];
#pragma unroll
            for (int t = 0; t < 8; ++t) { const GAS f32x4* wp = (const GAS f32x4*)(wr + (size_t)(512 * j + 8 * ln + t) * 8); wreg[j][t][0] = wp[0]; wreg[j][t][1] = wp[1]; } }
        const bool b0 = (ln & 1) != 0, b1 = (ln & 2) != 0, b2 = (ln & 4) != 0;
        const int m0 = rb * 128 + F.wave * 16;
        u32x4 nx[2];
#pragma unroll
        for (int j = 0; j < 2; ++j) nx[j] = ((const GAS u32x4*)(x + (size_t)m0 * XR_LD) + ln)[64 * j];
#pragma clang loop unroll(disable)
        for (int rr = 0; rr < 16; ++rr) {
            const int m = m0 + rr, mn = m + (rr < 15 ? 1 : 0);
            const u32x4 cw[2] = {nx[0], nx[1]};
#pragma unroll
            for (int j = 0; j < 2; ++j) nx[j] = ((const GAS u32x4*)(x + (size_t)mn * XR_LD) + ln)[64 * j];
            float v[2][8]; float s = 0.f;
#pragma unroll
            for (int j = 0; j < 2; ++j) { const u32x4 w = cw[j]; v[j][0] = bflo(w.x); v[j][1] = bfhi(w.x); v[j][2] = bflo(w.y); v[j][3] = bfhi(w.y); v[j][4] = bflo(w.z); v[j][5] = bfhi(w.z); v[j][6] = bflo(w.w); v[j][7] = bfhi(w.w);
#pragma unroll
                for (int e = 0; e < 8; ++e) s += v[j][e] * v[j][e]; }
            const float r = __builtin_amdgcn_rsqf(wave_sum(s) * (1.0f / DM) + RMS_EPS);
            float lg[8];
#pragma unroll
            for (int e = 0; e < 8; ++e) lg[e] = 0.f;
            typename OutT<F8>::t* o8 = h2 + (size_t)m * (F8 ? P8 : DM);
#pragma unroll
            for (int j = 0; j < 2; ++j) { const f32x4 ga = gg[j][0], gb = gg[j][1]; float hv[8];
                hv[0] = v[j][0] * r * ga.x; hv[1] = v[j][1] * r * ga.y; hv[2] = v[j][2] * r * ga.z; hv[3] = v[j][3] * r * ga.w; hv[4] = v[j][4] * r * gb.x; hv[5] = v[j][5] * r * gb.y; hv[6] = v[j][6] * r * gb.z; hv[7] = v[j][7] * r * gb.w;
                if constexpr (F8) ((GAS u32x2*)o8 + ln)[64 * j] = (u32x2){pk4_f8(clamp_f8(hv[0] * F8_SH), clamp_f8(hv[1] * F8_SH), clamp_f8(hv[2] * F8_SH), clamp_f8(hv[3] * F8_SH)), pk4_f8(clamp_f8(hv[4] * F8_SH), clamp_f8(hv[5] * F8_SH), clamp_f8(hv[6] * F8_SH), clamp_f8(hv[7] * F8_SH))};
                else ((GAS u32x4*)o8 + ln)[64 * j] = (u32x4){pk2(hv[0], hv[1]), pk2(hv[2], hv[3]), pk2(hv[4], hv[5]), pk2(hv[6], hv[7])};
#pragma unroll
                for (int t = 0; t < 8; ++t) { const f32x4 wa = wreg[j][t][0], wb = wreg[j][t][1]; const float hx = hv[t];
                    lg[0] += hx * wa.x; lg[1] += hx * wa.y; lg[2] += hx * wa.z; lg[3] += hx * wa.w; lg[4] += hx * wb.x; lg[5] += hx * wb.y; lg[6] += hx * wb.z; lg[7] += hx * wb.w; } }
            float q4[4], q2[2], q1;
#pragma unroll
            for (int i = 0; i < 4; ++i) { const float keep = b0 ? lg[i + 4] : lg[i], send = b0 ? lg[i] : lg[i + 4]; q4[i] = keep + xor_swz<1>(send); }
#pragma unroll
            for (int i = 0; i < 2; ++i) { const float keep = b1 ? q4[i + 2] : q4[i], send = b1 ? q4[i] : q4[i + 2]; q2[i] = keep + xor_swz<2>(send); }
            { const float keep = b2 ? q2[1] : q2[0], send = b2 ? q2[0] : q2[1]; q1 = keep + xor_swz<4>(send); }
            q1 += xor_swz<8>(q1); q1 += xor_swz<16>(q1); q1 += xor32(q1);
#pragma unroll
            for (int e = 0; e < 8; ++e) lg[e] = __builtin_bit_cast(float, __builtin_amdgcn_readlane(__builtin_bit_cast(int, q1), ((e >> 2) & 1) | (((e >> 1) & 1) << 1) | ((e & 1) << 2)));
            int i0 = 0; float v0 = lg[0];
#pragma unroll
            for (int e = 1; e < 8; ++e) if (lg[e] > v0) { v0 = lg[e]; i0 = e; }
            int i1 = -1; float v1 = -3.0e38f;
#pragma unroll
            for (int e = 0; e < 8; ++e) if (e != i0 && lg[e] > v1) { v1 = lg[e]; i1 = e; }
            if (ln == 0) { const float e1 = fast_exp(v1 - v0), w0 = __builtin_amdgcn_rcpf(1.0f + e1);
                topi[2 * m] = i0; topi[2 * m + 1] = i1; topw[2 * m] = w0; topw[2 * m + 1] = e1 * w0;
                atomicAdd((int*)&hist[i0], 1); atomicAdd((int*)&hist[i1], 1); }
        }
        __syncthreads();
        if (F.tid < 8) counts[rb * 8 + F.tid] = hist[F.tid];
        __syncthreads();
    }
    GAS int* tokof = (GAS int*)(F.ws + WS_TOKOF);
    for (int i = F.bid * NTHR + F.tid; i < PSLOTS; i += F.G * NTHR) tokof[i] = -1;
}
constexpr int MOE_TAB = 140000, MOE_TOKL = 144 * 1024;
static_assert(MOE_TOKL + 12 * 1024 <= LDS_MISC, "moe lds");
__device__ __forceinline__ void moe_tables(Frame& F) {
    const GAS int* counts = (const GAS int*)(F.ws + WS_COUNTS);
    LAS int* tab = (LAS int*)(F.lds + MOE_TAB);
    __syncthreads();
    if (F.tid < 8) tab[F.tid] = 0;
    __syncthreads();
    for (int i = F.tid; i < 2048; i += NTHR) atomicAdd((int*)&tab[i & 7], counts[i]);
    __syncthreads();
    if (F.tid == 0) { int off = 0; for (int e = 0; e < 8; ++e) { tab[8 + e] = off; const int np = (tab[e] + 255) >> 8; for (int p = 0; p < np; ++p) tab[32 + (off >> 8) + p] = e; off += np << 8; } tab[16] = off >> 8; }
    __syncthreads();
}
__device__ __forceinline__ void phase_moe_assign(Frame& F) {
    const GAS int* counts = (const GAS int*)(F.ws + WS_COUNTS); const GAS int* topi = (const GAS int*)(F.ws + WS_TOPI);
    GAS int* slotof = (GAS int*)(F.ws + WS_SLOT); GAS int* tokof = (GAS int*)(F.ws + WS_TOKOF);
    moe_tables(F);
    LAS int* tab = (LAS int*)(F.lds + MOE_TAB);
    LAS int* sc = (LAS int*)(F.lds + 65536);
    for (int rb = F.bid; rb < 256; rb += F.G) {
        if (F.tid < 8) sc[F.tid] = tab[8 + F.tid];
        __syncthreads();
        for (int i2 = F.tid; i2 < rb * 8; i2 += NTHR) atomicAdd((int*)&sc[i2 & 7], counts[i2]);
        int e = -1, rank = 0;
        if (F.tid < 256) { e = topi[rb * 256 + F.tid];
            for (int ee = 0; ee < 8; ++ee) { const unsigned long long mk = __ballot(e == ee); if (e == ee) rank = __popcll(mk & ((1ull << F.lane) - 1ull)); if (F.lane == 0) sc[8 + F.wave * 8 + ee] = __popcll(mk); } }
        __syncthreads();
        if (F.tid < 256) { int pre = 0; for (int w2 = 0; w2 < F.wave; ++w2) pre += sc[8 + w2 * 8 + e];
            const int slot = sc[e] + pre + rank; const int tok = rb * 128 + (F.tid >> 1);
            slotof[rb * 256 + F.tid] = slot; tokof[slot] = tok; }
        __syncthreads();
    }
}
constexpr int REM_SLOT0 = 256 * 256;
__device__ __forceinline__ void phase_moe_combine(Frame& F, int bid0) {
    const GAS int* slotof = (const GAS int*)(F.ws + WS_SLOT); const GAS float* topw = (const GAS float*)(F.ws + WS_TOPW); const GAS bf16_t* yp = (const GAS bf16_t*)(F.ws + WS_XP);
    const int gw = (F.bid - bid0) * NWAVES + F.wave, NGW = (F.G - bid0) * NWAVES;
    int sa0, sa1; float wa0, wa1;
    u32x4 x0, x1, a0, a1, b0, b1; float w0 = 0.f, w1 = 0.f;
#define CMB_A(tok_) do { const int t_ = (tok_) < NTOK ? (tok_) : NTOK - 1; sa0 = slotof[2 * t_]; sa1 = slotof[2 * t_ + 1]; wa0 = topw[2 * t_]; wa1 = topw[2 * t_ + 1]; } while (0)
#define CMB_B(tok_) do { const int t_ = (tok_) < NTOK ? (tok_) : NTOK - 1; const int r0 = sa0 < REM_SLOT0 ? sa0 : 0, r1 = sa1 < REM_SLOT0 ? sa1 : 0;        \
        w0 = sa0 < REM_SLOT0 ? wa0 : 0.f; w1 = sa1 < REM_SLOT0 ? wa1 : 0.f; \
        const GAS u32x4* xp = (const GAS u32x4*)((const GAS bf16_t*)F.out + (size_t)t_ * XR_LD) + 2 * F.lane;       \
        const GAS u32x4* ap = (const GAS u32x4*)(yp + (size_t)r0 * DM) + 2 * F.lane; const GAS u32x4* bp = (const GAS u32x4*)(yp + (size_t)r1 * DM) + 2 * F.lane; \
        x0 = xp[0]; x1 = xp[1]; a0 = ap[0]; a1 = ap[1]; b0 = bp[0]; b1 = bp[1]; } while (0)
    if (gw >= NTOK) return;
    CMB_A(gw); CMB_B(gw); CMB_A(gw + NGW);
    for (int tok = gw; tok < NTOK; tok += NGW) {
        const unsigned xw[8] = {x0.x, x0.y, x0.z, x0.w, x1.x, x1.y, x1.z, x1.w}, aw[8] = {a0.x, a0.y, a0.z, a0.w, a1.x, a1.y, a1.z, a1.w}, bw[8] = {b0.x, b0.y, b0.z, b0.w, b1.x, b1.y, b1.z, b1.w};
        float o[16];
#pragma unroll
        for (int p = 0; p < 8; ++p) { o[2 * p] = bflo(xw[p]) + w0 * bflo(aw[p]) + w1 * bflo(bw[p]); o[2 * p + 1] = bfhi(xw[p]) + w0 * bfhi(aw[p]) + w1 * bfhi(bw[p]); }
        __builtin_amdgcn_sched_barrier(0);
        CMB_B(tok + NGW);
        CMB_A(tok + 2 * NGW);
        __builtin_amdgcn_sched_barrier(0);
        GAS f32x4* op = (GAS f32x4*)(F.out + (size_t)tok * DM) + 4 * F.lane;
#pragma unroll
        for (int p = 0; p < 4; ++p) op[p] = (f32x4){o[4 * p], o[4 * p + 1], o[4 * p + 2], o[4 * p + 3]};
    }
#undef CMB_A
#undef CMB_B
}
__device__ __forceinline__ void phase_moe_fixup(Frame& F, int np) {
    const GAS int* slotof = (const GAS int*)(F.ws + WS_SLOT); const GAS int* tokof = (const GAS int*)(F.ws + WS_TOKOF); const GAS float* topw = (const GAS float*)(F.ws + WS_TOPW); const GAS bf16_t* yp = (const GAS bf16_t*)(F.ws + WS_XP);
    const int gw = F.bid * NWAVES + F.wave, NGW = F.G * NWAVES;
    for (int s = REM_SLOT0 + gw; s < np * 256; s += NGW) {
        const int tok = tokof[s]; if (tok < 0) continue;
        const int sa = slotof[2 * tok], sb = slotof[2 * tok + 1]; const int k = (sa == s) ? 0 : 1; const int other = k ? sa : sb;
        if (other >= REM_SLOT0 && other < s) continue;
        const float wk = topw[2 * tok + k], wo = other >= REM_SLOT0 ? topw[2 * tok + 1 - k] : 0.f; const int ro = other >= REM_SLOT0 ? other : s;
        const GAS u32x4* ap = (const GAS u32x4*)(yp + (size_t)s * DM) + 2 * F.lane; const GAS u32x4* bp = (const GAS u32x4*)(yp + (size_t)ro * DM) + 2 * F.lane;
        const u32x4 a0 = ap[0], a1 = ap[1], b0 = bp[0], b1 = bp[1];
        const unsigned aw[8] = {a0.x, a0.y, a0.z, a0.w, a1.x, a1.y, a1.z, a1.w}, bw[8] = {b0.x, b0.y, b0.z, b0.w, b1.x, b1.y, b1.z, b1.w};
        GAS f32x4* op = (GAS f32x4*)(F.out + (size_t)tok * DM) + 4 * F.lane;
#pragma unroll
        for (int p = 0; p < 4; ++p) { f32x4 o = op[p];
            o.x += wk * bflo(aw[2 * p]) + wo * bflo(bw[2 * p]); o.y += wk * bfhi(aw[2 * p]) + wo * bfhi(bw[2 * p]); o.z += wk * bflo(aw[2 * p + 1]) + wo * bflo(bw[2 * p + 1]); o.w += wk * bfhi(aw[2 * p + 1]) + wo * bfhi(bw[2 * p + 1]);
            op[p] = o; }
    }
}
constexpr int NPL = 16, NPHASE = 2 * NPL;
constexpr bool F8M = FP8_MOE != 0;
constexpr int MOE_DMK = F8M ? DM / 2 : DM, MOE_FFK = F8M ? FFP / 2 : FFP, MOE_EB = F8M ? 1 : 2;
constexpr int INP = I8_INPROJ ? 2 : 0;
constexpr int DUP = I8_DENSE_UP ? 2 : (FP8_DENSE ? 1 : 0);
constexpr bool DDN8 = FP8_DENSE != 0;
constexpr int INP_DMK = INP ? DM / 2 : DM, DUP_DMK = DUP ? DM / 2 : DM, DDN_FFK = DDN8 ? FFP / 2 : FFP;
static_assert(!(I8_INPROJ || I8_DENSE_UP) || FP8_MOE, "the int8 weights live where the bf16 MoE activations would end");
typedef OutT<F8M>::t moe_t; typedef OutT<(DUP == 1)>::t dgu_t; typedef OutT<DDN8>::t ddn_t;
struct Args { const float* in[30]; float* out; uchar* ws; int ph_lo, ph_hi, li, use_bar; };

__global__ void __launch_bounds__(NTHR, 2) mk_fwd(Args args) {
    extern __shared__ __attribute__((aligned(16))) uchar lds_raw[];
    Frame F;
    F.lds = (LAS uchar*)lds_raw;
    F.tid = threadIdx.x; F.lane = F.tid & 63; F.wave = __builtin_amdgcn_readfirstlane(F.tid >> 6);
    const int wave_s = F.wave;
    F.G = gridDim.x; F.bid = blockIdx.x;
    F.ws = args.ws; F.ctl = (unsigned*)(args.ws + WS_CTL); F.out = args.out;
    volatile LAS unsigned* misc = (volatile LAS unsigned*)(F.lds + LDS_MISC);
    if (F.tid < 64) misc[F.tid] = 0u;
    __syncthreads();
    XcdBarrier bar; bar.bar = F.ctl + CW_BAR + args.li * XCD_BAR_WORDS; bar.x = 0; bar.st = misc + 8;
    if (args.use_bar) bar = xcd_barrier_post(F.ctl + CW_BAR + args.li * XCD_BAR_WORDS, misc + 8);
    const int lo = args.ph_lo, hi = args.ph_hi;
    bool started = false;
#define PH_BEGIN(id) if (lo <= (id) && (id) < hi) { if (started) xcd_barrier(bar); started = true; \
    { int ws_ = wave_s; asm volatile("" : "+s"(ws_)); int ln_; asm volatile("v_mbcnt_lo_u32_b32 %0, -1, 0\n\tv_mbcnt_hi_u32_b32 %0, -1, %0" : "=v"(ln_));     F.lane = ln_; F.wave = ws_; F.tid = ws_ * 64 + ln_; \
      int b_ = blockIdx.x, g_ = gridDim.x; uchar* w_ = args.ws; float* o_ = args.out; asm volatile("" : "+s"(b_), "+s"(g_), "+s"(w_), "+s"(o_)); ASSUME_GLOBAL(w_); ASSUME_GLOBAL(o_); F.bid = b_; F.G = g_; F.ws = w_; F.out = o_; F.ctl = (unsigned*)w_; }
#define PH_END }
#define RELOAD_ID() do { int ws_ = wave_s; asm volatile("" : "+s"(ws_)); int ln_; asm volatile("v_mbcnt_lo_u32_b32 %0, -1, 0\n\tv_mbcnt_hi_u32_b32 %0, -1, %0" : "=v"(ln_));     F.lane = ln_; F.wave = ws_; F.tid = ws_ * 64 + ln_; } while (0)
#ifndef REP_ID
#define REP_ID -1
#endif
#ifndef REP_N
#define REP_N 1
#endif
#define REPEAT(id) RELOAD_ID(); for (int rep_ = 0; rep_ < ((id) == REP_ID ? REP_N : 1); ++rep_)
#define SITE(id, ...) { RELOAD_ID(); __VA_ARGS__ } if (REP_ID >= 0 && REP_ID == (id)) { { __VA_ARGS__ } { __VA_ARGS__ } }
#if DBG_CHECKS
#define CHK(x) x
#else
#define CHK(x)
#endif

    for (int layer = 0; layer < 2; ++layer) {
        const int pb = layer * NPL;
#define WSM (F.ws + WS_WSMALL + (size_t)layer * WSMALL_STRIDE)
#define WtokT ((bf16_t*)(WSM + OFF_WTOK))
#define WchT ((bf16_t*)(WSM + OFF_WCH))
#define PhT ((bf16_t*)(WSM + OFF_PH))
#define PaT ((bf16_t*)(WSM + OFF_PA))
#define WoutT ((bf16_t*)(WSM + OFF_WOUT))
#define hbuf ((bf16_t*)(F.ws + WS_H))
#define XR ((bf16_t*)F.out)
        const bool moe = (layer & 1) != 0;

        PH_BEGIN(pb + 0)
            CHK(if (layer == 1) chk_dense_down(F, 12); xcd_barrier(bar);)
            if (layer == 0) {
                for (int l2 = 0; l2 < 2; ++l2) { uchar* w2 = F.ws + WS_WSMALL + (size_t)l2 * WSMALL_STRIDE;
                    conv_win(F, argp(2) + (size_t)l2 * DM * INW, (bf16_t*)(w2 + OFF_WTOK), (bf16_t*)(w2 + OFF_WCH));
                    conv_plain(F, argp(19) + (size_t)l2 * HW * DM, HW, DM, (bf16_t*)(w2 + OFF_PH), DM);
                    conv_plain(F, argp(20) + (size_t)l2 * HW * DM, HW, DM, (bf16_t*)(w2 + OFF_PH) + HW, DM);
                    conv_plain(F, argp(21) + (size_t)l2 * DM * DM, DM, DM, (bf16_t*)(w2 + OFF_WOUT), DM); }
                conv_ffn<(DUP == 1), DDN8>(F, argp(23), argp(24), argp(25), (dgu_t*)(F.ws + WS_WGU), (ddn_t*)(F.ws + WS_WD), 1);
                rope_tables(F);
            }
            if (layer == 0) phase_norm<INP>(F, argp(0), argp(1) + layer * DM, (OutT<(INP != 0)>::t*)(F.ws + WS_H), (float*)(F.ws + WS_SH));
            else phase_norm_bf<INP>(F, XR, argp(1) + layer * DM, (OutT<(INP != 0)>::t*)(F.ws + WS_H), (float*)(F.ws + WS_SH));
            phase_hdn(F, layer);
        PH_END
        if (layer == 0 && (INP == 2 || DUP == 2)) {
            PH_BEGIN(pb + 1)
                if (INP == 2) for (int l2 = 0; l2 < 2; ++l2) { uchar* w2 = F.ws + WS_WSMALL + (size_t)l2 * WSMALL_STRIDE;
                    quant_rows(F, (const bf16_t*)(w2 + OFF_WTOK), F.ws + WS_I8W + l2 * I8W_LAYER, (float*)(F.ws + WS_SW) + l2 * SW_LAYER, 3072);
                    quant_rows(F, (const bf16_t*)(w2 + OFF_WCH), F.ws + WS_I8W + l2 * I8W_LAYER + I8W_CH, (float*)(F.ws + WS_SW) + l2 * SW_LAYER + 3072, 2048); }
                if (DUP == 2) quant_rows(F, (const bf16_t*)(F.ws + WS_WGU), F.ws + WS_I8W + I8W_DENSE, (float*)(F.ws + WS_SW) + SW_DENSE, 5632);
            PH_END
        }
        PH_BEGIN(pb + 2)
            CHK(if (layer == 0) chk_norm(F, argp(0), argp(1) + layer * DM, hbuf, layer * 13 + 1); xcd_barrier(bar);)
            SITE(pb + 1, const bf16_t* wtk = INP == 2 ? (const bf16_t*)(F.ws + WS_I8W + layer * I8W_LAYER) : WtokT; const float* sw = (const float*)(F.ws + WS_SW) + layer * SW_LAYER;
              pg8::Gemm g{hbuf, wtk, NTOK, 3072, INP_DMK, INP == 2 ? P8 : 0, INP == 2 ? P8 : 0}; pg8::StaticOrder S; S.init(NTOK, 3072, F.G, F.bid);
              pg8::EpiTok<INP> E{(bf16_t*)(F.ws + WS_QK), (uchar*)(F.ws + WS_GATES), argp(12) + layer * HD, argp(13) + layer * HD, (const bf16_t*)(F.ws + WS_ROPE), (const bf16_t*)(F.ws + WS_ROPE) + SEQ * 32, (const float*)(F.ws + WS_SH), sw};
              pg8::gemm_phase(F.lds, g, S, E, F.tid);)
            SITE(300 + pb + 1, const bf16_t* wch = INP == 2 ? (const bf16_t*)(F.ws + WS_I8W + layer * I8W_LAYER + I8W_CH) : WchT; const float* sw = (const float*)(F.ws + WS_SW) + layer * SW_LAYER + 3072;
              pg8::Gemm g{wch, hbuf, 2048, NTOK, INP_DMK, INP == 2 ? P8 : 0, INP == 2 ? P8 : 0}; pg8::StaticOrder S; S.init(2048, NTOK, F.G, F.bid);
              pg8::EpiBf16<INP> E{(bf16_t*)(F.ws + WS_CHT), NTOK, 0, 1.0f, sw, (const float*)(F.ws + WS_SH)};
              pg8::gemm_phase(F.lds, g, S, E, F.tid);)
            REPEAT(pb + 2) phase_fimg(F, layer);
        PH_END
        PH_BEGIN(pb + 3)
            CHK(chk_inproj(F, layer, layer * 13 + 2); chk_qkprep(F, layer, layer * 13 + 3); chk_fimg(F, layer, layer * 13 + 5); xcd_barrier(bar);)
            REPEAT(100 + pb + 3) phase_hyena(F, layer);
            REPEAT(200 + pb + 3) phase_attn(F, layer);
        PH_END
        PH_BEGIN(pb + 4)
            CHK(chk_hyena(F, layer, layer * 13 + 6); chk_attn(F, layer, layer * 13 + 7); xcd_barrier(bar);)
            REPEAT(pb + 4) phase_transpose_y(F);
        PH_END
        PH_BEGIN(pb + 5)
            CHK(chk_transpose(F, layer * 13 + 8); xcd_barrier(bar);)
            SITE(pb + 5, pg8::Gemm g{(const bf16_t*)(F.ws + WS_YCAT), PhT, NTOK, DM, DM}; pg8::StaticOrder S; S.init(NTOK, DM, F.G, F.bid);
              pg8::EpiMergeF E{(bf16_t*)(F.ws + WS_MERGED), (const uchar*)(F.ws + WS_GATES)};
              pg8::gemm_phase(F.lds, g, S, E, F.tid);)
        PH_END
        PH_BEGIN(pb + 6)
            CHK(chk_merge(F, layer, layer * 13 + 9); xcd_barrier(bar);)
            SITE(pb + 6, pg8::Gemm g{(const bf16_t*)(F.ws + WS_MERGED), WoutT, NTOK, DM, DM}; pg8::StaticOrder S; S.init(NTOK, DM, F.G, F.bid);
              if (layer == 0) { pg8::EpiRes<true> E{argp(0), XR, 1.0f}; pg8::gemm_phase(F.lds, g, S, E, F.tid); }
              else { pg8::EpiRes<false> E{nullptr, XR, 1.0f}; pg8::gemm_phase(F.lds, g, S, E, F.tid); })
        PH_END
        PH_BEGIN(pb + 7)
            CHK(if (layer == 0) chk_outproj(F, layer, 10); xcd_barrier(bar);)
            if (!moe) phase_norm_bf<DUP>(F, XR, argp(22) + layer * DM, (OutT<(DUP != 0)>::t*)(F.ws + WS_H), (float*)(F.ws + WS_SH));
            else {
                phase_norm_router<F8M>(F, XR, argp(22) + layer * DM, (moe_t*)(F.ws + WS_H2_MOE));
                REPEAT(pb + 7) conv_ffn<F8M>(F, argp(27), argp(28), argp(29), (moe_t*)(F.ws + WS_MOE_WGU), (moe_t*)(F.ws + WS_MOE_WD), NEXP);
            }
        PH_END
        if (!moe) {
            PH_BEGIN(pb + 9)
                SITE(pb + 9, pg8::Gemm g{hbuf, (const bf16_t*)(F.ws + (DUP == 2 ? WS_I8W + I8W_DENSE : WS_WGU)), NTOK, 5632, DUP_DMK, DUP == 2 ? P8 : 0, DUP == 2 ? P8 : 0}; pg8::StaticOrder S; S.init(NTOK, 5632, F.G, F.bid);
                  pg8::EpiSwiglu<DUP, DDN8> E{(bf16_t*)(F.ws + WS_ACT_DENSE), 0, (const float*)(F.ws + WS_SH), (const float*)(F.ws + WS_SW) + SW_DENSE};
                  pg8::gemm_phase(F.lds, g, S, E, F.tid);)
            PH_END
            PH_BEGIN(pb + 10)
                CHK(chk_dense_up(F, 11); xcd_barrier(bar);)
                { pg8::Gemm g{(const bf16_t*)(F.ws + WS_ACT_DENSE), (const bf16_t*)(F.ws + WS_WD), NTOK, DM, DDN_FFK}; pg8::StaticOrder S; S.init(NTOK, DM, F.G, F.bid);
                  pg8::EpiRes<false, DDN8> E{nullptr, XR, F8_DN_INV};
                  pg8::gemm_phase(F.lds, g, S, E, F.tid); }
            PH_END
        } else {
            PH_BEGIN(pb + 8)
                CHK(chk_router(F, 13 + 11); xcd_barrier(bar);)
                phase_moe_assign(F);
            PH_END
            for (int chunk = 0; chunk < 2; ++chunk) {
                PH_BEGIN(pb + 9 + 2 * chunk)
                    moe_tables(F);
                    CHK(if (chunk == 0) chk_assign(F, 13 + 12); xcd_barrier(bar);)
                    SITE(pb + 9 + 2 * chunk, const LAS int* tab = (const LAS int*)(F.lds + MOE_TAB); const int p0 = chunk * 128;
                      pg8::Gemm g{(const bf16_t*)(F.ws + WS_H2_MOE), (const bf16_t*)(F.ws + WS_MOE_WGU), 128 * 256, 5632, MOE_DMK, F8M ? P8 : 0, F8M ? P8 : 0};
                      pg8::MoeGatherOrder S; S.init(128 * 256, 5632, F.G, F.bid); S.p0 = p0; S.pexp = tab + 32; S.estride = F8M ? (long)5632 * P8 : (long)5632 * DM * 2; S.tokof = (const int*)(F.ws + WS_TOKOF); S.fill_tokl((LAS int*)(F.lds + MOE_TOKL), F.tid);
                      pg8::EpiSwiglu<(F8M ? 1 : 0), F8M> E{(bf16_t*)(F.ws + WS_ACT_MOE), p0, nullptr, nullptr};
                      pg8::gemm_phase(F.lds, g, S, E, F.tid);)
                    if (chunk == 1) {
                      SITE(pb + 14, const LAS int* tab = (const LAS int*)(F.lds + MOE_TAB); const int np = tab[16], nm = np - 256;
                        pg8::Gemm g{(const bf16_t*)(F.ws + WS_H2_MOE), (const bf16_t*)(F.ws + WS_MOE_WGU), nm * 256, 5632, MOE_DMK, F8M ? P8 : 0, F8M ? P8 : 0};
                        pg8::MoeGatherOrder S; S.init(nm * 256, 5632, F.G, F.bid); S.p0 = 256; S.pexp = tab + 32; S.estride = F8M ? (long)5632 * P8 : (long)5632 * DM * 2; S.tokof = (const int*)(F.ws + WS_TOKOF); S.fill_tokl((LAS int*)(F.lds + MOE_TOKL), F.tid);
                        pg8::EpiSwiglu<(F8M ? 1 : 0), F8M> E{(bf16_t*)(F.ws + WS_ACT_MOE), 128, nullptr, nullptr};
                        pg8::gemm_phase(F.lds, g, S, E, F.tid);)
                    }
                PH_END
                PH_BEGIN(pb + 10 + 2 * chunk)
                    moe_tables(F);
                    SITE(pb + 10 + 2 * chunk, const LAS int* tab = (const LAS int*)(F.lds + MOE_TAB); const int p0 = chunk * 128;
                      pg8::Gemm g{(const bf16_t*)(F.ws + WS_ACT_MOE) - (size_t)p0 * 256 * MOE_FFK, (const bf16_t*)(F.ws + WS_MOE_WD), 128 * 256, DM, MOE_FFK};
                      pg8::MoeOrder S; S.init(128 * 256, DM, F.G, F.bid); S.p0 = p0; S.pexp = tab + 32; S.estride = (long)DM * FFP * MOE_EB;
                      pg8::EpiBf16<(F8M ? 1 : 0)> E{(bf16_t*)(F.ws + WS_XP), DM, 0, F8_DN_INV, nullptr, nullptr};
                      pg8::gemm_phase(F.lds, g, S, E, F.tid);)
                PH_END
            }
            PH_BEGIN(pb + 13)
                CHK(chk_moe_ffn(F, 13 + 13); xcd_barrier(bar);)
                moe_tables(F);
                if (F.G >= 64 && F.bid < 32) {
                    SITE(pb + 13, const LAS int* tab = (const LAS int*)(F.lds + MOE_TAB); const int np = tab[16], nm = np - 256;
                      pg8::Gemm g{(const bf16_t*)(F.ws + WS_ACT_MOE) - (size_t)128 * 256 * MOE_FFK, (const bf16_t*)(F.ws + WS_MOE_WD), nm * 256, DM, MOE_FFK};
                      pg8::MoeOrder S; S.init(nm * 256, DM, 32, F.bid); S.p0 = 256; S.pexp = tab + 32; S.estride = (long)DM * FFP * MOE_EB;
                      pg8::EpiBf16<(F8M ? 1 : 0)> E{(bf16_t*)(F.ws + WS_XP), DM, 0, F8_DN_INV, nullptr, nullptr};
                      pg8::gemm_phase(F.lds, g, S, E, F.tid);)
                } else if (F.G >= 64) phase_moe_combine(F, 32);
                else {
                    { const LAS int* tab = (const LAS int*)(F.lds + MOE_TAB); const int np = tab[16], nm = np - 256;
                      pg8::Gemm g{(const bf16_t*)(F.ws + WS_ACT_MOE) - (size_t)128 * 256 * MOE_FFK, (const bf16_t*)(F.ws + WS_MOE_WD), nm * 256, DM, MOE_FFK};
                      pg8::MoeOrder S; S.init(nm * 256, DM, F.G, F.bid); S.p0 = 256; S.pexp = tab + 32; S.estride = (long)DM * FFP * MOE_EB;
                      pg8::EpiBf16<(F8M ? 1 : 0)> E{(bf16_t*)(F.ws + WS_XP), DM, 0, F8_DN_INV, nullptr, nullptr};
                      pg8::gemm_phase(F.lds, g, S, E, F.tid); }
                    phase_moe_combine(F, 0);
                }
            PH_END
            PH_BEGIN(pb + 15)
                moe_tables(F);
                { const LAS int* tab = (const LAS int*)(F.lds + MOE_TAB); phase_moe_fixup(F, tab[16]); }
            PH_END
        }
    }
#if DBG_CHECKS
    if (hi == NPHASE) { if (started) xcd_barrier(bar); dbg_report(F); }
#endif
#undef PH_BEGIN
#undef PH_END
#undef WSM
#undef WtokT
#undef WchT
#undef PhT
#undef PaT
#undef WoutT
#undef hbuf
#undef XR
}

#ifndef MK_SPLIT
#define MK_SPLIT 0
#endif
extern "C" void kernel_launch(void* const* d_in, const int* in_sizes, int n_in, void* d_out, int out_size, void* d_ws, size_t ws_size, hipStream_t stream) {
    static int grid = 0;
    if (grid == 0) {
        if (n_in != 30 || out_size != NTOK * DM || ws_size < WS_NEED) { fprintf(stderr, "kernel_launch: unexpected sizes n_in %d out %d ws %zu\n", n_in, out_size, ws_size); grid = -1; return; }
        int dev = 0, cus = 0, per_cu = 0;
        if (hipGetDevice(&dev) != hipSuccess || hipDeviceGetAttribute(&cus, hipDeviceAttributeMultiprocessorCount, dev) != hipSuccess) { grid = -1; return; }
        if (hipFuncSetAttribute((const void*)mk_fwd, hipFuncAttributeMaxDynamicSharedMemorySize, LDS_BYTES) != hipSuccess) { fprintf(stderr, "kernel_launch: hipFuncSetAttribute failed\n"); grid = -1; return; }
        if (hipOccupancyMaxActiveBlocksPerMultiprocessor(&per_cu, (const void*)mk_fwd, NTHR, LDS_BYTES) != hipSuccess || per_cu < 1) { fprintf(stderr, "kernel_launch: occupancy query says %d\n", per_cu); }
        (void)hipGetLastError();
        grid = cus;
    }
    if (grid < 0) return;
    (void)hipMemsetAsync((char*)d_ws + WS_CTL, 0, CTL_ZERO_BYTES, stream);
    Args a{};
    for (int i = 0; i < 30; ++i) a.in[i] = (const float*)d_in[i];
    a.out = (float*)d_out; a.ws = (uchar*)d_ws;
#if MK_SPLIT
    int li = 0;
    for (int p = 0; p < NPHASE; ++p) { a.ph_lo = p; a.ph_hi = p + 1; a.li = 0; a.use_bar = 0; (void)li;
        hipLaunchKernelGGL(mk_fwd, dim3(grid), dim3(NTHR), LDS_BYTES, stream, a); }
#else
    a.ph_lo = 0; a.ph_hi = NPHASE; a.li = 0; a.use_bar = 1;
    hipLaunchKernelGGL(mk_fwd, dim3(grid), dim3(NTHR), LDS_BYTES, stream, a);
#endif
}
```

```cpp
#include <hip/hip_runtime.h>
#include <cstdio>
#include <cstdint>

#define GAS __attribute__((address_space(1)))
#define LAS __attribute__((address_space(3)))
typedef unsigned short bf16_t;
typedef unsigned char uchar;
typedef short bf16x8 __attribute__((ext_vector_type(8)));
typedef short bf16x4 __attribute__((ext_vector_type(4)));
typedef float f32x2 __attribute__((ext_vector_type(2)));
typedef float f32x4 __attribute__((ext_vector_type(4)));
typedef float f32x16 __attribute__((ext_vector_type(16)));
typedef unsigned u32x4 __attribute__((ext_vector_type(4)));
typedef unsigned u32x2 __attribute__((ext_vector_type(2)));

#if defined(__HIP_DEVICE_COMPILE__)
#define ASSUME_GLOBAL(p) __builtin_assume(!__builtin_amdgcn_is_shared((const __attribute__((address_space(0))) void*)(p)) && !__builtin_amdgcn_is_private((const __attribute__((address_space(0))) void*)(p)))
#else
#define ASSUME_GLOBAL(p) ((void)0)
#endif
#ifndef DBG_CHECKS
#define DBG_CHECKS 0
#endif

constexpr int NB = 8, SEQ = 4096, DM = 1024, NTOK = NB * SEQ;
constexpr int HW = 512, INW = 5120, NHEAD = 4, HD = 64, DV = 128;
constexpr int DFF = 2752, FFP = 2816, NEXP = 8;
constexpr int FEMB = 33, FHID = 64;
constexpr int XR_LD = 2048;
constexpr int NPANEL_MAX = 264, PSLOTS = NPANEL_MAX * 256;
constexpr float RMS_EPS = 1e-6f;
constexpr int NWAVES = 8, NTHR = 512;
constexpr int FIMG_LEN = 8200, FIMG_BYTES = 4 * FIMG_LEN * 2;
constexpr int GIMG_LEN = 8320;

constexpr size_t MiB = 1u << 20, KiB = 1u << 10;
constexpr size_t WS_CTL = 0, CTL_ZERO_BYTES = 256 * KiB;
constexpr size_t WS_COUNTS = 512 * KiB;
constexpr size_t WS_ROPE = 1 * MiB;
constexpr size_t WS_HDN = 2 * MiB;
constexpr size_t WS_TOPI = 4 * MiB, WS_TOPW = WS_TOPI + 256 * KiB, WS_SLOT = WS_TOPW + 256 * KiB, WS_TOKOF = WS_SLOT + 256 * KiB;
constexpr size_t WS_WSMALL = 6 * MiB, WSMALL_STRIDE = 14 * MiB;
constexpr size_t OFF_WTOK = 0, OFF_WCH = 6 * MiB, OFF_PH = 10 * MiB, OFF_PA = 11 * MiB, OFF_WOUT = 12 * MiB;
constexpr size_t WS_WGU = 34 * MiB, WS_WD = 45 * MiB;
constexpr size_t WS_H = 51 * MiB;
constexpr size_t WS_YCAT = 51 * MiB, WS_YT = 452 * MiB;
constexpr size_t WS_QK = 115 * MiB;
constexpr size_t WS_GATES = 179 * MiB;
constexpr size_t WS_CHT = 307 * MiB;
constexpr size_t WS_MERGED = 307 * MiB;
constexpr size_t WS_FIMG = 435 * MiB;
constexpr size_t WS_ACT_DENSE = 115 * MiB;
constexpr size_t WS_MOE_WGU = 51 * MiB, WS_MOE_WD = 139 * MiB;
constexpr size_t WS_XP = 183 * MiB;
constexpr size_t WS_ACT_MOE = 315 * MiB;
constexpr size_t WS_H2_MOE = 251 * MiB;
constexpr size_t WS_SH = 5 * MiB + 512 * KiB;
constexpr size_t WS_SW = 5 * MiB + 640 * KiB;
constexpr size_t WS_I8W = 484 * MiB;
constexpr int SW_LAYER = 5120, SW_DENSE = 2 * SW_LAYER;
constexpr int P8 = 1152;
constexpr size_t I8W_LAYER = 6 * MiB, I8W_CH = 3 * MiB + 512 * KiB, I8W_DENSE = 2 * I8W_LAYER;
static_assert((size_t)3072 * P8 <= I8W_CH && I8W_CH + (size_t)2048 * P8 <= I8W_LAYER && WS_I8W + I8W_DENSE + (size_t)5632 * P8 <= 512 * MiB && WS_SW + (size_t)(SW_DENSE + 5632) * 4 <= 6 * MiB, "int8 weights / scales");
constexpr size_t WS_NEED = 512 * MiB;
static_assert(WS_FIMG + (size_t)2 * 512 * GIMG_LEN * 2 <= 512 * MiB, "fimg");
static_assert(WS_ACT_MOE + (size_t)136 * 256 * FFP * 2 <= 512 * MiB, "act moe");
static_assert(WS_MOE_WD + (size_t)8 * 1024 * FFP * 2 <= WS_XP, "moe wd");

constexpr int CW_DBG = 64;
constexpr int CW_BAR = 4096;

constexpr int LDS_BYTES = 163840;
constexpr int LDS_MISC = 160 * 1024 - 256;

__device__ __forceinline__ unsigned f2bf(float f) { unsigned u = __builtin_bit_cast(unsigned, f); return (u + 0x7fffu + ((u >> 16) & 1u)) >> 16; }
typedef __bf16 bf16x2v __attribute__((ext_vector_type(2)));
__device__ __forceinline__ unsigned pk2(float lo, float hi) { const f32x2 v = {lo, hi}; return __builtin_bit_cast(unsigned, __builtin_convertvector(v, bf16x2v)); }
__device__ __forceinline__ float bf2f(unsigned short b) { return __builtin_bit_cast(float, ((unsigned)b) << 16); }
__device__ __forceinline__ float bflo(unsigned w) { return __builtin_bit_cast(float, w << 16); }
__device__ __forceinline__ float bfhi(unsigned w) { return __builtin_bit_cast(float, w & 0xffff0000u); }
template <int M> __device__ __forceinline__ float xor_swz(float v) { return __builtin_bit_cast(float, __builtin_amdgcn_ds_swizzle(__builtin_bit_cast(int, v), (M << 10) | 0x1f)); }
__device__ __forceinline__ float xor32(float v) { const unsigned u = __builtin_bit_cast(unsigned, v);
    const auto r = __builtin_amdgcn_permlane32_swap(u, u, false, false);
    return __builtin_bit_cast(float, r[0] ^ r[1] ^ u); }
__device__ __forceinline__ float wave_sum(float v) {
    v += xor_swz<1>(v); v += xor_swz<2>(v); v += xor_swz<4>(v); v += xor_swz<8>(v); v += xor_swz<16>(v); v += xor32(v);
    return v;
}
__device__ __forceinline__ float fast_sin(float x) { return __builtin_amdgcn_sinf(x * 0.15915494309f); }
__device__ __forceinline__ float sin_rev(float r) { return __builtin_amdgcn_sinf(__builtin_amdgcn_fractf(r)); }
__device__ __forceinline__ float cos_rev(float r) { return __builtin_amdgcn_cosf(__builtin_amdgcn_fractf(r)); }
__device__ __forceinline__ float fast_exp(float x) { return __builtin_amdgcn_exp2f(x * 1.44269504089f); }
__device__ __forceinline__ float fast_sigmoid(float x) { return __builtin_amdgcn_rcpf(1.0f + __builtin_amdgcn_exp2f(-1.44269504089f * x)); }
#ifndef FP8_MOE
#define FP8_MOE 1
#endif
#ifndef FP8_DENSE
#define FP8_DENSE 0
#endif
typedef int i32x4 __attribute__((ext_vector_type(4)));
typedef int i32x8 __attribute__((ext_vector_type(8)));
constexpr float F8_SH = 16.0f, F8_SWGU = 64.0f, F8_SACT = 8.0f, F8_SWD = 128.0f;
constexpr float F8_UP_INV = 1.0f / (F8_SH * F8_SWGU), F8_DN_INV = 1.0f / (F8_SACT * F8_SWD);
__device__ __forceinline__ unsigned pk4_f8(float a, float b, float c, float d) { const int w = __builtin_amdgcn_cvt_pk_fp8_f32(a, b, 0, false); return (unsigned)__builtin_amdgcn_cvt_pk_fp8_f32(c, d, w, true); }
__device__ __forceinline__ float clamp_f8(float x) { return __builtin_amdgcn_fmed3f(x, -448.0f, 448.0f); }
__device__ __forceinline__ void mfma_f8(f32x4& c, const i32x8 a, const i32x8 b) { asm volatile("v_mfma_f32_16x16x128_f8f6f4 %0, %1, %2, %0" : "+v"(c) : "v"(a), "v"(b)); }
#define F8_ACC_SETTLE() asm volatile("s_nop 15\n\ts_nop 15" ::: "memory")
#ifndef I8_INPROJ
#define I8_INPROJ 1
#endif
#ifndef I8_DENSE_UP
#define I8_DENSE_UP 1
#endif
__device__ __forceinline__ float wave_max(float v) {
    v = fmaxf(v, xor_swz<1>(v)); v = fmaxf(v, xor_swz<2>(v)); v = fmaxf(v, xor_swz<4>(v)); v = fmaxf(v, xor_swz<8>(v)); v = fmaxf(v, xor_swz<16>(v)); v = fmaxf(v, xor32(v));
    return v;
}
__device__ __forceinline__ unsigned pk4_i8(float a, float b, float c, float d) {
    const int ia = (int)__builtin_rintf(a), ib = (int)__builtin_rintf(b), ic = (int)__builtin_rintf(c), id = (int)__builtin_rintf(d);
    return ((unsigned)ia & 255u) | (((unsigned)ib & 255u) << 8) | (((unsigned)ic & 255u) << 16) | ((unsigned)id << 24);
}
template <bool F8> struct OutT { typedef bf16_t t; };
template <> struct OutT<true> { typedef uchar t; };

#define XB_TMO      128
#define XB_XCNT(j)  (256  + 64 * (j))
#define XB_XSUB(j)  (1280 + 64 * (j))
#define XB_XGEN(j)  (2304 + 64 * (j))
#define XB_TOP      3328
#define XB_TOPGEN   3392
#define XCD_BAR_WORDS 3456
#define XB_SPIN_CAP (1u << 18)

__device__ __forceinline__ unsigned xb_ld(unsigned* p)              { return __hip_atomic_load(p, __ATOMIC_RELAXED, __HIP_MEMORY_SCOPE_AGENT); }
__device__ __forceinline__ unsigned xb_add(unsigned* p, unsigned v) { return __hip_atomic_fetch_add(p, v, __ATOMIC_RELAXED, __HIP_MEMORY_SCOPE_AGENT); }
__device__ __forceinline__ unsigned xb_xcc_id() { return (unsigned)__builtin_amdgcn_s_getreg((3 << 11) | 20) & 0xFu; }
#define XB_SPIN(cond, bar) do { unsigned _sp = 0; while (cond) { __builtin_amdgcn_s_sleep(1); \
    if ((++_sp & 255u) == 0u) { if (xb_ld(&(bar)[XB_TMO])) break; if (_sp > XB_SPIN_CAP) { atomicAdd(&(bar)[XB_TMO], 1u); break; } } } } while (0)

struct XcdBarrier {
    unsigned* bar; unsigned x;
    volatile LAS unsigned* st;
};

__device__ __forceinline__ XcdBarrier xcd_barrier_post(unsigned* bar, volatile LAS unsigned* st) {
    XcdBarrier b; b.bar = bar; b.x = xb_xcc_id(); b.st = st;
    if (threadIdx.x == 0) (void)xb_add(&bar[XB_XCNT(b.x)], 1u);
    return b;
}
__device__ __forceinline__ void xcd_barrier_complete(unsigned* bar, unsigned x, unsigned& nloc, unsigned& nx) {
    const unsigned G = gridDim.x * gridDim.y * gridDim.z;
    unsigned sum, cnt, mine, sp = 0u;
    for (;;) {
        sum = 0u; cnt = 0u; mine = 0u;
#pragma unroll
        for (unsigned j = 0; j < 16; ++j) { const unsigned c = xb_ld(&bar[XB_XCNT(j)]); sum += c; cnt += (c > 0u) ? 1u : 0u; mine = (j == x) ? c : mine; }
        if (sum == G) break;
        __builtin_amdgcn_s_sleep(1);
        if ((++sp & 255u) == 0u) { if (xb_ld(&bar[XB_TMO])) break; if (sp > XB_SPIN_CAP) { atomicAdd(&bar[XB_TMO], 1u); break; } }
    }
    nloc = mine > 0u ? mine : 1u; nx = cnt > 0u ? cnt : 1u;
}

__device__ __forceinline__ void xcd_barrier(const XcdBarrier& b) {
    asm volatile("s_waitcnt vmcnt(0)" ::: "memory");
    __syncthreads();
    if (threadIdx.x == 0) {
        unsigned* bar = b.bar;
        __builtin_amdgcn_s_waitcnt(0);
        unsigned nloc = b.st[0], nx = b.st[1];
        if (nloc == 0u) { xcd_barrier_complete(bar, b.x, nloc, nx); b.st[0] = nloc; b.st[1] = nx; }
        const unsigned old = xb_add(&bar[XB_XSUB(b.x)], 1u);
        const unsigned gen = old / nloc;
        if (old + 1u == (gen + 1u) * nloc) {
            __builtin_amdgcn_fence(__ATOMIC_RELEASE, "agent");
            asm volatile("s_waitcnt vmcnt(0)" ::: "memory");
            const unsigned og = xb_add(&bar[XB_TOP], 1u);
            const unsigned tg = og / nx;
            if (og + 1u == (tg + 1u) * nx) xb_add(&bar[XB_TOPGEN], 1u);
            else XB_SPIN(xb_ld(&bar[XB_TOPGEN]) == tg, bar);
            __builtin_amdgcn_fence(__ATOMIC_ACQUIRE, "agent");
            xb_add(&bar[XB_XGEN(b.x)], 1u);
            asm volatile("s_waitcnt vmcnt(0)" ::: "memory");
        } else {
            XB_SPIN(xb_ld(&bar[XB_XGEN(b.x)]) == gen, bar);
            __builtin_amdgcn_fence(__ATOMIC_ACQUIRE, "agent");
            asm volatile("s_waitcnt vmcnt(0)" ::: "memory");
        }
    }
    __syncthreads();
}

namespace pg8 {
constexpr int BM = 256, BK = 64, HALF = 128, HTB = HALF * BK * 2  , STAGE_BYTES = 8 * HTB, NXCD = 8, WGM = 8;
__host__ __device__ __forceinline__ int lds_byte(int r, int c) { const int st = (r >> 4) * 2 + (c >> 5), rr = r & 15, cc = c & 31, ob = rr * 64 + cc * 2; return st * 1024 + (ob ^ (((ob >> 9) & 1) << 5)); }
__host__ __device__ __forceinline__ void stage_rc(int b, int& R, int& C) { const int st = b / 1024, sb = b % 1024, swz = sb ^ (((sb >> 9) & 1) << 5); R = (st >> 1) * 16 + swz / 64; C = (st & 1) * 32 + (swz % 64) / 2; }
__host__ __device__ __forceinline__ int perm32(int rho) { const int n = rho >> 4, i = rho & 15; return 8 * (i >> 2) + 4 * n + (i & 3); }

struct Unit { int pm, pn; long boff; };
struct Gemm { const bf16_t* A; const bf16_t* Bt; int M, N, K; int lda = 0, ldb = 0; };

struct StaticOrder {
    static constexpr bool GATHER = false;
    int nM, nN, nwg, G, c;
    __device__ void init(int M, int N, int G_, int c_) { nM = M / BM; nN = N / BM; nwg = nM * nN; G = G_; c = c_; }
    __device__ bool next(int i, Unit& u) const {
        const long L = (long)i * G + c; if (L >= nwg) return false;
        int wgid = (int)L; { const int q = nwg / NXCD, r = nwg % NXCD, xcd = wgid % NXCD, off = wgid / NXCD; wgid = (xcd < r ? xcd * (q + 1) : r * (q + 1) + (xcd - r) * q) + off; }
        const int nig = WGM * nN, gid = wgid / nig, fm = gid * WGM, gsz = (nM - fm) < WGM ? (nM - fm) : WGM;
        u.pm = fm + ((wgid % nig) % gsz); u.pn = (wgid % nig) / gsz; u.boff = 0; return true;
    }
};
struct MoeOrder : StaticOrder {
    int p0; const LAS int* pexp; long estride;
    __device__ bool next(int i, Unit& u) const { if (!StaticOrder::next(i, u)) return false; u.pm += p0; u.boff = (long)pexp[u.pm] * estride; return true; }
};

struct MoeGatherOrder : MoeOrder {
    static constexpr bool GATHER = true;
    const int* tokof;
    const LAS int* tokl;
    __device__ __forceinline__ unsigned rowtok(int li, int r) const { return (unsigned)tokl[li * 256 + r]; }
    __device__ __forceinline__ void fill_tokl(LAS int* dst, int tid) { Unit u; for (int i = 0; next(i, u); ++i) if (tid < 256) { const int t = ((const GAS int*)tokof)[u.pm * BM + tid]; dst[i * 256 + tid] = t < 0 ? 0 : t; }
        tokl = dst; __syncthreads(); }
};

template <class Epi, class Sched>
__device__ __forceinline__ void gemm_phase(LAS unsigned char* lds, const Gemm g, const Sched& S, const Epi& E, const int tid) {
    const int wid = __builtin_amdgcn_readfirstlane(tid >> 6), lane = tid & 63, wr = wid >> 2, wc = wid & 3, fr = lane & 15, fq = lane >> 4;
    const int K = g.K, nt = K / BK, lda = g.lda ? g.lda : 2 * K, ldb = g.ldb ? g.ldb : 2 * K;
    unsigned voffA[2], voffB[2];
#pragma unroll
    for (int i = 0; i < 2; ++i) { int R, C; stage_rc(tid * 16 + i * 8192, R, C); const int Rb = Epi::PERM ? ((R & ~31) + perm32(R & 31)) : R;
        voffA[i] = (unsigned)(R * lda + C * 2); voffB[i] = (unsigned)(Rb * ldb + C * 2); }
    const size_t kstep = (size_t)(BK * 2);
    const size_t hstepA = (size_t)HALF * lda, hstepB = (size_t)HALF * ldb;
    const size_t tstepA = 2 * hstepA, tstepB = 2 * hstepB;
    const unsigned ldsw = (unsigned)wid * 1024u;
    const int aoff = lds_byte(wr * 64 + fr, fq * 8), boff = lds_byte(wc * 32 + fr, fq * 8);
#define PG8_SA(b, h) (((b) * 2 + (h)) * HTB)
#define PG8_SB(b, h) ((4 + (b) * 2 + (h)) * HTB)
#define PG8_STAGE(bufoff, gbase, voff) do { const char* gb_ = (const char*)(gbase); if constexpr (Epi::FP8) asm volatile("" : "+s"(gb_));     \
        _Pragma("unroll") for (int _i = 0; _i < 2; ++_i) \
        __builtin_amdgcn_global_load_lds((const unsigned*)(gb_ + (voff)[_i]), (LAS unsigned*)(lds + (bufoff) + ldsw + _i * 8192), 16, 0, 0); } while (0)
#define PG8_LDA(dst, b, h) do { _Pragma("unroll") for (int m = 0; m < 4; ++m) _Pragma("unroll") for (int k = 0; k < 2; ++k) dst[m][k] = *(const LAS bf16x8*)(lds + PG8_SA(b, h) + aoff + m * 2048 + k * 1024); } while (0)
#define PG8_LDB(dst, b, h) do { _Pragma("unroll") for (int n = 0; n < 2; ++n) _Pragma("unroll") for (int k = 0; k < 2; ++k) dst[n][k] = *(const LAS bf16x8*)(lds + PG8_SB(b, h) + boff + n * 2048 + k * 1024); } while (0)
#define PG8_CAT(x_, y_) __builtin_shufflevector(__builtin_bit_cast(i32x4, x_), __builtin_bit_cast(i32x4, y_), 0, 1, 2, 3, 4, 5, 6, 7)
#define PG8_MMA(ai, bj, At, Bt) do { __builtin_amdgcn_s_setprio(1); _Pragma("unroll") for (int m = 0; m < 4; ++m) _Pragma("unroll") for (int n = 0; n < 2; ++n) { \
        if constexpr (Epi::FP8) mfma_f8(acc[ai][bj][m][n], PG8_CAT(Bt[n][0], Bt[n][1]), PG8_CAT(At[m][0], At[m][1])); \
        else if constexpr (Epi::I8) { _Pragma("unroll") for (int k = 0; k < 2; ++k) acc[ai][bj][m][n] = __builtin_bit_cast(f32x4, __builtin_amdgcn_mfma_i32_16x16x64_i8(__builtin_bit_cast(i32x4, Bt[n][k]), __builtin_bit_cast(i32x4, At[m][k]), __builtin_bit_cast(i32x4, acc[ai][bj][m][n]), 0, 0, 0)); } \
        else { _Pragma("unroll") for (int k = 0; k < 2; ++k) acc[ai][bj][m][n] = __builtin_amdgcn_mfma_f32_16x16x32_bf16(Bt[n][k], At[m][k], acc[ai][bj][m][n], 0, 0, 0); } } \
        __builtin_amdgcn_s_setprio(0); } while (0)
#define PG8_WAIT_V(n) asm volatile("s_waitcnt vmcnt(" #n ")" ::: "memory")
#define PG8_WAIT_L(n) asm volatile("s_waitcnt lgkmcnt(" #n ")" ::: "memory")
#define PG8_BAR __builtin_amdgcn_s_barrier()
#define PG8_SCHED __builtin_amdgcn_sched_barrier(0)
#define PG8_KBODY \
            const bool last = (t == nt - 2); \
            const char* a1 = cA + (size_t)(t + 1) * kstep; \
            const char* a2 = last ? nA : cA + (size_t)(t + 2) * kstep; const char* b2 = last ? nB : cB + (size_t)(t + 2) * kstep; \
            const char* a3 = a2 + kstep; const char* b3 = b2 + kstep; const size_t k2b = last ? (size_t)0 : (size_t)(t + 2) * kstep; \
            PG8_LDB(B0, 0, 0); PG8_SCHED; PG8_LDA(At, 0, 0); PG8_STAGE_A(PG8_SA(1, 1), a1, 1, false, (size_t)(t + 1) * kstep); \
            PG8_WAIT_L(8); PG8_BAR; PG8_WAIT_L(0); PG8_MMA(0, 0, At, B0); PG8_BAR; PG8_SCHED; \
            PG8_LDB(B1, 0, 1); PG8_STAGE(PG8_SB(0, 0), b2, voffB); \
            PG8_BAR; PG8_WAIT_L(0); PG8_MMA(0, 1, At, B1); PG8_BAR; \
            PG8_LDA(At, 0, 1); PG8_STAGE_A(PG8_SA(0, 0), a2, 0, last, k2b); \
            PG8_BAR; PG8_WAIT_L(0); PG8_MMA(1, 0, At, B0); PG8_BAR; PG8_SCHED; \
            PG8_STAGE(PG8_SB(0, 1), b2 + hstepB, voffB); \
            PG8_WAIT_V(6); PG8_BAR; PG8_MMA(1, 1, At, B1); PG8_BAR; \
            PG8_LDB(B0, 1, 0); PG8_SCHED; PG8_LDA(At, 1, 0); PG8_STAGE_A(PG8_SA(0, 1), a2, 1, last, k2b); \
            PG8_WAIT_L(8); PG8_BAR; PG8_WAIT_L(0); PG8_MMA(0, 0, At, B0); PG8_BAR; PG8_SCHED; \
            PG8_LDB(B1, 1, 1); PG8_STAGE(PG8_SB(1, 0), b3, voffB); \
            PG8_BAR; PG8_WAIT_L(0); PG8_MMA(0, 1, At, B1); PG8_BAR; \
            PG8_LDA(At, 1, 1); PG8_STAGE_A(PG8_SA(1, 0), a3, 0, last, k2b + kstep); \
            PG8_BAR; PG8_WAIT_L(0); PG8_MMA(1, 0, At, B0); PG8_BAR; PG8_SCHED; \
            PG8_STAGE(PG8_SB(1, 1), b3 + hstepB, voffB); \
            PG8_WAIT_V(6); PG8_BAR; PG8_MMA(1, 1, At, B1); PG8_BAR;
    constexpr bool GATHER = Sched::GATHER;
    unsigned vgC[2][2], vgN[2][2];
#define PG8_GOFFS(dst, unit_, li_) do { if constexpr (GATHER) { _Pragma("unroll") for (int h_ = 0; h_ < 2; ++h_) _Pragma("unroll") for (int i_ = 0; i_ < 2; ++i_) { int R_, C_; stage_rc(tid * 16 + i_ * 8192, R_, C_); \
        dst[h_][i_] = S.rowtok(li_, h_ * HALF + R_) * (unsigned)lda + (unsigned)C_ * 2u; } } } while (0)
#define PG8_STAGE_A(bufoff, ptr_, h_, use_next_, kbyte_) do { if constexpr (GATHER) { _Pragma("unroll") for (int _i = 0; _i < 2; ++_i) \
        __builtin_amdgcn_global_load_lds((const unsigned*)((const char*)g.A + (kbyte_) + ((use_next_) ? vgN[h_][_i] : vgC[h_][_i])), (LAS unsigned*)(lds + (bufoff) + ldsw + _i * 8192), 16, 0, 0); } \
        else { PG8_STAGE(bufoff, (ptr_) + (h_) * hstepA, voffA); } } while (0)
    Unit cur, nxt; int ui = 0;
    if (!S.next(0, cur)) return;
    f32x4 acc[2][2][4][2];
#pragma unroll
    for (int a = 0; a < 2; ++a)
#pragma unroll
        for (int b = 0; b < 2; ++b)
#pragma unroll
            for (int m = 0; m < 4; ++m)
#pragma unroll
                for (int n = 0; n < 2; ++n) acc[a][b][m][n] = (f32x4){0.f, 0.f, 0.f, 0.f};
    bf16x8 At[4][2], B0[2][2], B1[2][2];
    const char* cA = (const char*)g.A + (size_t)cur.pm * tstepA; const char* cB = (const char*)g.Bt + cur.boff + (size_t)cur.pn * tstepB;
    PG8_GOFFS(vgC, cur, 0);
    PG8_STAGE(PG8_SB(0, 0), cB, voffB); PG8_STAGE_A(PG8_SA(0, 0), cA, 0, false, (size_t)0); PG8_STAGE(PG8_SB(0, 1), cB + hstepB, voffB); PG8_STAGE_A(PG8_SA(0, 1), cA, 1, false, (size_t)0);
    if (wr == 1) PG8_BAR;
    PG8_WAIT_V(4); PG8_BAR;
    PG8_STAGE(PG8_SB(1, 0), cB + kstep, voffB); PG8_STAGE_A(PG8_SA(1, 0), cA + kstep, 0, false, kstep); PG8_STAGE(PG8_SB(1, 1), cB + hstepB + kstep, voffB);
    PG8_WAIT_V(6); PG8_BAR;
    for (;;) {
        const bool has_next = S.next(ui + 1, nxt);
        if (has_next) PG8_GOFFS(vgN, nxt, ui + 1); else { if constexpr (GATHER) { _Pragma("unroll") for (int h_ = 0; h_ < 2; ++h_) _Pragma("unroll") for (int i_ = 0; i_ < 2; ++i_) vgN[h_][i_] = vgC[h_][i_]; } }
        const char* nA = has_next ? (const char*)g.A + (size_t)nxt.pm * tstepA : cA; const char* nB = has_next ? (const char*)g.Bt + nxt.boff + (size_t)nxt.pn * tstepB : cB;
        if constexpr (Epi::MID_T > 0) {
#pragma clang loop unroll(disable)
            for (int part = 0; part < 2; ++part) { const int t1 = part ? nt : Epi::MID_T;
#pragma clang loop unroll(disable)
                for (int t = part ? Epi::MID_T : 0; t < t1; t += 2) { PG8_KBODY }
                if (part == 0) E.mid(acc, cur, wr, wc, fr, fq); }
        } else if constexpr (Epi::FP8 || Epi::I8) {
#pragma clang loop unroll(disable)
            for (int t = 0; t < nt; t += 2) { PG8_KBODY }
        } else {
            for (int t = 0; t < nt; t += 2) { PG8_KBODY }
        }
        if constexpr (Epi::FP8) { F8_ACC_SETTLE();
#pragma unroll
            for (int a = 0; a < 2; ++a)
#pragma unroll
                for (int b = 0; b < 2; ++b)
#pragma unroll
                    for (int m = 0; m < 4; ++m)
#pragma unroll
                        for (int n = 0; n < 2; ++n) asm volatile("" : "+v"(acc[a][b][m][n])); }
        E(acc, cur, wr, wc, fr, fq);
        if (!has_next) break;
#pragma unroll
        for (int a = 0; a < 2; ++a)
#pragma unroll
            for (int b = 0; b < 2; ++b)
#pragma unroll
                for (int m = 0; m < 4; ++m)
#pragma unroll
                    for (int n = 0; n < 2; ++n) acc[a][b][m][n] = (f32x4){0.f, 0.f, 0.f, 0.f};
        cur = nxt; cA = nA; cB = nB; ++ui;
        if constexpr (GATHER) { _Pragma("unroll") for (int h_ = 0; h_ < 2; ++h_) _Pragma("unroll") for (int i_ = 0; i_ < 2; ++i_) vgC[h_][i_] = vgN[h_][i_]; }
    }
    PG8_WAIT_V(0);
    if (wr == 0) PG8_BAR;
    PG8_BAR;
#undef PG8_KBODY
#undef PG8_GOFFS
#undef PG8_STAGE_A
#undef PG8_SA
#undef PG8_SB
#undef PG8_STAGE
#undef PG8_LDA
#undef PG8_LDB
#undef PG8_MMA
#undef PG8_CAT
#undef PG8_WAIT_V
#undef PG8_WAIT_L
#undef PG8_BAR
#undef PG8_SCHED
}

typedef f32x4 Acc[2][2][4][2];

template <int IN> __device__ __forceinline__ f32x4 accv(const f32x4 a, const float rsv, const f32x4 c) {
    if constexpr (IN == 2) { const i32x4 q = __builtin_bit_cast(i32x4, a); return (f32x4){(float)q[0] * (rsv * c[0]), (float)q[1] * (rsv * c[1]), (float)q[2] * (rsv * c[2]), (float)q[3] * (rsv * c[3])}; }
    else return a;
}
template <int IN> __device__ __forceinline__ void col_scales(const float* cs, const Unit& u, int wc, int fq, f32x4 (&c)[2][2]) {
    if constexpr (IN == 2) { const GAS f32x4* p = (const GAS f32x4*)(cs + u.pn * BM + wc * 32 + 8 * fq);
        c[0][0] = p[0]; c[0][1] = p[1]; c[1][0] = p[HALF / 4]; c[1][1] = p[HALF / 4 + 1]; }
    else { c[0][0] = c[0][1] = c[1][0] = c[1][1] = (f32x4){1.f, 1.f, 1.f, 1.f}; }
}
template <int IN> struct EpiBf16 {
    static constexpr bool PERM = true; static constexpr int MID_T = 0; static constexpr bool FP8 = IN == 1, I8 = IN == 2;
    bf16_t* O; int ldc; int prow0; float sc; const float* rs; const float* cs;
    __device__ __forceinline__ void operator()(const Acc& acc, const Unit& u, int wr, int wc, int fr, int fq) const {
        const int row0 = (u.pm - prow0) * BM + wr * 64 + fr, col0 = u.pn * BM + wc * 32 + 8 * fq;
        f32x4 cv[2][2]; col_scales<IN>(cs, u, wc, fq, cv);
        float rsa[2][4];
#pragma unroll
        for (int ai = 0; ai < 2; ++ai)
#pragma unroll
            for (int m = 0; m < 4; ++m) { rsa[ai][m] = 1.f; if constexpr (I8) rsa[ai][m] = ((const GAS float*)rs)[u.pm * BM + wr * 64 + fr + ai * HALF + m * 16]; }
        if constexpr (I8) __builtin_amdgcn_sched_barrier(0);
#pragma unroll
        for (int ai = 0; ai < 2; ++ai)
#pragma unroll
            for (int m = 0; m < 4; ++m) { bf16_t* rowp = O + (size_t)(row0 + ai * HALF + m * 16) * ldc + col0;
                const float rsv = rsa[ai][m];
#pragma unroll
                for (int bj = 0; bj < 2; ++bj) { f32x4 v0 = accv<IN>(acc[ai][bj][m][0], rsv, cv[bj][0]), v1 = accv<IN>(acc[ai][bj][m][1], rsv, cv[bj][1]);
                    if constexpr (FP8) { v0 *= sc; v1 *= sc; }
                    u32x4 w; w.x = pk2(v0[0], v0[1]); w.y = pk2(v0[2], v0[3]); w.z = pk2(v1[0], v1[1]); w.w = pk2(v1[2], v1[3]);
                    *(GAS u32x4*)(rowp + bj * HALF) = w; } }
    }
};
template <int IN> struct EpiTok {
    static constexpr bool PERM = true; static constexpr int MID_T = 0; static constexpr bool FP8 = false, I8 = IN == 2;
    bf16_t* qk; uchar* gates; const float* qn; const float* kn; const bf16_t* ct; const bf16_t* st; const float* rs; const float* cs;
    __device__ __forceinline__ void operator()(const Acc& acc, const Unit& u, int wr, int wc, int fr_in, int fq_in) const {
        int fr = fr_in, fq = fq_in; asm volatile("" : "+v"(fr), "+v"(fq));
        const int row0 = u.pm * BM + wr * 64 + fr;
        f32x4 cv[2][2]; col_scales<IN>(cs, u, wc, fq, cv);
        if (u.pn < 4) {
            const int G = 4 * u.pn + wc; const bool isq = G < 8; const GAS float* gn = (const GAS float*)(isq ? qn : kn);
            const float post = isq ? (0.125f * 1.44269504089f) : 1.0f;
            const int i0 = 8 * fq;
            unsigned gpa[4], gpb[4];
            { const f32x4 ga0 = *(const GAS f32x4*)(gn + i0), ga1 = *(const GAS f32x4*)(gn + i0 + 4), gb0 = *(const GAS f32x4*)(gn + 32 + i0), gb1 = *(const GAS f32x4*)(gn + 36 + i0);
              gpa[0] = pk2(ga0[0], ga0[1]); gpa[1] = pk2(ga0[2], ga0[3]); gpa[2] = pk2(ga1[0], ga1[1]); gpa[3] = pk2(ga1[2], ga1[3]);
              gpb[0] = pk2(gb0[0], gb0[1]); gpb[1] = pk2(gb0[2], gb0[3]); gpb[2] = pk2(gb1[0], gb1[1]); gpb[3] = pk2(gb1[2], gb1[3]);
#pragma unroll
              for (int e = 0; e < 4; ++e) asm volatile("" : "+v"(gpa[e]), "+v"(gpb[e])); }
#pragma unroll
            for (int ai = 0; ai < 2; ++ai)
#pragma unroll
                for (int mb = 0; mb < 4; mb += 2) {
                    u32x4 cc[2], sn[2]; float rsb[2];
#pragma unroll
                    for (int mm = 0; mm < 2; ++mm) { const int row = row0 + ai * HALF + (mb + mm) * 16, l = row & (SEQ - 1);
                        cc[mm] = *(const GAS u32x4*)(ct + l * 32 + i0); sn[mm] = *(const GAS u32x4*)(st + l * 32 + i0);
                        rsb[mm] = 1.f; if constexpr (I8) rsb[mm] = ((const GAS float*)rs)[row]; }
                    __builtin_amdgcn_sched_barrier(0);
#pragma unroll
                    for (int mm = 0; mm < 2; ++mm) { const int m = mb + mm, row = row0 + ai * HALF + m * 16;
                        f32x4 xa[2][2];
#pragma unroll
                        for (int bj = 0; bj < 2; ++bj)
#pragma unroll
                            for (int n = 0; n < 2; ++n) xa[bj][n] = accv<IN>(acc[ai][bj][m][n], rsb[mm], cv[bj][n]);
                        float ss = 0.f;
#pragma unroll
                        for (int bj = 0; bj < 2; ++bj)
#pragma unroll
                            for (int n = 0; n < 2; ++n) { const f32x4 x = xa[bj][n]; ss += (x[0] * x[0] + x[1] * x[1]) + (x[2] * x[2] + x[3] * x[3]); }
                        ss += xor_swz<16>(ss); ss += xor32(ss);
                        const float r = __builtin_amdgcn_rsqf(ss * (1.0f / 64.0f) + RMS_EPS) * post;
                        float oa[8], ob[8];
#pragma unroll
                        for (int e = 0; e < 8; ++e) { const float a = xa[0][e >> 2][e & 3] * ((e & 1) ? bfhi(gpa[e >> 1]) : bflo(gpa[e >> 1])), b = xa[1][e >> 2][e & 3] * ((e & 1) ? bfhi(gpb[e >> 1]) : bflo(gpb[e >> 1]));
                            const float c = (e & 1) ? bfhi(cc[mm][e >> 1]) : bflo(cc[mm][e >> 1]), sv = (e & 1) ? bfhi(sn[mm][e >> 1]) : bflo(sn[mm][e >> 1]);
                            oa[e] = (a * c - b * sv) * r; ob[e] = (a * sv + b * c) * r; }
                        GAS bf16_t* rowp = (GAS bf16_t*)qk + (size_t)row * 1024 + 64 * G + i0;
                        *(GAS u32x4*)(rowp) = (u32x4){pk2(oa[0], oa[1]), pk2(oa[2], oa[3]), pk2(oa[4], oa[5]), pk2(oa[6], oa[7])};
                        *(GAS u32x4*)(rowp + 32) = (u32x4){pk2(ob[0], ob[1]), pk2(ob[2], ob[3]), pk2(ob[4], ob[5]), pk2(ob[6], ob[7])}; }
                    __builtin_amdgcn_sched_barrier(0);
                }
        } else {
            const int col0 = (u.pn - 4) * HALF + wc * 32 + 8 * fq;
            float rsa[2][4];
#pragma unroll
            for (int ai = 0; ai < 2; ++ai)
#pragma unroll
                for (int m = 0; m < 4; ++m) { rsa[ai][m] = 1.f; if constexpr (I8) rsa[ai][m] = ((const GAS float*)rs)[row0 + ai * HALF + m * 16]; }
            if constexpr (I8) __builtin_amdgcn_sched_barrier(0);
#pragma unroll
            for (int ai = 0; ai < 2; ++ai)
#pragma unroll
                for (int m = 0; m < 4; ++m) {
                    const float rsv = rsa[ai][m];
                    f32x4 xa[2][2];
#pragma unroll
                    for (int bj = 0; bj < 2; ++bj)
#pragma unroll
                        for (int n = 0; n < 2; ++n) xa[bj][n] = accv<IN>(acc[ai][bj][m][n], rsv, cv[bj][n]);
                    unsigned qh[8], qa[8];
#pragma unroll
                    for (int e = 0; e < 8; ++e) { qh[e] = (unsigned)(fast_sigmoid(xa[0][e >> 2][e & 3]) * 255.0f + 0.5f); qa[e] = (unsigned)(fast_sigmoid(xa[1][e >> 2][e & 3]) * 255.0f + 0.5f); }
                    u32x4 w; w.x = qh[0] | (qh[1] << 8) | (qh[2] << 16) | (qh[3] << 24); w.y = qh[4] | (qh[5] << 8) | (qh[6] << 16) | (qh[7] << 24);
                    w.z = qa[0] | (qa[1] << 8) | (qa[2] << 16) | (qa[3] << 24); w.w = qa[4] | (qa[5] << 8) | (qa[6] << 16) | (qa[7] << 24);
                    *(GAS u32x4*)((GAS uchar*)gates + (size_t)(row0 + ai * HALF + m * 16) * 2048 + (size_t)col0 * 2) = w; }
        }
    }
};
__device__ __forceinline__ float ub0(unsigned w) { return (float)(w & 0xffu); }
__device__ __forceinline__ float ub1(unsigned w) { return (float)((w >> 8) & 0xffu); }
__device__ __forceinline__ float ub2(unsigned w) { return (float)((w >> 16) & 0xffu); }
__device__ __forceinline__ float ub3(unsigned w) { return (float)(w >> 24); }
struct EpiMergeF {
    static constexpr bool PERM = true; static constexpr int MID_T = 8; static constexpr bool FP8 = false, I8 = false;
    bf16_t* merged; const uchar* gates;
    __device__ __forceinline__ void mid(Acc& acc, const Unit& u, int wr, int wc, int fr_in, int fq_in) const {
        int fr = fr_in, fq = fq_in; asm volatile("" : "+v"(fr), "+v"(fq));
        const int row0 = u.pm * BM + wr * 64 + fr, col0 = u.pn * BM + wc * 32 + 8 * fq;
#pragma unroll
        for (int ai = 0; ai < 2; ++ai)
#pragma unroll
            for (int mp = 0; mp < 2; ++mp) {
                u32x4 gw[2][2];
#pragma unroll
                for (int mm = 0; mm < 2; ++mm)
#pragma unroll
                    for (int bj = 0; bj < 2; ++bj) gw[mm][bj] = *(const GAS u32x4*)((const GAS uchar*)gates + (size_t)(row0 + ai * HALF + (2 * mp + mm) * 16) * 2048 + (size_t)(col0 + bj * HALF) * 2);
                __builtin_amdgcn_sched_barrier(0);
#pragma unroll
                for (int mm = 0; mm < 2; ++mm)
#pragma unroll
                    for (int bj = 0; bj < 2; ++bj) { const int m = 2 * mp + mm; const u32x4 g = gw[mm][bj];
                        acc[ai][bj][m][0][0] *= ub0(g.x) * __builtin_amdgcn_rcpf(fmaxf(ub0(g.z), 1.0f)); acc[ai][bj][m][0][1] *= ub1(g.x) * __builtin_amdgcn_rcpf(fmaxf(ub1(g.z), 1.0f));
                        acc[ai][bj][m][0][2] *= ub2(g.x) * __builtin_amdgcn_rcpf(fmaxf(ub2(g.z), 1.0f)); acc[ai][bj][m][0][3] *= ub3(g.x) * __builtin_amdgcn_rcpf(fmaxf(ub3(g.z), 1.0f));
                        acc[ai][bj][m][1][0] *= ub0(g.y) * __builtin_amdgcn_rcpf(fmaxf(ub0(g.w), 1.0f)); acc[ai][bj][m][1][1] *= ub1(g.y) * __builtin_amdgcn_rcpf(fmaxf(ub1(g.w), 1.0f));
                        acc[ai][bj][m][1][2] *= ub2(g.y) * __builtin_amdgcn_rcpf(fmaxf(ub2(g.w), 1.0f)); acc[ai][bj][m][1][3] *= ub3(g.y) * __builtin_amdgcn_rcpf(fmaxf(ub3(g.w), 1.0f)); }
                __builtin_amdgcn_sched_barrier(0);
            }
    }
    __device__ __forceinline__ void operator()(const Acc& acc, const Unit& u, int wr, int wc, int fr, int fq) const {
        const int row0 = u.pm * BM + wr * 64 + fr, col0 = u.pn * BM + wc * 32 + 8 * fq;
        const float k = 1.0f / 255.0f;
        u32x2 gwv[2][4][2];
#pragma unroll
        for (int ai = 0; ai < 2; ++ai)
#pragma unroll
            for (int m = 0; m < 4; ++m)
#pragma unroll
                for (int bj = 0; bj < 2; ++bj) gwv[ai][m][bj] = *(const GAS u32x2*)((const GAS uchar*)gates + (size_t)(row0 + ai * HALF + m * 16) * 2048 + (size_t)(col0 + bj * HALF) * 2 + 8);
        __builtin_amdgcn_sched_barrier(0);
#pragma unroll
        for (int ai = 0; ai < 2; ++ai)
#pragma unroll
            for (int m = 0; m < 4; ++m) { const size_t row = (size_t)(row0 + ai * HALF + m * 16);
#pragma unroll
                for (int bj = 0; bj < 2; ++bj) { f32x4 v0 = acc[ai][bj][m][0], v1 = acc[ai][bj][m][1];
                    const u32x2 gw = gwv[ai][m][bj];
                    v0[0] *= fmaxf(ub0(gw.x), 1.0f) * k; v0[1] *= fmaxf(ub1(gw.x), 1.0f) * k; v0[2] *= fmaxf(ub2(gw.x), 1.0f) * k; v0[3] *= fmaxf(ub3(gw.x), 1.0f) * k;
                    v1[0] *= fmaxf(ub0(gw.y), 1.0f) * k; v1[1] *= fmaxf(ub1(gw.y), 1.0f) * k; v1[2] *= fmaxf(ub2(gw.y), 1.0f) * k; v1[3] *= fmaxf(ub3(gw.y), 1.0f) * k;
                    u32x4 w; w.x = pk2(v0[0], v0[1]); w.y = pk2(v0[2], v0[3]); w.z = pk2(v1[0], v1[1]); w.w = pk2(v1[2], v1[3]);
                    *(GAS u32x4*)(merged + row * 1024 + col0 + bj * HALF) = w; } }
    }
};
template <bool IN_F32, bool F8 = false> struct EpiRes {
    static constexpr bool PERM = true; static constexpr int MID_T = 0; static constexpr bool FP8 = F8, I8 = false;
    const float* xin; bf16_t* xr; float sc;
    __device__ __forceinline__ void operator()(const Acc& acc, const Unit& u, int wr, int wc, int fr, int fq) const {
        const int row0 = u.pm * BM + wr * 64 + fr, col0 = u.pn * BM + wc * 32 + 8 * fq;
        constexpr int MB = IN_F32 ? 2 : 4;
#pragma unroll
        for (int ai = 0; ai < 2; ++ai)
#pragma unroll
            for (int mb = 0; mb < 4; mb += MB) {
                f32x4 xa[IN_F32 ? MB : 1][2][2]; u32x4 pw[IN_F32 ? 1 : MB][2];
#pragma unroll
                for (int mm = 0; mm < MB; ++mm)
#pragma unroll
                    for (int bj = 0; bj < 2; ++bj) { const size_t row = (size_t)(row0 + ai * HALF + (mb + mm) * 16);
                        if constexpr (IN_F32) { const GAS f32x4* ip = (const GAS f32x4*)(xin + row * 1024 + col0 + bj * HALF); xa[mm][bj][0] = ip[0]; xa[mm][bj][1] = ip[1]; }
                        else pw[mm][bj] = *(const GAS u32x4*)((const GAS bf16_t*)xr + row * XR_LD + col0 + bj * HALF); }
                __builtin_amdgcn_sched_barrier(0);
#pragma unroll
                for (int mm = 0; mm < MB; ++mm)
#pragma unroll
                    for (int bj = 0; bj < 2; ++bj) { const int m = mb + mm; const size_t row = (size_t)(row0 + ai * HALF + m * 16);
                        f32x4 v0 = acc[ai][bj][m][0], v1 = acc[ai][bj][m][1];
                        if constexpr (F8) { v0 *= sc; v1 *= sc; }
                        GAS bf16_t* op = (GAS bf16_t*)xr + row * XR_LD + col0 + bj * HALF;
                        if constexpr (IN_F32) { v0 += xa[mm][bj][0]; v1 += xa[mm][bj][1]; }
                        else { const u32x4 q = pw[mm][bj];
                            v0[0] += bflo(q.x); v0[1] += bfhi(q.x); v0[2] += bflo(q.y); v0[3] += bfhi(q.y);
                            v1[0] += bflo(q.z); v1[1] += bfhi(q.z); v1[2] += bflo(q.w); v1[3] += bfhi(q.w); }
                        *(GAS u32x4*)op = (u32x4){pk2(v0[0], v0[1]), pk2(v0[2], v0[3]), pk2(v1[0], v1[1]), pk2(v1[2], v1[3])}; }
                __builtin_amdgcn_sched_barrier(0);
            }
    }
};
template <int IN, bool OUT8> struct EpiSwiglu {
    static constexpr bool PERM = true; static constexpr int MID_T = 0; static constexpr bool FP8 = IN == 1, I8 = IN == 2;
    bf16_t* act; int prow0; const float* rs; const float* cs;
    __device__ __forceinline__ void operator()(const Acc& acc, const Unit& u, int wr, int wc, int fr, int fq) const {
        const int row0 = (u.pm - prow0) * BM + wr * 64 + fr, col0 = u.pn * HALF + wc * 32 + 8 * fq;
        f32x4 cv[2][2]; col_scales<IN>(cs, u, wc, fq, cv);
        constexpr float kg = FP8 ? F8_UP_INV : 1.0f, ku = kg * (OUT8 ? F8_SACT : 1.0f);
        float rsa[2][4];
#pragma unroll
        for (int ai = 0; ai < 2; ++ai)
#pragma unroll
            for (int m = 0; m < 4; ++m) { rsa[ai][m] = 1.f; if constexpr (I8) rsa[ai][m] = ((const GAS float*)rs)[u.pm * BM + wr * 64 + fr + ai * HALF + m * 16]; }
        if constexpr (I8) __builtin_amdgcn_sched_barrier(0);
#pragma unroll
        for (int ai = 0; ai < 2; ++ai)
#pragma unroll
            for (int m = 0; m < 4; ++m) {
                const float rsv = rsa[ai][m];
                float g[8], up[8], e[8], o[8];
#pragma unroll
                for (int n = 0; n < 2; ++n) { const f32x4 g4 = accv<IN>(acc[ai][0][m][n], rsv, cv[0][n]), u4 = accv<IN>(acc[ai][1][m][n], rsv, cv[1][n]);
#pragma unroll
                    for (int j = 0; j < 4; ++j) { g[n * 4 + j] = g4[j] * kg; up[n * 4 + j] = u4[j] * ku; } }
#pragma unroll
                for (int j = 0; j < 8; ++j) e[j] = __builtin_amdgcn_exp2f(g[j] * -1.44269504089f);
#pragma unroll
                for (int j = 0; j < 8; ++j) asm volatile("" : "+v"(e[j]));
#pragma unroll
                for (int j = 0; j < 8; ++j) e[j] = __builtin_amdgcn_rcpf(1.0f + e[j]);
#pragma unroll
                for (int j = 0; j < 8; ++j) asm volatile("" : "+v"(e[j]));
#pragma unroll
                for (int j = 0; j < 8; ++j) { o[j] = (g[j] * up[j]) * e[j]; if constexpr (OUT8) o[j] = clamp_f8(o[j]); }
                if constexpr (OUT8) { u32x2 w; w.x = pk4_f8(o[0], o[1], o[2], o[3]); w.y = pk4_f8(o[4], o[5], o[6], o[7]);
                    *(GAS u32x2*)((GAS uchar*)act + (size_t)(row0 + ai * HALF + m * 16) * FFP + col0) = w; }
                else { u32x4 w; w.x = pk2(o[0], o[1]); w.y = pk2(o[2], o[3]); w.z = pk2(o[4], o[5]); w.w = pk2(o[6], o[7]);
                    *(GAS u32x4*)(act + (size_t)(row0 + ai * HALF + m * 16) * FFP + col0) = w; } }
    }
};
}
struct Frame {
    LAS uchar* lds;
    int tid, lane, wave, G, bid;
    uchar* ws; unsigned* ctl;
    float* out;
};
#define CAS __attribute__((address_space(4)))
typedef const float* cfptr_t;
__device__ __forceinline__ const float* argp(int k) { const CAS char* kp = (const CAS char*)__builtin_amdgcn_kernarg_segment_ptr(); asm volatile("" : "+s"(kp)); const float* p_ = *(const CAS cfptr_t*)(kp + 8 * k); ASSUME_GLOBAL(p_); return p_; }

template <bool F8 = false> __device__ __forceinline__ void xpose64w(const float* src, int N, int k0, int n0, typename OutT<F8>::t* dst, int ldd, LAS float* scr, int lane, int hi_off = 0, float sc = 1.0f) {
    const GAS char* base = (const GAS char*)(src + (size_t)k0 * N + n0);
    unsigned voff = (unsigned)lane * 4u; const unsigned rstep = (unsigned)N * 4u;
    float v[64];
#pragma unroll
    for (int k = 0; k < 64; ++k) { asm volatile("" : "+v"(voff)); v[k] = *(const GAS float*)(base + voff); voff += rstep; }
#pragma unroll
    for (int k = 0; k < 64; ++k) scr[k * 65 + lane] = v[k];
    asm volatile("s_waitcnt lgkmcnt(0)" ::: "memory"); __builtin_amdgcn_wave_barrier();
    const int kc = lane & 7;
#pragma unroll
    for (int i = 0; i < 8; ++i) { const int n = (lane >> 3) + 8 * i; const LAS float* s = scr + (8 * kc) * 65 + n;
        if constexpr (F8) { u32x2 o; o.x = pk4_f8(s[0] * sc, s[65] * sc, s[2 * 65] * sc, s[3 * 65] * sc); o.y = pk4_f8(s[4 * 65] * sc, s[5 * 65] * sc, s[6 * 65] * sc, s[7 * 65] * sc);
            *(GAS u32x2*)(dst + (size_t)n * ldd + 8 * kc + (n >= 32 ? hi_off : 0)) = o; }
        else { u32x4 o; o.x = pk2(s[0], s[65]); o.y = pk2(s[2 * 65], s[3 * 65]); o.z = pk2(s[4 * 65], s[5 * 65]); o.w = pk2(s[6 * 65], s[7 * 65]);
            *(GAS u32x4*)(dst + (size_t)n * ldd + 8 * kc + (n >= 32 ? hi_off : 0)) = o; } }
    asm volatile("s_waitcnt lgkmcnt(0)" ::: "memory"); __builtin_amdgcn_wave_barrier();
}
#define WAVE_SCR(F) ((LAS float*)((F).lds) + (F).wave * (64 * 65))
__device__ __forceinline__ void conv_win(Frame& F, const float* w, bf16_t* wtok, bf16_t* wch) {
    LAS float* scr = WAVE_SCR(F);
    for (int t = F.bid * NWAVES + F.wave; t < 16 * 80; t += F.G * NWAVES) {
        const int kb = t / 80, nb = t % 80, n0 = nb * 64;
        bf16_t* dst; int hi = 0;
        if (n0 < 1536) dst = wch + (size_t)n0 * 1024;
        else if (n0 < 2560) { const int G = (n0 - 1536) >> 6; dst = wtok + (size_t)(256 * (G >> 2) + 32 * (G & 3)) * 1024; hi = (128 - 32) * 1024; }
        else if (n0 < 3072) dst = wch + (size_t)(1536 + n0 - 2560) * 1024;
        else if (n0 < 4096) { const int c = n0 - 3072; dst = wtok + (size_t)(256 * (4 + (c >> 7)) + (c & 127)) * 1024; }
        else { const int c = n0 - 4096; dst = wtok + (size_t)(256 * (4 + (c >> 7)) + 128 + (c & 127)) * 1024; }
        xpose64w(w, INW, kb * 64, n0, dst + kb * 64, 1024, scr, F.lane, hi);
    }
}
__device__ __forceinline__ void conv_plain(Frame& F, const float* w, int K, int N, bf16_t* dst, int ldd) {
    LAS float* scr = WAVE_SCR(F);
    const int nkb = K / 64, nnb = N / 64;
    for (int t = F.bid * NWAVES + F.wave; t < nkb * nnb; t += F.G * NWAVES) { const int kb = t / nnb, nb = t % nnb;
        xpose64w(w, N, kb * 64, nb * 64, dst + (size_t)(nb * 64) * ldd + kb * 64, ldd, scr, F.lane); }
}
template <bool F8, bool F8DN = F8> __device__ __forceinline__ void conv_ffn(Frame& F, const float* wg, const float* wu, const float* wd, typename OutT<F8>::t* wgu, typename OutT<F8DN>::t* wdt, int nexp) {
    LAS float* scr = WAVE_SCR(F);
    constexpr int GUP = F8 ? P8 : 1024;
    const int per = 16 * 43;
    for (int t = F.bid * NWAVES + F.wave; t < nexp * 3 * per; t += F.G * NWAVES) {
        const int e = t / (3 * per), r = t % (3 * per), which = r / per, q = r % per;
        if (which < 2) { const int kb = q / 43, nb = q % 43, n0 = nb * 64; const float* src = (which ? wu : wg) + (size_t)e * 1024 * DFF;
            const int drow = (n0 / 128) * 256 + which * 128 + (n0 % 128);
            xpose64w<F8>(src, DFF, kb * 64, n0, wgu + (size_t)e * 5632 * GUP + (size_t)drow * GUP + kb * 64, GUP, scr, F.lane, 0, F8_SWGU);
        } else { const int kb = q / 16, nb = q % 16; const float* src = wd + (size_t)e * DFF * 1024;
            xpose64w<F8DN>(src, 1024, kb * 64, nb * 64, wdt + (size_t)e * 1024 * FFP + (size_t)(nb * 64) * FFP + kb * 64, FFP, scr, F.lane, 0, F8_SWD); }
    }
    constexpr int EPC = F8 ? 16 : 8, CR = 1024 / EPC, EPD = F8DN ? 16 : 8, CD = 64 / EPD;
    const int gt = F.bid * NTHR + F.tid, GT = F.G * NTHR;
    for (int i = gt; i < nexp * 128 * CR; i += GT) { const int e = i / (128 * CR), r = (i / CR) % 128, c8 = i % CR;
        const int row = 256 * 21 + (r < 64 ? 64 + r : 192 + (r - 64));
        *(GAS u32x4*)(wgu + (size_t)e * 5632 * GUP + (size_t)row * GUP + c8 * EPC) = (u32x4){0u, 0u, 0u, 0u}; }
    for (int i = gt; i < nexp * 1024 * CD; i += GT) { const int e = i / (1024 * CD), n = (i / CD) % 1024, c8 = i % CD;
        *(GAS u32x4*)(wdt + (size_t)e * 1024 * FFP + (size_t)n * FFP + DFF + c8 * EPD) = (u32x4){0u, 0u, 0u, 0u}; }
}

__device__ __forceinline__ void rope_tables(Frame& F) {
    GAS bf16_t* ct = (GAS bf16_t*)(F.ws + WS_ROPE); GAS bf16_t* st = ct + SEQ * 32;
    const int gt = F.bid * NTHR + F.tid, GT = F.G * NTHR;
    for (int i = gt; i < SEQ * 32; i += GT) { const int l = i >> 5, j = i & 31;
        const float inv_rev = __builtin_amdgcn_exp2f(-(float)j * (13.287712379549449f / 32.0f)) * 0.15915494309f;
        const float rev = (float)l * inv_rev;
        ct[i] = (bf16_t)f2bf(cos_rev(rev)); st[i] = (bf16_t)f2bf(sin_rev(rev)); }
}

__device__ __forceinline__ void norm_row_load(const float* xrow, int lane, f32x4 (&v)[4]) {
    const GAS f32x4* xr = (const GAS f32x4*)xrow + lane;
#pragma unroll
    for (int j = 0; j < 4; ++j) v[j] = xr[64 * j];
}
template <int OM> __device__ __forceinline__ void norm_row(f32x4 (&v)[4], const float* g, typename OutT<(OM != 0)>::t* orow, float* srow, int lane) {
    const GAS f32x4* gr = (const GAS f32x4*)g + lane;
    float s = 0.f;
#pragma unroll
    for (int j = 0; j < 4; ++j) s += (v[j].x * v[j].x + v[j].y * v[j].y) + (v[j].z * v[j].z + v[j].w * v[j].w);
    const float r = __builtin_amdgcn_rsqf(wave_sum(s) * (1.0f / DM) + RMS_EPS);
    if constexpr (OM == 2) {
        float mx = 0.f;
#pragma unroll
        for (int j = 0; j < 4; ++j) { const f32x4 gg = gr[64 * j]; v[j].x *= r * gg.x; v[j].y *= r * gg.y; v[j].z *= r * gg.z; v[j].w *= r * gg.w;
            mx = fmaxf(fmaxf(mx, fmaxf(fabsf(v[j].x), fabsf(v[j].y))), fmaxf(fabsf(v[j].z), fabsf(v[j].w))); }
        mx = fmaxf(wave_max(mx), 1e-30f); const float inv = 127.0f * __builtin_amdgcn_rcpf(mx);
#pragma unroll
        for (int j = 0; j < 4; ++j) ((GAS unsigned*)orow + lane)[64 * j] = pk4_i8(v[j].x * inv, v[j].y * inv, v[j].z * inv, v[j].w * inv);
        if (lane == 0) *(GAS float*)srow = mx * (1.0f / 127.0f);
    } else {
        GAS u32x2* o8 = (GAS u32x2*)orow + lane;
#pragma unroll
        for (int j = 0; j < 4; ++j) { const f32x4 gg = gr[64 * j]; u32x2 w; w.x = pk2(v[j].x * r * gg.x, v[j].y * r * gg.y); w.y = pk2(v[j].z * r * gg.z, v[j].w * r * gg.w); o8[64 * j] = w; }
    }
}
template <int OM> __device__ __forceinline__ void norm_row_bf(const u32x4 (&xw)[2], const float* g, typename OutT<(OM != 0)>::t* orow, float* srow, int lane) {
    const GAS f32x4* gr = (const GAS f32x4*)g + 2 * lane;
    float v[2][8]; float s = 0.f;
#pragma unroll
    for (int j = 0; j < 2; ++j) { const u32x4 w = xw[j]; v[j][0] = bflo(w.x); v[j][1] = bfhi(w.x); v[j][2] = bflo(w.y); v[j][3] = bfhi(w.y); v[j][4] = bflo(w.z); v[j][5] = bfhi(w.z); v[j][6] = bflo(w.w); v[j][7] = bfhi(w.w);
#pragma unroll
        for (int e = 0; e < 8; ++e) s += v[j][e] * v[j][e]; }
    const float r = __builtin_amdgcn_rsqf(wave_sum(s) * (1.0f / DM) + RMS_EPS) * (OM == 1 ? F8_SH : 1.0f);
    if constexpr (OM == 2) {
        float mx = 0.f;
#pragma unroll
        for (int j = 0; j < 2; ++j) { const f32x4 ga = gr[128 * j], gb = gr[128 * j + 1];
            v[j][0] *= r * ga.x; v[j][1] *= r * ga.y; v[j][2] *= r * ga.z; v[j][3] *= r * ga.w; v[j][4] *= r * gb.x; v[j][5] *= r * gb.y; v[j][6] *= r * gb.z; v[j][7] *= r * gb.w;
#pragma unroll
            for (int e = 0; e < 8; ++e) mx = fmaxf(mx, fabsf(v[j][e])); }
        mx = fmaxf(wave_max(mx), 1e-30f); const float inv = 127.0f * __builtin_amdgcn_rcpf(mx);
#pragma unroll
        for (int j = 0; j < 2; ++j) ((GAS u32x2*)orow + lane)[64 * j] = (u32x2){pk4_i8(v[j][0] * inv, v[j][1] * inv, v[j][2] * inv, v[j][3] * inv), pk4_i8(v[j][4] * inv, v[j][5] * inv, v[j][6] * inv, v[j][7] * inv)};
        if (lane == 0) *(GAS float*)srow = mx * (1.0f / 127.0f);
    } else {
#pragma unroll
        for (int j = 0; j < 2; ++j) { const f32x4 ga = gr[128 * j], gb = gr[128 * j + 1];
            if constexpr (OM == 1) ((GAS u32x2*)orow + lane)[64 * j] = (u32x2){pk4_f8(v[j][0] * r * ga.x, v[j][1] * r * ga.y, v[j][2] * r * ga.z, v[j][3] * r * ga.w), pk4_f8(v[j][4] * r * gb.x, v[j][5] * r * gb.y, v[j][6] * r * gb.z, v[j][7] * r * gb.w)};
            else ((GAS u32x4*)orow + lane)[64 * j] = (u32x4){pk2(v[j][0] * r * ga.x, v[j][1] * r * ga.y), pk2(v[j][2] * r * ga.z, v[j][3] * r * ga.w), pk2(v[j][4] * r * gb.x, v[j][5] * r * gb.y), pk2(v[j][6] * r * gb.z, v[j][7] * r * gb.w)}; }
    }
}
template <int OM> __device__ __forceinline__ void phase_norm_bf(Frame& F, const bf16_t* xr, const float* g, typename OutT<(OM != 0)>::t* h, float* hs) {
    const int gw = F.bid * NWAVES + F.wave, NGW = F.G * NWAVES;
    u32x4 xw[2], nw[2];
    if (gw < NTOK) { xw[0] = ((const GAS u32x4*)(xr + (size_t)gw * XR_LD) + F.lane)[0]; xw[1] = ((const GAS u32x4*)(xr + (size_t)gw * XR_LD) + F.lane)[64]; }
    for (int m = gw; m < NTOK; m += NGW) { const int mn = m + NGW < NTOK ? m + NGW : m;
        nw[0] = ((const GAS u32x4*)(xr + (size_t)mn * XR_LD) + F.lane)[0]; nw[1] = ((const GAS u32x4*)(xr + (size_t)mn * XR_LD) + F.lane)[64];
        norm_row_bf<OM>(xw, g, h + (size_t)m * (OM == 2 ? P8 : DM), hs + m, F.lane);
        xw[0] = nw[0]; xw[1] = nw[1]; }
}
template <int OM> __device__ __forceinline__ void phase_norm(Frame& F, const float* x, const float* g, typename OutT<(OM != 0)>::t* h, float* hs) {
    const int gw = F.bid * NWAVES + F.wave, NGW = F.G * NWAVES;
    f32x4 v[4], nv[4];
    if (gw < NTOK) norm_row_load(x + (size_t)gw * DM, F.lane, v);
    for (int m = gw; m < NTOK; m += NGW) { const int mn = m + NGW < NTOK ? m + NGW : m;
        norm_row_load(x + (size_t)mn * DM, F.lane, nv);
        norm_row<OM>(v, g, h + (size_t)m * (OM == 2 ? P8 : DM), hs + m, F.lane);
#pragma unroll
        for (int j = 0; j < 4; ++j) v[j] = nv[j]; }
}
__device__ __forceinline__ void quant_rows(Frame& F, const bf16_t* src, uchar* dst, float* sc, int R) {
    const int gw = F.bid * NWAVES + F.wave, NGW = F.G * NWAVES;
    for (int r = gw; r < R; r += NGW) {
        const GAS u32x4* sp = (const GAS u32x4*)(src + (size_t)r * 1024) + 2 * F.lane;
        const u32x4 a = sp[0], b = sp[1];
        const unsigned w[8] = {a.x, a.y, a.z, a.w, b.x, b.y, b.z, b.w};
        float v[16]; float mx = 0.f;
#pragma unroll
        for (int e = 0; e < 8; ++e) { v[2 * e] = bflo(w[e]); v[2 * e + 1] = bfhi(w[e]); mx = fmaxf(mx, fmaxf(fabsf(v[2 * e]), fabsf(v[2 * e + 1]))); }
        mx = fmaxf(wave_max(mx), 1e-30f); const float inv = 127.0f * __builtin_amdgcn_rcpf(mx);
        *((GAS u32x4*)(dst + (size_t)r * P8) + F.lane) = (u32x4){pk4_i8(v[0] * inv, v[1] * inv, v[2] * inv, v[3] * inv), pk4_i8(v[4] * inv, v[5] * inv, v[6] * inv, v[7] * inv),
                                                                   pk4_i8(v[8] * inv, v[9] * inv, v[10] * inv, v[11] * inv), pk4_i8(v[12] * inv, v[13] * inv, v[14] * inv, v[15] * inv)};
        if (F.lane == 0) ((GAS float*)sc)[r] = mx * (1.0f / 127.0f);
    }
}

__device__ __forceinline__ void phase_hdn(Frame& F, int layer) {
    const GAS float* w1 = (const GAS float*)argp(4) + (size_t)layer * FEMB * FHID; const GAS float* b1 = (const GAS float*)argp(5) + layer * FHID; const GAS float* fr1 = (const GAS float*)argp(6) + layer * FHID;
    const GAS float* w2 = (const GAS float*)argp(7) + (size_t)layer * FHID * FHID; const GAS float* b2 = (const GAS float*)argp(8) + layer * FHID; const GAS float* fr2 = (const GAS float*)argp(9) + layer * FHID;
    GAS float* hdn = (GAS float*)(F.ws + WS_HDN) + (size_t)layer * SEQ * FHID;
    LAS float* scr = (LAS float*)(F.lds + 136 * 1024) + F.wave * 128;
    const int gw = F.bid * NWAVES + F.wave, NGW = F.G * NWAVES, j = F.lane;
    for (int l = gw; l < SEQ; l += NGW) {
        float z = 0.f;
        if (j == 0) z = (float)l * (1.0f / (float)(SEQ - 1));
        else if (j < FEMB) { const int i = (j - 1) & 15; const float f = 1e-4f + (float)i * ((15.0f - 1e-4f) / 15.0f);
            const float rev = f * ((float)l * (1.0f / (float)SEQ)); z = (j <= 16) ? cos_rev(rev) : -sin_rev(rev); }
        scr[j] = z;
        __builtin_amdgcn_wave_barrier(); asm volatile("s_waitcnt lgkmcnt(0)" ::: "memory");
        float a1 = b1[j];
        for (int i = 0; i < FEMB; ++i) a1 += scr[i] * w1[i * FHID + j];
        const float h1 = fast_sin(fr1[j] * a1);
        scr[64 + j] = h1;
        __builtin_amdgcn_wave_barrier(); asm volatile("s_waitcnt lgkmcnt(0)" ::: "memory");
        float a2 = b2[j];
        for (int i = 0; i < FHID; ++i) a2 += scr[64 + i] * w2[i * FHID + j];
        hdn[(size_t)l * FHID + j] = fast_sin(fr2[j] * a2);
        __builtin_amdgcn_wave_barrier(); asm volatile("s_waitcnt lgkmcnt(0)" ::: "memory");
    }
}

__device__ __forceinline__ void phase_fimg(Frame& F, int layer) {
    const GAS float* hdn = (const GAS float*)(F.ws + WS_HDN) + (size_t)layer * SEQ * FHID;
    const GAS float* w3 = (const GAS float*)argp(10) + (size_t)layer * FHID * 2048;
    GAS bf16_t* gimg = (GAS bf16_t*)(F.ws + WS_FIMG);
    const int gw = F.bid * NWAVES + F.wave, NGW = F.G * NWAVES;
    const float min_decay = -4.605170185988091f / 1.5f, max_decay = -4.605170185988091f / 0.3f;
    for (int it = gw; it < 32 * 64; it += NGW) {
        const int lbp = it >> 6, cb = it & 63;
        const int o = cb >> 5, dir = (cb >> 4) & 1;
        int l[2], u[2], lc[2];
#pragma unroll
        for (int h = 0; h < 2; ++h) { const int lb = 2 * lbp + h; l[h] = dir ? (64 * lb + 1 + F.lane) : (64 * lb + 63 - F.lane); u[h] = dir ? (4160 + 64 * lb + F.lane) : (4096 - 64 * lb + F.lane); lc[h] = l[h] < SEQ ? l[h] : SEQ - 1; }
        f32x2 hv[FHID];
        { const GAS f32x4* hp0 = (const GAS f32x4*)(hdn + (size_t)lc[0] * FHID); const GAS f32x4* hp1 = (const GAS f32x4*)(hdn + (size_t)lc[1] * FHID);
#pragma unroll
          for (int i = 0; i < 16; ++i) { const f32x4 a = hp0[i], b = hp1[i]; hv[4 * i] = (f32x2){a.x, b.x}; hv[4 * i + 1] = (f32x2){a.y, b.y}; hv[4 * i + 2] = (f32x2){a.z, b.z}; hv[4 * i + 3] = (f32x2){a.w, b.w}; } }
        LAS float* wt = (LAS float*)(F.lds) + F.wave * 2048;
        { const GAS f32x4* wp = (const GAS f32x4*)(w3 + (size_t)F.lane * 2048 + cb * 32);
#pragma unroll
          for (int q = 0; q < 8; ++q) { const f32x4 t = wp[q]; wt[(4 * q) * 64 + F.lane] = t.x; wt[(4 * q + 1) * 64 + F.lane] = t.y; wt[(4 * q + 2) * 64 + F.lane] = t.z; wt[(4 * q + 3) * 64 + F.lane] = t.w; } }
        asm volatile("s_waitcnt lgkmcnt(0)" ::: "memory"); __builtin_amdgcn_wave_barrier();
        const f32x2 tl = {(float)lc[0] * (1.0f / (float)(SEQ - 1)), (float)lc[1] * (1.0f / (float)(SEQ - 1))};
        for (int cc = 0; cc < 32; ++cc) {
            const int col = cb * 32 + cc, c = col & 511;
            f32x2 acc = {0.f, 0.f};
            const LAS f32x4* wc4 = (const LAS f32x4*)(wt + cc * 64);
#pragma unroll
            for (int i = 0; i < 16; ++i) { const f32x4 w4 = wc4[i];
                acc += hv[4 * i] * (f32x2){w4.x, w4.x}; acc += hv[4 * i + 1] * (f32x2){w4.y, w4.y}; acc += hv[4 * i + 2] * (f32x2){w4.z, w4.z}; acc += hv[4 * i + 3] * (f32x2){w4.w, w4.w}; }
            const float delta = fabsf(min_decay + (float)c * ((max_decay - min_decay) / 511.0f));
#pragma unroll
            for (int h = 0; h < 2; ++h) { const float val = l[h] < SEQ ? acc[h] * fast_exp(-tl[h] * delta) : 0.f;
                gimg[(size_t)(o * 512 + c) * GIMG_LEN + u[h]] = (unsigned short)f2bf(val); }
        }
        asm volatile("s_waitcnt lgkmcnt(0)" ::: "memory"); __builtin_amdgcn_wave_barrier();
    }
}

typedef short s16x4 __attribute__((ext_vector_type(4)));
__device__ __forceinline__ void phase_transpose_y(Frame& F) {
    const GAS bf16_t* yT = (const GAS bf16_t*)(F.ws + WS_YT); GAS bf16_t* yh = (GAS bf16_t*)(F.ws + WS_YCAT);
    constexpr int RB = 144;
    const int r = F.tid >> 3, c8 = F.tid & 7;
    const int w = F.wave, g = F.lane >> 4, i = F.lane & 15, q = i >> 2, p = i & 3;
    u32x4 nx = *(const GAS u32x4*)(yT + (size_t)((F.bid & 7) * 64 + r) * NTOK + (F.bid >> 3) * 64 + c8 * 8);
    int par = 0;
    for (int t = F.bid; t < 8 * 512; t += F.G) {
        const int cb = t & 7, tb = t >> 3;
        LAS uchar* buf = F.lds + par * (64 * RB); par ^= 1;
        *(LAS u32x4*)(buf + r * RB + c8 * 16) = nx;
        { const int tn = t + F.G < 8 * 512 ? t + F.G : t; nx = *(const GAS u32x4*)(yT + (size_t)((tn & 7) * 64 + r) * NTOK + (tn >> 3) * 64 + c8 * 8); }
        __syncthreads();
        const s16x4 va = __builtin_amdgcn_ds_read_tr16_b64_v4i16((LAS s16x4*)(buf + (8 * w + q) * RB + (16 * g + 4 * p) * 2));
        const s16x4 vb = __builtin_amdgcn_ds_read_tr16_b64_v4i16((LAS s16x4*)(buf + (8 * w + 4 + q) * RB + (16 * g + 4 * p) * 2));
        const bf16x8 o = __builtin_shufflevector(va, vb, 0, 1, 2, 3, 4, 5, 6, 7);
        *(GAS bf16x8*)(yh + (size_t)(tb * 64 + 16 * g + i) * 1024 + cb * 64 + 8 * w) = o;
    }
    __syncthreads();
}
constexpr int HY_F = 0, HY_V = FIMG_BYTES, HY_VROW = 144, HY_VROWS = 78 * 8;
static_assert(HY_V + HY_VROWS * HY_VROW <= LDS_MISC, "hyena LDS");

__device__ __forceinline__ void hy_load_fimg(Frame& F, const GAS bf16_t* g) {
    const GAS u32x4* src = (const GAS u32x4*)g;
    constexpr int NJ = FIMG_LEN / 8, NQ = (NJ + NTHR - 1) / NTHR;
    u32x4 av[NQ], bv[NQ];
#pragma unroll
    for (int q = 0; q < NQ; ++q) { const int j0 = F.tid + q * NTHR, j = j0 < NJ ? j0 : NJ - 1; av[q] = src[j + 7]; bv[q] = src[j + 8]; }
#pragma unroll
    for (int q = 0; q < NQ; ++q) { const int j = F.tid + q * NTHR; if (j < NJ) {
        const u32x4 a = av[q], b = bv[q];
        const unsigned d2 = a.z, d3 = a.w, d4 = b.x, d5 = b.y, d6 = b.z, d7 = b.w;
        LAS uchar* dst = F.lds + HY_F + j * 16;
        *(LAS u32x4*)(dst) = (u32x4){__builtin_amdgcn_alignbit(d4, d3, 16), __builtin_amdgcn_alignbit(d5, d4, 16), __builtin_amdgcn_alignbit(d6, d5, 16), __builtin_amdgcn_alignbit(d7, d6, 16)};
        *(LAS u32x4*)(dst + FIMG_LEN * 2) = (u32x4){d3, d4, d5, d6};
        *(LAS u32x4*)(dst + 2 * FIMG_LEN * 2) = (u32x4){__builtin_amdgcn_alignbit(d3, d2, 16), __builtin_amdgcn_alignbit(d4, d3, 16), __builtin_amdgcn_alignbit(d5, d4, 16), __builtin_amdgcn_alignbit(d6, d5, 16)};
        *(LAS u32x4*)(dst + 3 * FIMG_LEN * 2) = (u32x4){d2, d3, d4, d5}; } }
}
__device__ __forceinline__ bf16x8 hy_lda(const LAS uchar* p) { const bf16x4 lo = *(const volatile LAS bf16x4*)p; const bf16x4 hi = *(const volatile LAS bf16x4*)(p + 8); return __builtin_shufflevector(lo, hi, 0, 1, 2, 3, 4, 5, 6, 7); }
template <int N0, int N1> __device__ __forceinline__ void hy_step(const LAS uchar*& pA, const LAS uchar*& pB, bf16x8 (&a0)[4], bf16x8 (&a1)[4], bf16x8 (&b0)[4], bf16x8 (&b1)[4], f32x4 (&acc)[4][4]) {
#pragma unroll
    for (int r = 0; r < 4; ++r) { a1[r] = hy_lda(pA + r * (FIMG_LEN * 2) + 64); b1[r] = *(const LAS bf16x8*)(pB + r * (16 * HY_VROW) + 64);
#pragma unroll
        for (int nt = N0; nt < N1; ++nt) acc[r][nt] = __builtin_amdgcn_mfma_f32_16x16x32_bf16(a0[r], b0[nt], acc[r][nt], 0, 0, 0);
        __builtin_amdgcn_sched_barrier(0); }
#pragma unroll
    for (int r = 0; r < 4; ++r) { a0[r] = hy_lda(pA + r * (FIMG_LEN * 2) + 128); b0[r] = *(const LAS bf16x8*)(pB + r * (16 * HY_VROW) + 8 * HY_VROW);
#pragma unroll
        for (int nt = N0; nt < N1; ++nt) acc[r][nt] = __builtin_amdgcn_mfma_f32_16x16x32_bf16(a1[r], b1[nt], acc[r][nt], 0, 0, 0);
        __builtin_amdgcn_sched_barrier(0); }
    pA += 128; pB += 8 * HY_VROW;
}
__device__ __forceinline__ void hy_conv(Frame& F, f32x4 (&acc)[4][4]) {
    const int q = F.wave, i = F.lane & 15, g = F.lane >> 4;
#pragma unroll
    for (int r = 0; r < 4; ++r)
#pragma unroll
        for (int nt = 0; nt < 4; ++nt) acc[r][nt] = (f32x4){0.f, 0.f, 0.f, 0.f};
    const int dhi = 8 * q + 7;
    const LAS uchar* pA = F.lds + (unsigned)(HY_F + 8192 - 8 * i + 16 * g - 128 * dhi);
    const LAS uchar* pB = F.lds + (unsigned)(HY_V + ((8 * q + (i >> 3) + 7) * 8 + (i & 7)) * HY_VROW + 16 * g - 8 * HY_VROW * dhi);
    bf16x8 a0[4], a1[4], b0[4], b1[4];
#pragma unroll
    for (int r = 0; r < 4; ++r) { a0[r] = hy_lda(pA + r * (FIMG_LEN * 2)); b0[r] = *(const LAS bf16x8*)(pB + r * (16 * HY_VROW)); }
    hy_step<3, 4>(pA, pB, a0, a1, b0, b1, acc); hy_step<3, 4>(pA, pB, a0, a1, b0, b1, acc);
    hy_step<2, 4>(pA, pB, a0, a1, b0, b1, acc); hy_step<2, 4>(pA, pB, a0, a1, b0, b1, acc);
    hy_step<1, 4>(pA, pB, a0, a1, b0, b1, acc); hy_step<1, 4>(pA, pB, a0, a1, b0, b1, acc);
#pragma clang loop unroll(disable)
    for (int m = 6; m < 65; ++m) hy_step<0, 4>(pA, pB, a0, a1, b0, b1, acc);
    hy_step<0, 3>(pA, pB, a0, a1, b0, b1, acc); hy_step<0, 3>(pA, pB, a0, a1, b0, b1, acc);
    hy_step<0, 2>(pA, pB, a0, a1, b0, b1, acc); hy_step<0, 2>(pA, pB, a0, a1, b0, b1, acc);
    hy_step<0, 1>(pA, pB, a0, a1, b0, b1, acc); hy_step<0, 1>(pA, pB, a0, a1, b0, b1, acc);
}
__device__ __forceinline__ void conv8(const u32x4 u, float left, float right, float w0, float w1, float w2, float (&y)[8]) {
    float x[10]; x[0] = left; x[1] = bflo(u.x); x[2] = bfhi(u.x); x[3] = bflo(u.y); x[4] = bfhi(u.y); x[5] = bflo(u.z); x[6] = bfhi(u.z); x[7] = bflo(u.w); x[8] = bfhi(u.w); x[9] = right;
#pragma unroll
    for (int e = 0; e < 8; ++e) y[e] = w0 * x[e] + w1 * x[e + 1] + w2 * x[e + 2];
}
struct Run16 { u32x4 a, b; unsigned short l, r; };
__device__ __forceinline__ Run16 run16_load(const GAS bf16_t* p, int t) { Run16 x; x.a = *(const GAS u32x4*)(p + t); x.b = *(const GAS u32x4*)(p + t + 8); x.l = p[t > 0 ? t - 1 : t]; x.r = p[t + 16 < SEQ ? t + 16 : t]; return x; }
__device__ __forceinline__ void run16_conv(const Run16& x, int t, float w0, float w1, float w2, float (&y)[16]) {
    const float left = t > 0 ? bf2f(x.l) : 0.f, right = t + 16 < SEQ ? bf2f(x.r) : 0.f;
    float ya[8], yb[8];
    conv8(x.a, left, bflo(x.b.x), w0, w1, w2, ya); conv8(x.b, bfhi(x.a.w), right, w0, w1, w2, yb);
#pragma unroll
    for (int e = 0; e < 8; ++e) { y[e] = ya[e]; y[8 + e] = yb[e]; }
}
__device__ __forceinline__ void phase_hyena(Frame& F, int layer) {
    const GAS bf16_t* hy = (const GAS bf16_t*)(F.ws + WS_CHT);
    GAS bf16_t* yT = (GAS bf16_t*)(F.ws + WS_YT);
    const GAS bf16_t* fimg = (const GAS bf16_t*)(F.ws + WS_FIMG);
    const GAS float* hb = (const GAS float*)argp(11) + (size_t)layer * 2 * HW;
    const GAS float* cw = (const GAS float*)argp(3) + (size_t)layer * 3 * 1536;
    const int q = F.wave, n = F.lane & 15, g = F.lane >> 4;
    for (int c = F.bid; c < HW; c += F.G) {
        for (int i = F.tid; i < 112 * (HY_VROW / 16); i += NTHR) { const int r = i / (HY_VROW / 16), k = i % (HY_VROW / 16); const int row = r < 56 ? r : (71 * 8 + r - 56);
            *(LAS u32x4*)(F.lds + HY_V + row * HY_VROW + k * 16) = (u32x4){0u, 0u, 0u, 0u}; }
        { const float w0 = cw[1024 + c], w1 = cw[1536 + 1024 + c], w2 = cw[2 * 1536 + 1024 + c];
          int tl = F.tid; asm volatile("" : "+v"(tl));
          const int k = tl & 7, b = (tl >> 3) & 7, sq = tl >> 6;
          const GAS char* pc = (const GAS char*)(hy + (size_t)(1024 + c) * NTOK); asm volatile("" : "+s"(pc));
          const unsigned ob = (unsigned)(b * SEQ + k * 8) * 2u;
#pragma unroll
          for (int jb = 0; jb < 8; jb += 4) {
          u32x4 uu[4]; unsigned short ll[4], rr[4];
#pragma unroll
          for (int j = 0; j < 4; ++j) { const int t = (sq + 8 * (jb + j)) * 64 + k * 8; const unsigned o = ob + (unsigned)(sq + 8 * (jb + j)) * 128u;
              uu[j] = *(const GAS u32x4*)(pc + o); ll[j] = *(const GAS unsigned short*)(pc + (t > 0 ? o - 2u : o)); rr[j] = *(const GAS unsigned short*)(pc + (t + 8 < SEQ ? o + 16u : o)); }
          __builtin_amdgcn_sched_barrier(0);
#pragma unroll
          for (int j = 0; j < 4; ++j) { const int s1 = sq + 8 * (jb + j), t = s1 * 64 + k * 8, r = s1 * 8 + b;
            const float left = t > 0 ? bf2f(ll[j]) : 0.f, right = t + 8 < SEQ ? bf2f(rr[j]) : 0.f;
            float y[8]; conv8(uu[j], left, right, w0, w1, w2, y);
            *(LAS u32x4*)(F.lds + HY_V + (r + 56) * HY_VROW + k * 16) = (u32x4){pk2(y[0], y[1]), pk2(y[2], y[3]), pk2(y[4], y[5]), pk2(y[6], y[7])}; }
          __builtin_amdgcn_sched_barrier(0);
          } }
        hy_load_fimg(F, fimg + (size_t)(0 * 512 + c) * GIMG_LEN);
        __syncthreads();
        f32x4 acc[4][4];
        Run16 xr[4];
        { const int b = n & 7;
#pragma unroll
          for (int nt = 0; nt < 4; ++nt) xr[nt] = run16_load(hy + (size_t)c * NTOK + b * SEQ, (8 * q + 2 * nt + (n >> 3)) * 64 + 16 * g); }
        hy_conv(F, acc);
        __syncthreads();
        {
            const float bias = hb[c]; const int b = n & 7;
            const float w0 = cw[c], w1 = cw[1536 + c], w2 = cw[2 * 1536 + c];
#pragma unroll
            for (int nt = 0; nt < 4; ++nt) {
                const int t1 = 8 * q + 2 * nt + (n >> 3), t0 = 16 * g;
                LAS u32x4* vp = (LAS u32x4*)(F.lds + HY_V + ((t1 + 7) * 8 + b) * HY_VROW + t0 * 2);
                float xv[16]; run16_conv(xr[nt], t1 * 64 + t0, w0, w1, w2, xv);
                const u32x4 v0 = vp[0], v1 = vp[1];
                const unsigned vw[8] = {v0.x, v0.y, v0.z, v0.w, v1.x, v1.y, v1.z, v1.w};
                unsigned ow[8];
#pragma unroll
                for (int p = 0; p < 8; ++p) {
                    const int e0 = 2 * p, e1 = 2 * p + 1;
                    const float z0 = xv[e0] * (acc[e0 & 3][nt][e0 >> 2] + bias * bflo(vw[p]));
                    const float z1 = xv[e1] * (acc[e1 & 3][nt][e1 >> 2] + bias * bfhi(vw[p]));
                    ow[p] = pk2(z0, z1); }
                vp[0] = (u32x4){ow[0], ow[1], ow[2], ow[3]}; vp[1] = (u32x4){ow[4], ow[5], ow[6], ow[7]};
            }
        }
        hy_load_fimg(F, fimg + (size_t)(1 * 512 + c) * GIMG_LEN);
        { const int b = n & 7;
#pragma unroll
          for (int nt = 0; nt < 4; ++nt) xr[nt] = run16_load(hy + (size_t)(512 + c) * NTOK + b * SEQ, (8 * q + 2 * nt + (n >> 3)) * 64 + 16 * g); }
        __syncthreads();
        hy_conv(F, acc);
        {
            const float bias = hb[HW + c]; const int b = n & 7;
            const float w0 = cw[512 + c], w1 = cw[1536 + 512 + c], w2 = cw[2 * 1536 + 512 + c];
#pragma unroll
            for (int nt = 0; nt < 4; ++nt) {
                const int t1 = 8 * q + 2 * nt + (n >> 3), t0 = 16 * g;
                const LAS u32x4* vp = (const LAS u32x4*)(F.lds + HY_V + ((t1 + 7) * 8 + b) * HY_VROW + t0 * 2);
                float xv[16]; run16_conv(xr[nt], t1 * 64 + t0, w0, w1, w2, xv);
                GAS u32x4* op = (GAS u32x4*)(yT + (size_t)c * NTOK + b * SEQ + t1 * 64 + t0);
                const u32x4 v0 = vp[0], v1 = vp[1];
                const unsigned vw[8] = {v0.x, v0.y, v0.z, v0.w, v1.x, v1.y, v1.z, v1.w};
                unsigned ow[8];
#pragma unroll
                for (int p = 0; p < 8; ++p) {
                    const int e0 = 2 * p, e1 = 2 * p + 1;
                    const float z0 = xv[e0] * (acc[e0 & 3][nt][e0 >> 2] + bias * bflo(vw[p]));
                    const float z1 = xv[e1] * (acc[e1 & 3][nt][e1 >> 2] + bias * bfhi(vw[p]));
                    ow[p] = pk2(z0, z1); }
                op[0] = (u32x4){ow[0], ow[1], ow[2], ow[3]}; op[1] = (u32x4){ow[4], ow[5], ow[6], ow[7]};
            }
        }
        __syncthreads();
    }
}

constexpr int AK_SLOT = 16384, AV_BASE = 65536, AV_SLOT = 16384;
constexpr int AT_X = 0, AT_XROW = 132 * 4, AT_Y = 4 * 32 * AT_XROW, AT_YROW = 272;
constexpr int AT_OFS = 131072;
static_assert(AT_Y + 128 * AT_YROW <= AT_OFS && AV_BASE + 4 * AV_SLOT <= AT_OFS && AT_OFS + 512 * 16 <= LDS_MISC, "attn LDS");
#define AT_SBAR() __builtin_amdgcn_sched_barrier(0)
#define AT_PIN(x) asm volatile("" : "+v"(x))
#define AT_MFMA(a_, b_, c_) __builtin_amdgcn_mfma_f32_32x32x16_bf16(a_, b_, c_, 0, 0, 0)
#define AT_LDK(slot_, mt_, kk_) (*(const LAS bf16x8*)(pk[kk_] + ((slot_) * AK_SLOT + (mt_) * 8192)))
#define AT_LDV(slot_, ks_, mv_) (*(const LAS bf16x8*)(pv[ks_] + ((slot_) * AV_SLOT + (mv_) * 4096)))
#define AT_QTR(SRC, SP, DST, KK0, CIN, KF0, KF1, VF0, VF1, VF2, VF3, PP, PC, NK0, NK1, NKS, NKM, NKK, NV0, NV1, NV2, NV3, NVS, NVK) do { \
        float e0_, e1_, e2_, e3_, e4_, e5_, e6_, e7_; unsigned w0_, w1_, w2_, w3_; \
        DST = AT_MFMA(KF0, qf[KK0], CIN); NK0 = AT_LDK(NKS, NKM, NKK); \
        e0_ = __builtin_amdgcn_exp2f(SRC[8 * (SP)]); e1_ = __builtin_amdgcn_exp2f(SRC[8 * (SP) + 1]); AT_PIN(e0_); AT_PIN(e1_); AT_SBAR(); \
        DST = AT_MFMA(KF1, qf[(KK0) + 1], DST); NK1 = AT_LDK(NKS, NKM, (NKK) + 1); \
        e2_ = __builtin_amdgcn_exp2f(SRC[8 * (SP) + 2]); e3_ = __builtin_amdgcn_exp2f(SRC[8 * (SP) + 3]); lsum += e0_; lsum += e1_; AT_PIN(e2_); AT_PIN(e3_); AT_PIN(lsum); AT_SBAR(); \
        o[0] = AT_MFMA(VF0, PP, o[0]); NV0 = AT_LDV(NVS, NVK, 0); \
        e4_ = __builtin_amdgcn_exp2f(SRC[8 * (SP) + 4]); e5_ = __builtin_amdgcn_exp2f(SRC[8 * (SP) + 5]); lsum += e2_; lsum += e3_; AT_PIN(e4_); AT_PIN(e5_); AT_PIN(lsum); AT_SBAR(); \
        o[1] = AT_MFMA(VF1, PP, o[1]); NV1 = AT_LDV(NVS, NVK, 1); \
        e6_ = __builtin_amdgcn_exp2f(SRC[8 * (SP) + 6]); e7_ = __builtin_amdgcn_exp2f(SRC[8 * (SP) + 7]); lsum += e4_; lsum += e5_; AT_PIN(e6_); AT_PIN(e7_); AT_PIN(lsum); AT_SBAR(); \
        o[2] = AT_MFMA(VF2, PP, o[2]); NV2 = AT_LDV(NVS, NVK, 2); \
        w0_ = pk2(e0_, e1_); w1_ = pk2(e2_, e3_); lsum += e6_; lsum += e7_; AT_PIN(w0_); AT_PIN(w1_); AT_PIN(lsum); AT_SBAR(); \
        o[3] = AT_MFMA(VF3, PP, o[3]); NV3 = AT_LDV(NVS, NVK, 3); \
        w2_ = pk2(e4_, e5_); w3_ = pk2(e6_, e7_); AT_PIN(w2_); AT_PIN(w3_); AT_SBAR(); \
        PC = __builtin_bit_cast(bf16x8, (u32x4){w0_, w1_, w2_, w3_}); } while (0)

__device__ __forceinline__ void phase_attn(Frame& F, int layer) {
    const GAS bf16_t* qk = (const GAS bf16_t*)(F.ws + WS_QK); const GAS bf16_t* vT = (const GAS bf16_t*)(F.ws + WS_CHT) + (size_t)1536 * NTOK;
    GAS bf16_t* ya = (GAS bf16_t*)(F.ws + WS_YCAT) + 512;
    const float lambda_init = 0.8f - 0.6f * fast_exp(-0.3f * (float)layer);
    float lam;
    {
        const GAS float* q1 = (const GAS float*)argp(14) + layer * HD; const GAS float* k1 = (const GAS float*)argp(15) + layer * HD; const GAS float* q2 = (const GAS float*)argp(16) + layer * HD; const GAS float* k2 = (const GAS float*)argp(17) + layer * HD;
        float s1 = 0.f, s2 = 0.f;
        for (int i = 0; i < HD; ++i) { s1 += q1[i] * k1[i]; s2 += q2[i] * k2[i]; }
        lam = fast_exp(s1) - fast_exp(s2) + lambda_init;
    }
    const GAS float* subg = (const GAS float*)argp(18) + layer * DV;
    const int w = F.wave, comp = w >> 2, qs = w & 3, i = F.lane & 31, hh = F.lane >> 5;
    const int pi_i = i ^ ((((i >> 2) ^ (i >> 3)) & 1) * 12);
    {
        u32x4 ofs;
        { const int key0 = 8 * w + (F.lane >> 4), key1 = key0 + 4; ofs.x = (unsigned)(key0 * 2048 + (((F.lane & 15) ^ (key0 & 15)) << 4)); ofs.y = (unsigned)(key1 * 2048 + (((F.lane & 15) ^ (key1 & 15)) << 4));
          const int dv0 = 16 * w + (F.lane >> 3), dv1 = dv0 + 8; ofs.z = (unsigned)dv0 * (unsigned)(NTOK * 2) + (unsigned)((((F.lane & 7) ^ ((dv0 >> 1) & 7))) << 4); ofs.w = (unsigned)dv1 * (unsigned)(NTOK * 2) + (unsigned)((((F.lane & 7) ^ ((dv1 >> 1) & 7))) << 4); }
        *(LAS u32x4*)(F.lds + AT_OFS + F.tid * 16) = ofs;
    }
    const LAS uchar* pk[4]; const LAS uchar* pv[4];
#pragma unroll
    for (int kk = 0; kk < 4; ++kk) { const int ch = comp * 8 + 2 * kk + hh; pk[kk] = F.lds + (unsigned)(pi_i * 256 + ((ch ^ (pi_i & 15)) << 4)); }
#pragma unroll
    for (int ks = 0; ks < 4; ++ks) { const int cv = 2 * ks + hh; pv[ks] = F.lds + (unsigned)(AV_BASE + i * 128 + ((cv ^ ((i >> 1) & 7)) << 4)); }
    const f32x16 negMv = {0.f, 0.f, 0.f, 0.f, 0.f, 0.f, 0.f, 0.f, 0.f, 0.f, 0.f, 0.f, 0.f, 0.f, 0.f, 0.f};
#define AT_ISSUE_KV(tk_, tv_) do { const int tk2_ = (tk_) < 64 ? (tk_) : 63, tv2_ = (tv_) < 64 ? (tv_) : 63; \
        const GAS char* kb_ = kbase + (size_t)tk2_ * 131072; const GAS char* vb_ = vbase + (size_t)tv2_ * 128; asm volatile("" : "+s"(kb_), "+s"(vb_));     \
        __builtin_amdgcn_global_load_lds((const GAS unsigned*)(kb_ + ofs.x), (LAS unsigned*)(F.lds + ((tk_) & 3) * AK_SLOT + (2 * w) * 1024), 16, 0, 0); \
        __builtin_amdgcn_global_load_lds((const GAS unsigned*)(kb_ + ofs.y), (LAS unsigned*)(F.lds + ((tk_) & 3) * AK_SLOT + (2 * w + 1) * 1024), 16, 0, 0); \
        __builtin_amdgcn_global_load_lds((const GAS unsigned*)(vb_ + ofs.z), (LAS unsigned*)(F.lds + AV_BASE + ((tv_) & 3) * AV_SLOT + (2 * w) * 1024), 16, 0, 0); \
        __builtin_amdgcn_global_load_lds((const GAS unsigned*)(vb_ + ofs.w), (LAS unsigned*)(F.lds + AV_BASE + ((tv_) & 3) * AV_SLOT + (2 * w + 1) * 1024), 16, 0, 0); } while (0)
#define AT_LOAD_OFS() (ofs = *(const LAS u32x4*)(F.lds + AT_OFS + F.tid * 16))
#define AT_ISSUE_K(t_) do { const int tt_ = (t_) < 64 ? (t_) : 63; const u32x2 ofs_ = *(const LAS u32x2*)(F.lds + AT_OFS + F.tid * 16); \
        __builtin_amdgcn_global_load_lds((const GAS unsigned*)(kbase + (size_t)tt_ * 131072 + ofs_.x), (LAS unsigned*)(F.lds + ((t_) & 3) * AK_SLOT + (2 * w) * 1024), 16, 0, 0); \
        __builtin_amdgcn_global_load_lds((const GAS unsigned*)(kbase + (size_t)tt_ * 131072 + ofs_.y), (LAS unsigned*)(F.lds + ((t_) & 3) * AK_SLOT + (2 * w + 1) * 1024), 16, 0, 0); } while (0)
#define AT_ISSUE_V(t_) do { const int tt_ = (t_) < 64 ? (t_) : 63; const u32x2 ofs_ = *(const LAS u32x2*)(F.lds + AT_OFS + F.tid * 16 + 8); \
        __builtin_amdgcn_global_load_lds((const GAS unsigned*)(vbase + (size_t)tt_ * 128 + ofs_.x), (LAS unsigned*)(F.lds + AV_BASE + ((t_) & 3) * AV_SLOT + (2 * w) * 1024), 16, 0, 0); \
        __builtin_amdgcn_global_load_lds((const GAS unsigned*)(vbase + (size_t)tt_ * 128 + ofs_.y), (LAS unsigned*)(F.lds + AV_BASE + ((t_) & 3) * AV_SLOT + (2 * w + 1) * 1024), 16, 0, 0); } while (0)
#define AT_TILE(t_, S_, N_) do { \
        if ((t_) > 0) { asm volatile("s_waitcnt vmcnt(4)\n\ts_barrier" ::: "memory"); } \
        AT_ISSUE_KV((t_) + 3, (t_) + 2); \
          \
        AT_QTR(sA, 0, sB, 0, negMv, kx0, kx1, vx0, vx1, vx2, vx3, pp, pc, ky0, ky1, S_, 1, 2, vy0, vy1, vy2, vy3, S_, 0); \
          \
        AT_QTR(sA, 1, sB, 2, sB, ky0, ky1, vy0, vy1, vy2, vy3, pc, pp, kx0, kx1, N_, 0, 0, vx0, vx1, vx2, vx3, S_, 1); \
          \
        AT_QTR(sB, 0, sA, 0, negMv, kx0, kx1, vx0, vx1, vx2, vx3, pp, pc, ky0, ky1, N_, 0, 2, vy0, vy1, vy2, vy3, S_, 2); \
          \
        AT_QTR(sB, 1, sA, 2, sA, ky0, ky1, vy0, vy1, vy2, vy3, pc, pp, kx0, kx1, N_, 1, 0, vx0, vx1, vx2, vx3, S_, 3); \
        AT_LOAD_OFS();        \
    } while (0)
    for (int r = 0; r < 4; ++r) {
        int bh, qb;
        if (F.G == 256) { bh = (F.bid & 7) + 8 * r; qb = F.bid >> 3; }
        else { const int u = F.bid + r * F.G; if (u >= 1024) break; bh = u >> 5; qb = u & 31; }
        const int b = bh >> 2, h = bh & 3;
        const size_t row0 = (size_t)b * SEQ;
        const GAS char* kbase = (const GAS char*)(qk + row0 * 1024 + 512 + h * 128);
        const GAS char* vbase = (const GAS char*)(vT + (size_t)(h * 128) * NTOK + row0);
        AT_ISSUE_K(0); AT_ISSUE_K(1); AT_ISSUE_V(0); AT_ISSUE_K(2); AT_ISSUE_V(1);
        bf16x8 qf[4];
        { const GAS bf16_t* qp = qk + (row0 + qb * 128 + qs * 32 + i) * 1024 + h * 128 + comp * 64 + 8 * hh;
#pragma unroll
          for (int kk = 0; kk < 4; ++kk) qf[kk] = *(const GAS bf16x8*)(qp + 16 * kk); }
        f32x16 o[4];
#pragma unroll
        for (int m = 0; m < 4; ++m)
#pragma unroll
            for (int e = 0; e < 16; ++e) o[m][e] = 0.f;
        float lsum = 0.f;
        asm volatile("s_waitcnt vmcnt(0)\n\ts_barrier" ::: "memory");
        f32x16 sA, sB;
        bf16x8 kx0, kx1, vx0, vx1, vx2, vx3, ky0, ky1, vy0, vy1, vy2, vy3, pp, pc;
        sA = negMv;
#pragma unroll
        for (int kk = 0; kk < 4; ++kk) sA = AT_MFMA(AT_LDK(0, 0, kk), qf[kk], sA);
        kx0 = AT_LDK(0, 1, 0); kx1 = AT_LDK(0, 1, 1);
        vx0 = AT_LDV(0, 3, 0); vx1 = AT_LDV(0, 3, 1); vx2 = AT_LDV(0, 3, 2); vx3 = AT_LDV(0, 3, 3);
        pp = (bf16x8){0, 0, 0, 0, 0, 0, 0, 0}; pc = pp; sB = negMv;
        u32x4 ofs; AT_LOAD_OFS();
        for (int t = 0; t < 64; t += 4) {
            AT_TILE(t, 0, 1); AT_TILE(t + 1, 1, 2); AT_TILE(t + 2, 2, 3); AT_TILE(t + 3, 3, 0);
        }
        o[0] = AT_MFMA(vx0, pp, o[0]); o[1] = AT_MFMA(vx1, pp, o[1]); o[2] = AT_MFMA(vx2, pp, o[2]); o[3] = AT_MFMA(vx3, pp, o[3]);
        asm volatile("s_waitcnt vmcnt(0)\n\ts_barrier" ::: "memory");
        const float ltot = lsum + xor32(lsum);
        const float inv = (comp ? lam : 1.0f) * __builtin_amdgcn_rcpf(ltot);
        if (comp == 1) {
#pragma unroll
            for (int mv = 0; mv < 4; ++mv)
#pragma unroll
                for (int g = 0; g < 4; ++g) { const int dv = 32 * mv + 8 * g + 4 * hh;
                    *(LAS f32x4*)(F.lds + AT_X + (qs * 32 + i) * AT_XROW + dv * 4) = (f32x4){o[mv][4 * g] * inv, o[mv][4 * g + 1] * inv, o[mv][4 * g + 2] * inv, o[mv][4 * g + 3] * inv}; }
        }
        __syncthreads();
        if (comp == 0) {
            float ss = 0.f;
#pragma unroll
            for (int mv = 0; mv < 4; ++mv)
#pragma unroll
                for (int g = 0; g < 4; ++g) { const int dv = 32 * mv + 8 * g + 4 * hh;
                    const f32x4 x = *(const LAS f32x4*)(F.lds + AT_X + (qs * 32 + i) * AT_XROW + dv * 4);
#pragma unroll
                    for (int j = 0; j < 4; ++j) { const float v = o[mv][4 * g + j] * inv - x[j]; o[mv][4 * g + j] = v; ss += v * v; } }
            ss += xor32(ss);
            const float rn = (1.0f - lambda_init) * __builtin_amdgcn_rsqf(ss * (1.0f / DV) + RMS_EPS);
#pragma unroll
            for (int mv = 0; mv < 4; ++mv)
#pragma unroll
                for (int g = 0; g < 4; ++g) { const int dv = 32 * mv + 8 * g + 4 * hh; const f32x4 gg = *(const GAS f32x4*)(subg + dv);
                    u32x2 wv; wv.x = pk2(o[mv][4 * g] * rn * gg.x, o[mv][4 * g + 1] * rn * gg.y); wv.y = pk2(o[mv][4 * g + 2] * rn * gg.z, o[mv][4 * g + 3] * rn * gg.w);
                    *(LAS u32x2*)(F.lds + AT_Y + (qs * 32 + i) * AT_YROW + dv * 2) = wv; }
        }
        __syncthreads();
#pragma unroll
        for (int p2 = 0; p2 < 4; ++p2) { const int p = F.tid + 512 * p2, qq = p >> 4, c8 = p & 15;
            *(GAS u32x4*)(ya + (row0 + qb * 128 + qq) * 1024 + h * 128 + c8 * 8) = *(const LAS u32x4*)(F.lds + AT_Y + qq * AT_YROW + c8 * 16); }
        __syncthreads();
    }
#undef AT_ISSUE_K
#undef AT_ISSUE_KV
#undef AT_LOAD_OFS
#undef AT_ISSUE_V
#undef AT_TILE
}
template <bool F8> __device__ __forceinline__ void phase_norm_router(Frame& F, const bf16_t* x, const float* g, typename OutT<F8>::t* h2) {
    const GAS float* wr = (const GAS float*)argp(26);
    GAS int* topi = (GAS int*)(F.ws + WS_TOPI); GAS float* topw = (GAS float*)(F.ws + WS_TOPW); GAS int* counts = (GAS int*)(F.ws + WS_COUNTS);
    LAS int* hist = (LAS int*)(F.lds + 65536);
    for (int rb = F.bid; rb < 256; rb += F.G) {
        if (F.tid < 8) hist[F.tid] = 0;
        __syncthreads();
        int ln = F.lane; asm volatile("" : "+v"(ln));
        f32x4 wreg[2][8][2], gg[2][2];
#pragma unroll
        for (int j = 0; j < 2; ++j) { gg[j][0] = ((const GAS f32x4*)g)[2 * ln + 128 * j]; gg[j][1] = ((const GAS f32x4*)g)[2 * ln + 128 * j + 1];
#pragma unroll
            for (int t = 0; t < 8; ++t) { const GAS f32x4* wp = (const GAS f32x4*)(wr + (size_t)(512 * j + 8 * ln + t) * 8); wreg[j][t][0] = wp[0]; wreg[j][t][1] = wp[1]; } }
        const bool b0 = (ln & 1) != 0, b1 = (ln & 2) != 0, b2 = (ln & 4) != 0;
        const int m0 = rb * 128 + F.wave * 16;
        u32x4 nx[2];
#pragma unroll
        for (int j = 0; j < 2; ++j) nx[j] = ((const GAS u32x4*)(x + (size_t)m0 * XR_LD) + ln)[64 * j];
#pragma clang loop unroll(disable)
        for (int rr = 0; rr < 16; ++rr) {
            const int m = m0 + rr, mn = m + (rr < 15 ? 1 : 0);
            const u32x4 cw[2] = {nx[0], nx[1]};
#pragma unroll
            for (int j = 0; j < 2; ++j) nx[j] = ((const GAS u32x4*)(x + (size_t)mn * XR_LD) + ln)[64 * j];
            float v[2][8]; float s = 0.f;
#pragma unroll
            for (int j = 0; j < 2; ++j) { const u32x4 w = cw[j]; v[j][0] = bflo(w.x); v[j][1] = bfhi(w.x); v[j][2] = bflo(w.y); v[j][3] = bfhi(w.y); v[j][4] = bflo(w.z); v[j][5] = bfhi(w.z); v[j][6] = bflo(w.w); v[j][7] = bfhi(w.w);
#pragma unroll
                for (int e = 0; e < 8; ++e) s += v[j][e] * v[j][e]; }
            const float r = __builtin_amdgcn_rsqf(wave_sum(s) * (1.0f / DM) + RMS_EPS);
            float lg[8];
#pragma unroll
            for (int e = 0; e < 8; ++e) lg[e] = 0.f;
            typename OutT<F8>::t* o8 = h2 + (size_t)m * (F8 ? P8 : DM);
#pragma unroll
            for (int j = 0; j < 2; ++j) { const f32x4 ga = gg[j][0], gb = gg[j][1]; float hv[8];
                hv[0] = v[j][0] * r * ga.x; hv[1] = v[j][1] * r * ga.y; hv[2] = v[j][2] * r * ga.z; hv[3] = v[j][3] * r * ga.w; hv[4] = v[j][4] * r * gb.x; hv[5] = v[j][5] * r * gb.y; hv[6] = v[j][6] * r * gb.z; hv[7] = v[j][7] * r * gb.w;
                if constexpr (F8) ((GAS u32x2*)o8 + ln)[64 * j] = (u32x2){pk4_f8(clamp_f8(hv[0] * F8_SH), clamp_f8(hv[1] * F8_SH), clamp_f8(hv[2] * F8_SH), clamp_f8(hv[3] * F8_SH)), pk4_f8(clamp_f8(hv[4] * F8_SH), clamp_f8(hv[5] * F8_SH), clamp_f8(hv[6] * F8_SH), clamp_f8(hv[7] * F8_SH))};
                else ((GAS u32x4*)o8 + ln)[64 * j] = (u32x4){pk2(hv[0], hv[1]), pk2(hv[2], hv[3]), pk2(hv[4], hv[5]), pk2(hv[6], hv[7])};
#pragma unroll
                for (int t = 0; t < 8; ++t) { const f32x4 wa = wreg[j][t][0], wb = wreg[j][t][1]; const float hx = hv[t];
                    lg[0] += hx * wa.x; lg[1] += hx * wa.y; lg[2] += hx * wa.z; lg[3] += hx * wa.w; lg[4] += hx * wb.x; lg[5] += hx * wb.y; lg[6] += hx * wb.z; lg[7] += hx * wb.w; } }
            float q4[4], q2[2], q1;
#pragma unroll
            for (int i = 0; i < 4; ++i) { const float keep = b0 ? lg[i + 4] : lg[i], send = b0 ? lg[i] : lg[i + 4]; q4[i] = keep + xor_swz<1>(send); }
#pragma unroll
            for (int i = 0; i < 2; ++i) { const float keep = b1 ? q4[i + 2] : q4[i], send = b1 ? q4[i] : q4[i + 2]; q2[i] = keep + xor_swz<2>(send); }
            { const float keep = b2 ? q2[1] : q2[0], send = b2 ? q2[0] : q2[1]; q1 = keep + xor_swz<4>(send); }
            q1 += xor_swz<8>(q1); q1 += xor_swz<16>(q1); q1 += xor32(q1);
#pragma unroll
            for (int e = 0; e < 8; ++e) lg[e] = __builtin_bit_cast(float, __builtin_amdgcn_readlane(__builtin_bit_cast(int, q1), ((e >> 2) & 1) | (((e >> 1) & 1) << 1) | ((e & 1) << 2)));
            int i0 = 0; float v0 = lg[0];
#pragma unroll
            for (int e = 1; e < 8; ++e) if (lg[e] > v0) { v0 = lg[e]; i0 = e; }
            int i1 = -1; float v1 = -3.0e38f;
#pragma unroll
            for (int e = 0; e < 8; ++e) if (e != i0 && lg[e] > v1) { v1 = lg[e]; i1 = e; }
            if (ln == 0) { const float e1 = fast_exp(v1 - v0), w0 = __builtin_amdgcn_rcpf(1.0f + e1);
                topi[2 * m] = i0; topi[2 * m + 1] = i1; topw[2 * m] = w0; topw[2 * m + 1] = e1 * w0;
                atomicAdd((int*)&hist[i0], 1); atomicAdd((int*)&hist[i1], 1); }
        }
        __syncthreads();
        if (F.tid < 8) counts[rb * 8 + F.tid] = hist[F.tid];
        __syncthreads();
    }
    GAS int* tokof = (GAS int*)(F.ws + WS_TOKOF);
    for (int i = F.bid * NTHR + F.tid; i < PSLOTS; i += F.G * NTHR) tokof[i] = -1;
}
constexpr int MOE_TAB = 140000, MOE_TOKL = 144 * 1024;
static_assert(MOE_TOKL + 12 * 1024 <= LDS_MISC, "moe lds");
__device__ __forceinline__ void moe_tables(Frame& F) {
    const GAS int* counts = (const GAS int*)(F.ws + WS_COUNTS);
    LAS int* tab = (LAS int*)(F.lds + MOE_TAB);
    __syncthreads();
    if (F.tid < 8) tab[F.tid] = 0;
    __syncthreads();
    for (int i = F.tid; i < 2048; i += NTHR) atomicAdd((int*)&tab[i & 7], counts[i]);
    __syncthreads();
    if (F.tid == 0) { int off = 0; for (int e = 0; e < 8; ++e) { tab[8 + e] = off; const int np = (tab[e] + 255) >> 8; for (int p = 0; p < np; ++p) tab[32 + (off >> 8) + p] = e; off += np << 8; } tab[16] = off >> 8; }
    __syncthreads();
}
__device__ __forceinline__ void phase_moe_assign(Frame& F) {
    const GAS int* counts = (const GAS int*)(F.ws + WS_COUNTS); const GAS int* topi = (const GAS int*)(F.ws + WS_TOPI);
    GAS int* slotof = (GAS int*)(F.ws + WS_SLOT); GAS int* tokof = (GAS int*)(F.ws + WS_TOKOF);
    moe_tables(F);
    LAS int* tab = (LAS int*)(F.lds + MOE_TAB);
    LAS int* sc = (LAS int*)(F.lds + 65536);
    for (int rb = F.bid; rb < 256; rb += F.G) {
        if (F.tid < 8) sc[F.tid] = tab[8 + F.tid];
        __syncthreads();
        for (int i2 = F.tid; i2 < rb * 8; i2 += NTHR) atomicAdd((int*)&sc[i2 & 7], counts[i2]);
        int e = -1, rank = 0;
        if (F.tid < 256) { e = topi[rb * 256 + F.tid];
            for (int ee = 0; ee < 8; ++ee) { const unsigned long long mk = __ballot(e == ee); if (e == ee) rank = __popcll(mk & ((1ull << F.lane) - 1ull)); if (F.lane == 0) sc[8 + F.wave * 8 + ee] = __popcll(mk); } }
        __syncthreads();
        if (F.tid < 256) { int pre = 0; for (int w2 = 0; w2 < F.wave; ++w2) pre += sc[8 + w2 * 8 + e];
            const int slot = sc[e] + pre + rank; const int tok = rb * 128 + (F.tid >> 1);
            slotof[rb * 256 + F.tid] = slot; tokof[slot] = tok; }
        __syncthreads();
    }
}
constexpr int REM_SLOT0 = 256 * 256;
__device__ __forceinline__ void phase_moe_combine(Frame& F, int bid0) {
    const GAS int* slotof = (const GAS int*)(F.ws + WS_SLOT); const GAS float* topw = (const GAS float*)(F.ws + WS_TOPW); const GAS bf16_t* yp = (const GAS bf16_t*)(F.ws + WS_XP);
    const int gw = (F.bid - bid0) * NWAVES + F.wave, NGW = (F.G - bid0) * NWAVES;
    int sa0, sa1; float wa0, wa1;
    u32x4 x0, x1, a0, a1, b0, b1; float w0 = 0.f, w1 = 0.f;
#define CMB_A(tok_) do { const int t_ = (tok_) < NTOK ? (tok_) : NTOK - 1; sa0 = slotof[2 * t_]; sa1 = slotof[2 * t_ + 1]; wa0 = topw[2 * t_]; wa1 = topw[2 * t_ + 1]; } while (0)
#define CMB_B(tok_) do { const int t_ = (tok_) < NTOK ? (tok_) : NTOK - 1; const int r0 = sa0 < REM_SLOT0 ? sa0 : 0, r1 = sa1 < REM_SLOT0 ? sa1 : 0;        \
        w0 = sa0 < REM_SLOT0 ? wa0 : 0.f; w1 = sa1 < REM_SLOT0 ? wa1 : 0.f; \
        const GAS u32x4* xp = (const GAS u32x4*)((const GAS bf16_t*)F.out + (size_t)t_ * XR_LD) + 2 * F.lane;       \
        const GAS u32x4* ap = (const GAS u32x4*)(yp + (size_t)r0 * DM) + 2 * F.lane; const GAS u32x4* bp = (const GAS u32x4*)(yp + (size_t)r1 * DM) + 2 * F.lane; \
        x0 = xp[0]; x1 = xp[1]; a0 = ap[0]; a1 = ap[1]; b0 = bp[0]; b1 = bp[1]; } while (0)
    if (gw >= NTOK) return;
    CMB_A(gw); CMB_B(gw); CMB_A(gw + NGW);
    for (int tok = gw; tok < NTOK; tok += NGW) {
        const unsigned xw[8] = {x0.x, x0.y, x0.z, x0.w, x1.x, x1.y, x1.z, x1.w}, aw[8] = {a0.x, a0.y, a0.z, a0.w, a1.x, a1.y, a1.z, a1.w}, bw[8] = {b0.x, b0.y, b0.z, b0.w, b1.x, b1.y, b1.z, b1.w};
        float o[16];
#pragma unroll
        for (int p = 0; p < 8; ++p) { o[2 * p] = bflo(xw[p]) + w0 * bflo(aw[p]) + w1 * bflo(bw[p]); o[2 * p + 1] = bfhi(xw[p]) + w0 * bfhi(aw[p]) + w1 * bfhi(bw[p]); }
        __builtin_amdgcn_sched_barrier(0);
        CMB_B(tok + NGW);
        CMB_A(tok + 2 * NGW);
        __builtin_amdgcn_sched_barrier(0);
        GAS f32x4* op = (GAS f32x4*)(F.out + (size_t)tok * DM) + 4 * F.lane;
#pragma unroll
        for (int p = 0; p < 4; ++p) op[p] = (f32x4){o[4 * p], o[4 * p + 1], o[4 * p + 2], o[4 * p + 3]};
    }
#undef CMB_A
#undef CMB_B
}
__device__ __forceinline__ void phase_moe_fixup(Frame& F, int np) {
    const GAS int* slotof = (const GAS int*)(F.ws + WS_SLOT); const GAS int* tokof = (const GAS int*)(F.ws + WS_TOKOF); const GAS float* topw = (const GAS float*)(F.ws + WS_TOPW); const GAS bf16_t* yp = (const GAS bf16_t*)(F.ws + WS_XP);
    const int gw = F.bid * NWAVES + F.wave, NGW = F.G * NWAVES;
    for (int s = REM_SLOT0 + gw; s < np * 256; s += NGW) {
        const int tok = tokof[s]; if (tok < 0) continue;
        const int sa = slotof[2 * tok], sb = slotof[2 * tok + 1]; const int k = (sa == s) ? 0 : 1; const int other = k ? sa : sb;
        if (other >= REM_SLOT0 && other < s) continue;
        const float wk = topw[2 * tok + k], wo = other >= REM_SLOT0 ? topw[2 * tok + 1 - k] : 0.f; const int ro = other >= REM_SLOT0 ? other : s;
        const GAS u32x4* ap = (const GAS u32x4*)(yp + (size_t)s * DM) + 2 * F.lane; const GAS u32x4* bp = (const GAS u32x4*)(yp + (size_t)ro * DM) + 2 * F.lane;
        const u32x4 a0 = ap[0], a1 = ap[1], b0 = bp[0], b1 = bp[1];
        const unsigned aw[8] = {a0.x, a0.y, a0.z, a0.w, a1.x, a1.y, a1.z, a1.w}, bw[8] = {b0.x, b0.y, b0.z, b0.w, b1.x, b1.y, b1.z, b1.w};
        GAS f32x4* op = (GAS f32x4*)(F.out + (size_t)tok * DM) + 4 * F.lane;
#pragma unroll
        for (int p = 0; p < 4; ++p) { f32x4 o = op[p];
            o.x += wk * bflo(aw[2 * p]) + wo * bflo(bw[2 * p]); o.y += wk * bfhi(aw[2 * p]) + wo * bfhi(bw[2 * p]); o.z += wk * bflo(aw[2 * p + 1]) + wo * bflo(bw[2 * p + 1]); o.w += wk * bfhi(aw[2 * p + 1]) + wo * bfhi(bw[2 * p + 1]);
            op[p] = o; }
    }
}
constexpr int NPL = 16, NPHASE = 2 * NPL;
constexpr bool F8M = FP8_MOE != 0;
constexpr int MOE_DMK = F8M ? DM / 2 : DM, MOE_FFK = F8M ? FFP / 2 : FFP, MOE_EB = F8M ? 1 : 2;
constexpr int INP = I8_INPROJ ? 2 : 0;
constexpr int DUP = I8_DENSE_UP ? 2 : (FP8_DENSE ? 1 : 0);
constexpr bool DDN8 = FP8_DENSE != 0;
constexpr int INP_DMK = INP ? DM / 2 : DM, DUP_DMK = DUP ? DM / 2 : DM, DDN_FFK = DDN8 ? FFP / 2 : FFP;
static_assert(!(I8_INPROJ || I8_DENSE_UP) || FP8_MOE, "the int8 weights live where the bf16 MoE activations would end");
typedef OutT<F8M>::t moe_t; typedef OutT<(DUP == 1)>::t dgu_t; typedef OutT<DDN8>::t ddn_t;
struct Args { const float* in[30]; float* out; uchar* ws; int ph_lo, ph_hi, li, use_bar; };

__global__ void __launch_bounds__(NTHR, 2) mk_fwd(Args args) {
    extern __shared__ __attribute__((aligned(16))) uchar lds_raw[];
    Frame F;
    F.lds = (LAS uchar*)lds_raw;
    F.tid = threadIdx.x; F.lane = F.tid & 63; F.wave = __builtin_amdgcn_readfirstlane(F.tid >> 6);
    const int wave_s = F.wave;
    F.G = gridDim.x; F.bid = blockIdx.x;
    F.ws = args.ws; F.ctl = (unsigned*)(args.ws + WS_CTL); F.out = args.out;
    volatile LAS unsigned* misc = (volatile LAS unsigned*)(F.lds + LDS_MISC);
    if (F.tid < 64) misc[F.tid] = 0u;
    __syncthreads();
    XcdBarrier bar; bar.bar = F.ctl + CW_BAR + args.li * XCD_BAR_WORDS; bar.x = 0; bar.st = misc + 8;
    if (args.use_bar) bar = xcd_barrier_post(F.ctl + CW_BAR + args.li * XCD_BAR_WORDS, misc + 8);
    const int lo = args.ph_lo, hi = args.ph_hi;
    bool started = false;
#define PH_BEGIN(id) if (lo <= (id) && (id) < hi) { if (started) xcd_barrier(bar); started = true; \
    { int ws_ = wave_s; asm volatile("" : "+s"(ws_)); int ln_; asm volatile("v_mbcnt_lo_u32_b32 %0, -1, 0\n\tv_mbcnt_hi_u32_b32 %0, -1, %0" : "=v"(ln_));     F.lane = ln_; F.wave = ws_; F.tid = ws_ * 64 + ln_; \
      int b_ = blockIdx.x, g_ = gridDim.x; uchar* w_ = args.ws; float* o_ = args.out; asm volatile("" : "+s"(b_), "+s"(g_), "+s"(w_), "+s"(o_)); ASSUME_GLOBAL(w_); ASSUME_GLOBAL(o_); F.bid = b_; F.G = g_; F.ws = w_; F.out = o_; F.ctl = (unsigned*)w_; }
#define PH_END }
#define RELOAD_ID() do { int ws_ = wave_s; asm volatile("" : "+s"(ws_)); int ln_; asm volatile("v_mbcnt_lo_u32_b32 %0, -1, 0\n\tv_mbcnt_hi_u32_b32 %0, -1, %0" : "=v"(ln_));     F.lane = ln_; F.wave = ws_; F.tid = ws_ * 64 + ln_; } while (0)
#ifndef REP_ID
#define REP_ID -1
#endif
#ifndef REP_N
#define REP_N 1
#endif
#define REPEAT(id) RELOAD_ID(); for (int rep_ = 0; rep_ < ((id) == REP_ID ? REP_N : 1); ++rep_)
#define SITE(id, ...) { RELOAD_ID(); __VA_ARGS__ } if (REP_ID >= 0 && REP_ID == (id)) { { __VA_ARGS__ } { __VA_ARGS__ } }
#if DBG_CHECKS
#define CHK(x) x
#else
#define CHK(x)
#endif

    for (int layer = 0; layer < 2; ++layer) {
        const int pb = layer * NPL;
#define WSM (F.ws + WS_WSMALL + (size_t)layer * WSMALL_STRIDE)
#define WtokT ((bf16_t*)(WSM + OFF_WTOK))
#define WchT ((bf16_t*)(WSM + OFF_WCH))
#define PhT ((bf16_t*)(WSM + OFF_PH))
#define PaT ((bf16_t*)(WSM + OFF_PA))
#define WoutT ((bf16_t*)(WSM + OFF_WOUT))
#define hbuf ((bf16_t*)(F.ws + WS_H))
#define XR ((bf16_t*)F.out)
        const bool moe = (layer & 1) != 0;

        PH_BEGIN(pb + 0)
            CHK(if (layer == 1) chk_dense_down(F, 12); xcd_barrier(bar);)
            if (layer == 0) {
                for (int l2 = 0; l2 < 2; ++l2) { uchar* w2 = F.ws + WS_WSMALL + (size_t)l2 * WSMALL_STRIDE;
                    conv_win(F, argp(2) + (size_t)l2 * DM * INW, (bf16_t*)(w2 + OFF_WTOK), (bf16_t*)(w2 + OFF_WCH));
                    conv_plain(F, argp(19) + (size_t)l2 * HW * DM, HW, DM, (bf16_t*)(w2 + OFF_PH), DM);
                    conv_plain(F, argp(20) + (size_t)l2 * HW * DM, HW, DM, (bf16_t*)(w2 + OFF_PH) + HW, DM);
                    conv_plain(F, argp(21) + (size_t)l2 * DM * DM, DM, DM, (bf16_t*)(w2 + OFF_WOUT), DM); }
                conv_ffn<(DUP == 1), DDN8>(F, argp(23), argp(24), argp(25), (dgu_t*)(F.ws + WS_WGU), (ddn_t*)(F.ws + WS_WD), 1);
                rope_tables(F);
            }
            if (layer == 0) phase_norm<INP>(F, argp(0), argp(1) + layer * DM, (OutT<(INP != 0)>::t*)(F.ws + WS_H), (float*)(F.ws + WS_SH));
            else phase_norm_bf<INP>(F, XR, argp(1) + layer * DM, (OutT<(INP != 0)>::t*)(F.ws + WS_H), (float*)(F.ws + WS_SH));
            phase_hdn(F, layer);
        PH_END
        if (layer == 0 && (INP == 2 || DUP == 2)) {
            PH_BEGIN(pb + 1)
                if (INP == 2) for (int l2 = 0; l2 < 2; ++l2) { uchar* w2 = F.ws + WS_WSMALL + (size_t)l2 * WSMALL_STRIDE;
                    quant_rows(F, (const bf16_t*)(w2 + OFF_WTOK), F.ws + WS_I8W + l2 * I8W_LAYER, (float*)(F.ws + WS_SW) + l2 * SW_LAYER, 3072);
                    quant_rows(F, (const bf16_t*)(w2 + OFF_WCH), F.ws + WS_I8W + l2 * I8W_LAYER + I8W_CH, (float*)(F.ws + WS_SW) + l2 * SW_LAYER + 3072, 2048); }
                if (DUP == 2) quant_rows(F, (const bf16_t*)(F.ws + WS_WGU), F.ws + WS_I8W + I8W_DENSE, (float*)(F.ws + WS_SW) + SW_DENSE, 5632);
            PH_END
        }
        PH_BEGIN(pb + 2)
            CHK(if (layer == 0) chk_norm(F, argp(0), argp(1) + layer * DM, hbuf, layer * 13 + 1); xcd_barrier(bar);)
            SITE(pb + 1, const bf16_t* wtk = INP == 2 ? (const bf16_t*)(F.ws + WS_I8W + layer * I8W_LAYER) : WtokT; const float* sw = (const float*)(F.ws + WS_SW) + layer * SW_LAYER;
              pg8::Gemm g{hbuf, wtk, NTOK, 3072, INP_DMK, INP == 2 ? P8 : 0, INP == 2 ? P8 : 0}; pg8::StaticOrder S; S.init(NTOK, 3072, F.G, F.bid);
              pg8::EpiTok<INP> E{(bf16_t*)(F.ws + WS_QK), (uchar*)(F.ws + WS_GATES), argp(12) + layer * HD, argp(13) + layer * HD, (const bf16_t*)(F.ws + WS_ROPE), (const bf16_t*)(F.ws + WS_ROPE) + SEQ * 32, (const float*)(F.ws + WS_SH), sw};
              pg8::gemm_phase(F.lds, g, S, E, F.tid);)
            SITE(300 + pb + 1, const bf16_t* wch = INP == 2 ? (const bf16_t*)(F.ws + WS_I8W + layer * I8W_LAYER + I8W_CH) : WchT; const float* sw = (const float*)(F.ws + WS_SW) + layer * SW_LAYER + 3072;
              pg8::Gemm g{wch, hbuf, 2048, NTOK, INP_DMK, INP == 2 ? P8 : 0, INP == 2 ? P8 : 0}; pg8::StaticOrder S; S.init(2048, NTOK, F.G, F.bid);
              pg8::EpiBf16<INP> E{(bf16_t*)(F.ws + WS_CHT), NTOK, 0, 1.0f, sw, (const float*)(F.ws + WS_SH)};
              pg8::gemm_phase(F.lds, g, S, E, F.tid);)
            REPEAT(pb + 2) phase_fimg(F, layer);
        PH_END
        PH_BEGIN(pb + 3)
            CHK(chk_inproj(F, layer, layer * 13 + 2); chk_qkprep(F, layer, layer * 13 + 3); chk_fimg(F, layer, layer * 13 + 5); xcd_barrier(bar);)
            REPEAT(100 + pb + 3) phase_hyena(F, layer);
            REPEAT(200 + pb + 3) phase_attn(F, layer);
        PH_END
        PH_BEGIN(pb + 4)
            CHK(chk_hyena(F, layer, layer * 13 + 6); chk_attn(F, layer, layer * 13 + 7); xcd_barrier(bar);)
            REPEAT(pb + 4) phase_transpose_y(F);
        PH_END
        PH_BEGIN(pb + 5)
            CHK(chk_transpose(F, layer * 13 + 8); xcd_barrier(bar);)
            SITE(pb + 5, pg8::Gemm g{(const bf16_t*)(F.ws + WS_YCAT), PhT, NTOK, DM, DM}; pg8::StaticOrder S; S.init(NTOK, DM, F.G, F.bid);
              pg8::EpiMergeF E{(bf16_t*)(F.ws + WS_MERGED), (const uchar*)(F.ws + WS_GATES)};
              pg8::gemm_phase(F.lds, g, S, E, F.tid);)
        PH_END
        PH_BEGIN(pb + 6)
            CHK(chk_merge(F, layer, layer * 13 + 9); xcd_barrier(bar);)
            SITE(pb + 6, pg8::Gemm g{(const bf16_t*)(F.ws + WS_MERGED), WoutT, NTOK, DM, DM}; pg8::StaticOrder S; S.init(NTOK, DM, F.G, F.bid);
              if (layer == 0) { pg8::EpiRes<true> E{argp(0), XR, 1.0f}; pg8::gemm_phase(F.lds, g, S, E, F.tid); }
              else { pg8::EpiRes<false> E{nullptr, XR, 1.0f}; pg8::gemm_phase(F.lds, g, S, E, F.tid); })
        PH_END
        PH_BEGIN(pb + 7)
            CHK(if (layer == 0) chk_outproj(F, layer, 10); xcd_barrier(bar);)
            if (!moe) phase_norm_bf<DUP>(F, XR, argp(22) + layer * DM, (OutT<(DUP != 0)>::t*)(F.ws + WS_H), (float*)(F.ws + WS_SH));
            else {
                phase_norm_router<F8M>(F, XR, argp(22) + layer * DM, (moe_t*)(F.ws + WS_H2_MOE));
                REPEAT(pb + 7) conv_ffn<F8M>(F, argp(27), argp(28), argp(29), (moe_t*)(F.ws + WS_MOE_WGU), (moe_t*)(F.ws + WS_MOE_WD), NEXP);
            }
        PH_END
        if (!moe) {
            PH_BEGIN(pb + 9)
                SITE(pb + 9, pg8::Gemm g{hbuf, (const bf16_t*)(F.ws + (DUP == 2 ? WS_I8W + I8W_DENSE : WS_WGU)), NTOK, 5632, DUP_DMK, DUP == 2 ? P8 : 0, DUP == 2 ? P8 : 0}; pg8::StaticOrder S; S.init(NTOK, 5632, F.G, F.bid);
                  pg8::EpiSwiglu<DUP, DDN8> E{(bf16_t*)(F.ws + WS_ACT_DENSE), 0, (const float*)(F.ws + WS_SH), (const float*)(F.ws + WS_SW) + SW_DENSE};
                  pg8::gemm_phase(F.lds, g, S, E, F.tid);)
            PH_END
            PH_BEGIN(pb + 10)
                CHK(chk_dense_up(F, 11); xcd_barrier(bar);)
                { pg8::Gemm g{(const bf16_t*)(F.ws + WS_ACT_DENSE), (const bf16_t*)(F.ws + WS_WD), NTOK, DM, DDN_FFK}; pg8::StaticOrder S; S.init(NTOK, DM, F.G, F.bid);
                  pg8::EpiRes<false, DDN8> E{nullptr, XR, F8_DN_INV};
                  pg8::gemm_phase(F.lds, g, S, E, F.tid); }
            PH_END
        } else {
            PH_BEGIN(pb + 8)
                CHK(chk_router(F, 13 + 11); xcd_barrier(bar);)
                phase_moe_assign(F);
            PH_END
            for (int chunk = 0; chunk < 2; ++chunk) {
                PH_BEGIN(pb + 9 + 2 * chunk)
                    moe_tables(F);
                    CHK(if (chunk == 0) chk_assign(F, 13 + 12); xcd_barrier(bar);)
                    SITE(pb + 9 + 2 * chunk, const LAS int* tab = (const LAS int*)(F.lds + MOE_TAB); const int p0 = chunk * 128;
                      pg8::Gemm g{(const bf16_t*)(F.ws + WS_H2_MOE), (const bf16_t*)(F.ws + WS_MOE_WGU), 128 * 256, 5632, MOE_DMK, F8M ? P8 : 0, F8M ? P8 : 0};
                      pg8::MoeGatherOrder S; S.init(128 * 256, 5632, F.G, F.bid); S.p0 = p0; S.pexp = tab + 32; S.estride = F8M ? (long)5632 * P8 : (long)5632 * DM * 2; S.tokof = (const int*)(F.ws + WS_TOKOF); S.fill_tokl((LAS int*)(F.lds + MOE_TOKL), F.tid);
                      pg8::EpiSwiglu<(F8M ? 1 : 0), F8M> E{(bf16_t*)(F.ws + WS_ACT_MOE), p0, nullptr, nullptr};
                      pg8::gemm_phase(F.lds, g, S, E, F.tid);)
                    if (chunk == 1) {
                      SITE(pb + 14, const LAS int* tab = (const LAS int*)(F.lds + MOE_TAB); const int np = tab[16], nm = np - 256;
                        pg8::Gemm g{(const bf16_t*)(F.ws + WS_H2_MOE), (const bf16_t*)(F.ws + WS_MOE_WGU), nm * 256, 5632, MOE_DMK, F8M ? P8 : 0, F8M ? P8 : 0};
                        pg8::MoeGatherOrder S; S.init(nm * 256, 5632, F.G, F.bid); S.p0 = 256; S.pexp = tab + 32; S.estride = F8M ? (long)5632 * P8 : (long)5632 * DM * 2; S.tokof = (const int*)(F.ws + WS_TOKOF); S.fill_tokl((LAS int*)(F.lds + MOE_TOKL), F.tid);
                        pg8::EpiSwiglu<(F8M ? 1 : 0), F8M> E{(bf16_t*)(F.ws + WS_ACT_MOE), 128, nullptr, nullptr};
                        pg8::gemm_phase(F.lds, g, S, E, F.tid);)
                    }
                PH_END
                PH_BEGIN(pb + 10 + 2 * chunk)
                    moe_tables(F);
                    SITE(pb + 10 + 2 * chunk, const LAS int* tab = (const LAS int*)(F.lds + MOE_TAB); const int p0 = chunk * 128;
                      pg8::Gemm g{(const bf16_t*)(F.ws + WS_ACT_MOE) - (size_t)p0 * 256 * MOE_FFK, (const bf16_t*)(F.ws + WS_MOE_WD), 128 * 256, DM, MOE_FFK};
                      pg8::MoeOrder S; S.init(128 * 256, DM, F.G, F.bid); S.p0 = p0; S.pexp = tab + 32; S.estride = (long)DM * FFP * MOE_EB;
                      pg8::EpiBf16<(F8M ? 1 : 0)> E{(bf16_t*)(F.ws + WS_XP), DM, 0, F8_DN_INV, nullptr, nullptr};
                      pg8::gemm_phase(F.lds, g, S, E, F.tid);)
                PH_END
            }
            PH_BEGIN(pb + 13)
                CHK(chk_moe_ffn(F, 13 + 13); xcd_barrier(bar);)
                moe_tables(F);
                if (F.G >= 64 && F.bid < 32) {
                    SITE(pb + 13, const LAS int* tab = (const LAS int*)(F.lds + MOE_TAB); const int np = tab[16], nm = np - 256;
                      pg8::Gemm g{(const bf16_t*)(F.ws + WS_ACT_MOE) - (size_t)128 * 256 * MOE_FFK, (const bf16_t*)(F.ws + WS_MOE_WD), nm * 256, DM, MOE_FFK};
                      pg8::MoeOrder S; S.init(nm * 256, DM, 32, F.bid); S.p0 = 256; S.pexp = tab + 32; S.estride = (long)DM * FFP * MOE_EB;
                      pg8::EpiBf16<(F8M ? 1 : 0)> E{(bf16_t*)(F.ws + WS_XP), DM, 0, F8_DN_INV, nullptr, nullptr};
                      pg8::gemm_phase(F.lds, g, S, E, F.tid);)
                } else if (F.G >= 64) phase_moe_combine(F, 32);
                else {
                    { const LAS int* tab = (const LAS int*)(F.lds + MOE_TAB); const int np = tab[16], nm = np - 256;
                      pg8::Gemm g{(const bf16_t*)(F.ws + WS_ACT_MOE) - (size_t)128 * 256 * MOE_FFK, (const bf16_t*)(F.ws + WS_MOE_WD), nm * 256, DM, MOE_FFK};
                      pg8::MoeOrder S; S.init(nm * 256, DM, F.G, F.bid); S.p0 = 256; S.pexp = tab + 32; S.estride = (long)DM * FFP * MOE_EB;
                      pg8::EpiBf16<(F8M ? 1 : 0)> E{(bf16_t*)(F.ws + WS_XP), DM, 0, F8_DN_INV, nullptr, nullptr};
                      pg8::gemm_phase(F.lds, g, S, E, F.tid); }
                    phase_moe_combine(F, 0);
                }
            PH_END
            PH_BEGIN(pb + 15)
                moe_tables(F);
                { const LAS int* tab = (const LAS int*)(F.lds + MOE_TAB); phase_moe_fixup(F, tab[16]); }
            PH_END
        }
    }
#if DBG_CHECKS
    if (hi == NPHASE) { if (started) xcd_barrier(bar); dbg_report(F); }
#endif
#undef PH_BEGIN
#undef PH_END
#undef WSM
#undef WtokT
#undef WchT
#undef PhT
#undef PaT
#undef WoutT
#undef hbuf
#undef XR
}

#ifndef MK_SPLIT
#define MK_SPLIT 0
#endif
extern "C" void kernel_launch(void* const* d_in, const int* in_sizes, int n_in, void* d_out, int out_size, void* d_ws, size_t ws_size, hipStream_t stream) {
    static int grid = 0;
    if (grid == 0) {
        if (n_in != 30 || out_size != NTOK * DM || ws_size < WS_NEED) { fprintf(stderr, "kernel_launch: unexpected sizes n_in %d out %d ws %zu\n", n_in, out_size, ws_size); grid = -1; return; }
        int dev = 0, cus = 0, per_cu = 0;
        if (hipGetDevice(&dev) != hipSuccess || hipDeviceGetAttribute(&cus, hipDeviceAttributeMultiprocessorCount, dev) != hipSuccess) { grid = -1; return; }
        if (hipFuncSetAttribute((const void*)mk_fwd, hipFuncAttributeMaxDynamicSharedMemorySize, LDS_BYTES) != hipSuccess) { fprintf(stderr, "kernel_launch: hipFuncSetAttribute failed\n"); grid = -1; return; }
        if (hipOccupancyMaxActiveBlocksPerMultiprocessor(&per_cu, (const void*)mk_fwd, NTHR, LDS_BYTES) != hipSuccess || per_cu < 1) { fprintf(stderr, "kernel_launch: occupancy query says %d\n", per_cu); }
        (void)hipGetLastError();
        grid = cus;
    }
    if (grid < 0) return;
    (void)hipMemsetAsync((char*)d_ws + WS_CTL, 0, CTL_ZERO_BYTES, stream);
    Args a{};
    for (int i = 0; i < 30; ++i) a.in[i] = (const float*)d_in[i];
    a.out = (float*)d_out; a.ws = (uchar*)d_ws;
#if MK_SPLIT
    int li = 0;
    for (int p = 0; p < NPHASE; ++p) { a.ph_lo = p; a.ph_hi = p + 1; a.li = 0; a.use_bar = 0; (void)li;
        hipLaunchKernelGGL(mk_fwd, dim3(grid), dim3(NTHR), LDS_BYTES, stream, a); }
#else
    a.ph_lo = 0; a.ph_hi = NPHASE; a.li = 0; a.use_bar = 1;
    hipLaunchKernelGGL(mk_fwd, dim3(grid), dim3(NTHR), LDS_BYTES, stream, a);
#endif
}
```

```cpp
#include <hip/hip_runtime.h>
#include <cstdio>
#include <cstdint>

#define GAS __attribute__((address_space(1)))
#define LAS __attribute__((address_space(3)))
typedef unsigned short bf16_t;
typedef unsigned char uchar;
typedef short bf16x8 __attribute__((ext_vector_type(8)));
typedef short bf16x4 __attribute__((ext_vector_type(4)));
typedef float f32x2 __attribute__((ext_vector_type(2)));
typedef float f32x4 __attribute__((ext_vector_type(4)));
typedef float f32x16 __attribute__((ext_vector_type(16)));
typedef unsigned u32x4 __attribute__((ext_vector_type(4)));
typedef unsigned u32x2 __attribute__((ext_vector_type(2)));

#if defined(__HIP_DEVICE_COMPILE__)
#define ASSUME_GLOBAL(p) __builtin_assume(!__builtin_amdgcn_is_shared((const __attribute__((address_space(0))) void*)(p)) && !__builtin_amdgcn_is_private((const __attribute__((address_space(0))) void*)(p)))
#else
#define ASSUME_GLOBAL(p) ((void)0)
#endif
#ifndef DBG_CHECKS
#define DBG_CHECKS 0
#endif

constexpr int NB = 8, SEQ = 4096, DM = 1024, NTOK = NB * SEQ;
constexpr int HW = 512, INW = 5120, NHEAD = 4, HD = 64, DV = 128;
constexpr int DFF = 2752, FFP = 2816, NEXP = 8;
constexpr int FEMB = 33, FHID = 64;
constexpr int XR_LD = 2048;
constexpr int NPANEL_MAX = 264, PSLOTS = NPANEL_MAX * 256;
constexpr float RMS_EPS = 1e-6f;
constexpr int NWAVES = 8, NTHR = 512;
constexpr int FIMG_LEN = 8200, FIMG_BYTES = 4 * FIMG_LEN * 2;
constexpr int GIMG_LEN = 8320;

constexpr size_t MiB = 1u << 20, KiB = 1u << 10;
constexpr size_t WS_CTL = 0, CTL_ZERO_BYTES = 256 * KiB;
constexpr size_t WS_COUNTS = 512 * KiB;
constexpr size_t WS_ROPE = 1 * MiB;
constexpr size_t WS_HDN = 2 * MiB;
constexpr size_t WS_TOPI = 4 * MiB, WS_TOPW = WS_TOPI + 256 * KiB, WS_SLOT = WS_TOPW + 256 * KiB, WS_TOKOF = WS_SLOT + 256 * KiB;
constexpr size_t WS_WSMALL = 6 * MiB, WSMALL_STRIDE = 14 * MiB;
constexpr size_t OFF_WTOK = 0, OFF_WCH = 6 * MiB, OFF_PH = 10 * MiB, OFF_PA = 11 * MiB, OFF_WOUT = 12 * MiB;
constexpr size_t WS_WGU = 34 * MiB, WS_WD = 45 * MiB;
constexpr size_t WS_H = 51 * MiB;
constexpr size_t WS_YCAT = 51 * MiB, WS_YT = 452 * MiB;
constexpr size_t WS_QK = 115 * MiB;
constexpr size_t WS_GATES = 179 * MiB;
constexpr size_t WS_CHT = 307 * MiB;
constexpr size_t WS_MERGED = 307 * MiB;
constexpr size_t WS_FIMG = 435 * MiB;
constexpr size_t WS_ACT_DENSE = 115 * MiB;
constexpr size_t WS_MOE_WGU = 51 * MiB, WS_MOE_WD = 139 * MiB;
constexpr size_t WS_XP = 183 * MiB;
constexpr size_t WS_ACT_MOE = 315 * MiB;
constexpr size_t WS_H2_MOE = 251 * MiB;
constexpr size_t WS_SH = 5 * MiB + 512 * KiB;
constexpr size_t WS_SW = 5 * MiB + 640 * KiB;
constexpr size_t WS_I8W = 484 * MiB;
constexpr int SW_LAYER = 5120, SW_DENSE = 2 * SW_LAYER;
constexpr int P8 = 1152;
constexpr size_t I8W_LAYER = 6 * MiB, I8W_CH = 3 * MiB + 512 * KiB, I8W_DENSE = 2 * I8W_LAYER;
static_assert((size_t)3072 * P8 <= I8W_CH && I8W_CH + (size_t)2048 * P8 <= I8W_LAYER && WS_I8W + I8W_DENSE + (size_t)5632 * P8 <= 512 * MiB && WS_SW + (size_t)(SW_DENSE + 5632) * 4 <= 6 * MiB, "int8 weights / scales");
constexpr size_t WS_NEED = 512 * MiB;
static_assert(WS_FIMG + (size_t)2 * 512 * GIMG_LEN * 2 <= 512 * MiB, "fimg");
static_assert(WS_ACT_MOE + (size_t)136 * 256 * FFP * 2 <= 512 * MiB, "act moe");
static_assert(WS_MOE_WD + (size_t)8 * 1024 * FFP * 2 <= WS_XP, "moe wd");

constexpr int CW_DBG = 64;
constexpr int CW_BAR = 4096;

constexpr int LDS_BYTES = 163840;
constexpr int LDS_MISC = 160 * 1024 - 256;

__device__ __forceinline__ unsigned f2bf(float f) { unsigned u = __builtin_bit_cast(unsigned, f); return (u + 0x7fffu + ((u >> 16) & 1u)) >> 16; }
typedef __bf16 bf16x2v __attribute__((ext_vector_type(2)));
__device__ __forceinline__ unsigned pk2(float lo, float hi) { const f32x2 v = {lo, hi}; return __builtin_bit_cast(unsigned, __builtin_convertvector(v, bf16x2v)); }
__device__ __forceinline__ float bf2f(unsigned short b) { return __builtin_bit_cast(float, ((unsigned)b) << 16); }
__device__ __forceinline__ float bflo(unsigned w) { return __builtin_bit_cast(float, w << 16); }
__device__ __forceinline__ float bfhi(unsigned w) { return __builtin_bit_cast(float, w & 0xffff0000u); }
template <int M> __device__ __forceinline__ float xor_swz(float v) { return __builtin_bit_cast(float, __builtin_amdgcn_ds_swizzle(__builtin_bit_cast(int, v), (M << 10) | 0x1f)); }
__device__ __forceinline__ float xor32(float v) { const unsigned u = __builtin_bit_cast(unsigned, v);
    const auto r = __builtin_amdgcn_permlane32_swap(u, u, false, false);
    return __builtin_bit_cast(float, r[0] ^ r[1] ^ u); }
__device__ __forceinline__ float wave_sum(float v) {
    v += xor_swz<1>(v); v += xor_swz<2>(v); v += xor_swz<4>(v); v += xor_swz<8>(v); v += xor_swz<16>(v); v += xor32(v);
    return v;
}
__device__ __forceinline__ float fast_sin(float x) { return __builtin_amdgcn_sinf(x * 0.15915494309f); }
__device__ __forceinline__ float sin_rev(float r) { return __builtin_amdgcn_sinf(__builtin_amdgcn_fractf(r)); }
__device__ __forceinline__ float cos_rev(float r) { return __builtin_amdgcn_cosf(__builtin_amdgcn_fractf(r)); }
__device__ __forceinline__ float fast_exp(float x) { return __builtin_amdgcn_exp2f(x * 1.44269504089f); }
__device__ __forceinline__ float fast_sigmoid(float x) { return __builtin_amdgcn_rcpf(1.0f + __builtin_amdgcn_exp2f(-1.44269504089f * x)); }
#ifndef FP8_MOE
#define FP8_MOE 1
#endif
#ifndef FP8_DENSE
#define FP8_DENSE 1
#endif
typedef int i32x4 __attribute__((ext_vector_type(4)));
typedef int i32x8 __attribute__((ext_vector_type(8)));
constexpr float F8_SH = 16.0f, F8_SWGU = 64.0f, F8_SACT = 8.0f, F8_SWD = 128.0f;
constexpr float F8_UP_INV = 1.0f / (F8_SH * F8_SWGU), F8_DN_INV = 1.0f / (F8_SACT * F8_SWD);
__device__ __forceinline__ unsigned pk4_f8(float a, float b, float c, float d) { const int w = __builtin_amdgcn_cvt_pk_fp8_f32(a, b, 0, false); return (unsigned)__builtin_amdgcn_cvt_pk_fp8_f32(c, d, w, true); }
__device__ __forceinline__ float clamp_f8(float x) { return __builtin_amdgcn_fmed3f(x, -448.0f, 448.0f); }
__device__ __forceinline__ void mfma_f8(f32x4& c, const i32x8 a, const i32x8 b) { asm volatile("v_mfma_f32_16x16x128_f8f6f4 %0, %1, %2, %0" : "+v"(c) : "v"(a), "v"(b)); }
#define F8_ACC_SETTLE() asm volatile("s_nop 15\n\ts_nop 15" ::: "memory")
#ifndef I8_INPROJ
#define I8_INPROJ 1
#endif
#ifndef I8_DENSE_UP
#define I8_DENSE_UP 1
#endif
__device__ __forceinline__ float wave_max(float v) {
    v = fmaxf(v, xor_swz<1>(v)); v = fmaxf(v, xor_swz<2>(v)); v = fmaxf(v, xor_swz<4>(v)); v = fmaxf(v, xor_swz<8>(v)); v = fmaxf(v, xor_swz<16>(v)); v = fmaxf(v, xor32(v));
    return v;
}
__device__ __forceinline__ unsigned pk4_i8(float a, float b, float c, float d) {
    const int ia = (int)__builtin_rintf(a), ib = (int)__builtin_rintf(b), ic = (int)__builtin_rintf(c), id = (int)__builtin_rintf(d);
    return ((unsigned)ia & 255u) | (((unsigned)ib & 255u) << 8) | (((unsigned)ic & 255u) << 16) | ((unsigned)id << 24);
}
template <bool F8> struct OutT { typedef bf16_t t; };
template <> struct OutT<true> { typedef uchar t; };

#define XB_TMO      128
#define XB_XCNT(j)  (256  + 64 * (j))
#define XB_XSUB(j)  (1280 + 64 * (j))
#define XB_XGEN(j)  (2304 + 64 * (j))
#define XB_TOP      3328
#define XB_TOPGEN   3392
#define XCD_BAR_WORDS 3456
#define XB_SPIN_CAP (1u << 18)

__device__ __forceinline__ unsigned xb_ld(unsigned* p)              { return __hip_atomic_load(p, __ATOMIC_RELAXED, __HIP_MEMORY_SCOPE_AGENT); }
__device__ __forceinline__ unsigned xb_add(unsigned* p, unsigned v) { return __hip_atomic_fetch_add(p, v, __ATOMIC_RELAXED, __HIP_MEMORY_SCOPE_AGENT); }
__device__ __forceinline__ unsigned xb_xcc_id() { return (unsigned)__builtin_amdgcn_s_getreg((3 << 11) | 20) & 0xFu; }
#define XB_SPIN(cond, bar) do { unsigned _sp = 0; while (cond) { __builtin_amdgcn_s_sleep(1); \
    if ((++_sp & 255u) == 0u) { if (xb_ld(&(bar)[XB_TMO])) break; if (_sp > XB_SPIN_CAP) { atomicAdd(&(bar)[XB_TMO], 1u); break; } } } } while (0)

struct XcdBarrier {
    unsigned* bar; unsigned x;
    volatile LAS unsigned* st;
};

__device__ __forceinline__ XcdBarrier xcd_barrier_post(unsigned* bar, volatile LAS unsigned* st) {
    XcdBarrier b; b.bar = bar; b.x = xb_xcc_id(); b.st = st;
    if (threadIdx.x == 0) (void)xb_add(&bar[XB_XCNT(b.x)], 1u);
    return b;
}
__device__ __forceinline__ void xcd_barrier_complete(unsigned* bar, unsigned x, unsigned& nloc, unsigned& nx) {
    const unsigned G = gridDim.x * gridDim.y * gridDim.z;
    unsigned sum, cnt, mine, sp = 0u;
    for (;;) {
        sum = 0u; cnt = 0u; mine = 0u;
#pragma unroll
        for (unsigned j = 0; j < 16; ++j) { const unsigned c = xb_ld(&bar[XB_XCNT(j)]); sum += c; cnt += (c > 0u) ? 1u : 0u; mine = (j == x) ? c : mine; }
        if (sum == G) break;
        __builtin_amdgcn_s_sleep(1);
        if ((++sp & 255u) == 0u) { if (xb_ld(&bar[XB_TMO])) break; if (sp > XB_SPIN_CAP) { atomicAdd(&bar[XB_TMO], 1u); break; } }
    }
    nloc = mine > 0u ? mine : 1u; nx = cnt > 0u ? cnt : 1u;
}

__device__ __forceinline__ void xcd_barrier(const XcdBarrier& b) {
    asm volatile("s_waitcnt vmcnt(0)" ::: "memory");
    __syncthreads();
    if (threadIdx.x == 0) {
        unsigned* bar = b.bar;
        __builtin_amdgcn_s_waitcnt(0);
        unsigned nloc = b.st[0], nx = b.st[1];
        if (nloc == 0u) { xcd_barrier_complete(bar, b.x, nloc, nx); b.st[0] = nloc; b.st[1] = nx; }
        const unsigned old = xb_add(&bar[XB_XSUB(b.x)], 1u);
        const unsigned gen = old / nloc;
        if (old + 1u == (gen + 1u) * nloc) {
            __builtin_amdgcn_fence(__ATOMIC_RELEASE, "agent");
            asm volatile("s_waitcnt vmcnt(0)" ::: "memory");
            const unsigned og = xb_add(&bar[XB_TOP], 1u);
            const unsigned tg = og / nx;
            if (og + 1u == (tg + 1u) * nx) xb_add(&bar[XB_TOPGEN], 1u);
            else XB_SPIN(xb_ld(&bar[XB_TOPGEN]) == tg, bar);
            __builtin_amdgcn_fence(__ATOMIC_ACQUIRE, "agent");
            xb_add(&bar[XB_XGEN(b.x)], 1u);
            asm volatile("s_waitcnt vmcnt(0)" ::: "memory");
        } else {
            XB_SPIN(xb_ld(&bar[XB_XGEN(b.x)]) == gen, bar);
            __builtin_amdgcn_fence(__ATOMIC_ACQUIRE, "agent");
            asm volatile("s_waitcnt vmcnt(0)" ::: "memory");
        }
    }
    __syncthreads();
}

namespace pg8 {
constexpr int BM = 256, BK = 64, HALF = 128, HTB = HALF * BK * 2  , STAGE_BYTES = 8 * HTB, NXCD = 8, WGM = 8;
__host__ __device__ __forceinline__ int lds_byte(int r, int c) { const int st = (r >> 4) * 2 + (c >> 5), rr = r & 15, cc = c & 31, ob = rr * 64 + cc * 2; return st * 1024 + (ob ^ (((ob >> 9) & 1) << 5)); }
__host__ __device__ __forceinline__ void stage_rc(int b, int& R, int& C) { const int st = b / 1024, sb = b % 1024, swz = sb ^ (((sb >> 9) & 1) << 5); R = (st >> 1) * 16 + swz / 64; C = (st & 1) * 32 + (swz % 64) / 2; }
__host__ __device__ __forceinline__ int perm32(int rho) { const int n = rho >> 4, i = rho & 15; return 8 * (i >> 2) + 4 * n + (i & 3); }

struct Unit { int pm, pn; long boff; };
struct Gemm { const bf16_t* A; const bf16_t* Bt; int M, N, K; int lda = 0, ldb = 0; };

struct StaticOrder {
    static constexpr bool GATHER = false;
    int nM, nN, nwg, G, c;
    __device__ void init(int M, int N, int G_, int c_) { nM = M / BM; nN = N / BM; nwg = nM * nN; G = G_; c = c_; }
    __device__ bool next(int i, Unit& u) const {
        const long L = (long)i * G + c; if (L >= nwg) return false;
        int wgid = (int)L; { const int q = nwg / NXCD, r = nwg % NXCD, xcd = wgid % NXCD, off = wgid / NXCD; wgid = (xcd < r ? xcd * (q + 1) : r * (q + 1) + (xcd - r) * q) + off; }
        const int nig = WGM * nN, gid = wgid / nig, fm = gid * WGM, gsz = (nM - fm) < WGM ? (nM - fm) : WGM;
        u.pm = fm + ((wgid % nig) % gsz); u.pn = (wgid % nig) / gsz; u.boff = 0; return true;
    }
};
struct MoeOrder : StaticOrder {
    int p0; const LAS int* pexp; long estride;
    __device__ bool next(int i, Unit& u) const { if (!StaticOrder::next(i, u)) return false; u.pm += p0; u.boff = (long)pexp[u.pm] * estride; return true; }
};

struct MoeGatherOrder : MoeOrder {
    static constexpr bool GATHER = true;
    const int* tokof;
    const LAS int* tokl;
    __device__ __forceinline__ unsigned rowtok(int li, int r) const { return (unsigned)tokl[li * 256 + r]; }
    __device__ __forceinline__ void fill_tokl(LAS int* dst, int tid) { Unit u; for (int i = 0; next(i, u); ++i) if (tid < 256) { const int t = ((const GAS int*)tokof)[u.pm * BM + tid]; dst[i * 256 + tid] = t < 0 ? 0 : t; }
        tokl = dst; __syncthreads(); }
};

template <class Epi, class Sched>
__device__ __forceinline__ void gemm_phase(LAS unsigned char* lds, const Gemm g, const Sched& S, const Epi& E, const int tid) {
    const int wid = __builtin_amdgcn_readfirstlane(tid >> 6), lane = tid & 63, wr = wid >> 2, wc = wid & 3, fr = lane & 15, fq = lane >> 4;
    const int K = g.K, nt = K / BK, lda = g.lda ? g.lda : 2 * K, ldb = g.ldb ? g.ldb : 2 * K;
    unsigned voffA[2], voffB[2];
#pragma unroll
    for (int i = 0; i < 2; ++i) { int R, C; stage_rc(tid * 16 + i * 8192, R, C); const int Rb = Epi::PERM ? ((R & ~31) + perm32(R & 31)) : R;
        voffA[i] = (unsigned)(R * lda + C * 2); voffB[i] = (unsigned)(Rb * ldb + C * 2); }
    const size_t kstep = (size_t)(BK * 2);
    const size_t hstepA = (size_t)HALF * lda, hstepB = (size_t)HALF * ldb;
    const size_t tstepA = 2 * hstepA, tstepB = 2 * hstepB;
    const unsigned ldsw = (unsigned)wid * 1024u;
    const int aoff = lds_byte(wr * 64 + fr, fq * 8), boff = lds_byte(wc * 32 + fr, fq * 8);
#define PG8_SA(b, h) (((b) * 2 + (h)) * HTB)
#define PG8_SB(b, h) ((4 + (b) * 2 + (h)) * HTB)
#define PG8_STAGE(bufoff, gbase, voff) do { const char* gb_ = (const char*)(gbase); if constexpr (Epi::FP8) asm volatile("" : "+s"(gb_));     \
        _Pragma("unroll") for (int _i = 0; _i < 2; ++_i) \
        __builtin_amdgcn_global_load_lds((const unsigned*)(gb_ + (voff)[_i]), (LAS unsigned*)(lds + (bufoff) + ldsw + _i * 8192), 16, 0, 0); } while (0)
#define PG8_LDA(dst, b, h) do { _Pragma("unroll") for (int m = 0; m < 4; ++m) _Pragma("unroll") for (int k = 0; k < 2; ++k) dst[m][k] = *(const LAS bf16x8*)(lds + PG8_SA(b, h) + aoff + m * 2048 + k * 1024); } while (0)
#define PG8_LDB(dst, b, h) do { _Pragma("unroll") for (int n = 0; n < 2; ++n) _Pragma("unroll") for (int k = 0; k < 2; ++k) dst[n][k] = *(const LAS bf16x8*)(lds + PG8_SB(b, h) + boff + n * 2048 + k * 1024); } while (0)
#define PG8_CAT(x_, y_) __builtin_shufflevector(__builtin_bit_cast(i32x4, x_), __builtin_bit_cast(i32x4, y_), 0, 1, 2, 3, 4, 5, 6, 7)
#define PG8_MMA(ai, bj, At, Bt) do { __builtin_amdgcn_s_setprio(1); _Pragma("unroll") for (int m = 0; m < 4; ++m) _Pragma("unroll") for (int n = 0; n < 2; ++n) { \
        if constexpr (Epi::FP8) mfma_f8(acc[ai][bj][m][n], PG8_CAT(Bt[n][0], Bt[n][1]), PG8_CAT(At[m][0], At[m][1])); \
        else if constexpr (Epi::I8) { _Pragma("unroll") for (int k = 0; k < 2; ++k) acc[ai][bj][m][n] = __builtin_bit_cast(f32x4, __builtin_amdgcn_mfma_i32_16x16x64_i8(__builtin_bit_cast(i32x4, Bt[n][k]), __builtin_bit_cast(i32x4, At[m][k]), __builtin_bit_cast(i32x4, acc[ai][bj][m][n]), 0, 0, 0)); } \
        else { _Pragma("unroll") for (int k = 0; k < 2; ++k) acc[ai][bj][m][n] = __builtin_amdgcn_mfma_f32_16x16x32_bf16(Bt[n][k], At[m][k], acc[ai][bj][m][n], 0, 0, 0); } } \
        __builtin_amdgcn_s_setprio(0); } while (0)
#define PG8_WAIT_V(n) asm volatile("s_waitcnt vmcnt(" #n ")" ::: "memory")
#define PG8_WAIT_L(n) asm volatile("s_waitcnt lgkmcnt(" #n ")" ::: "memory")
#define PG8_BAR __builtin_amdgcn_s_barrier()
#define PG8_SCHED __builtin_amdgcn_sched_barrier(0)
#define PG8_KBODY \
            const bool last = (t == nt - 2); \
            const char* a1 = cA + (size_t)(t + 1) * kstep; \
            const char* a2 = last ? nA : cA + (size_t)(t + 2) * kstep; const char* b2 = last ? nB : cB + (size_t)(t + 2) * kstep; \
            const char* a3 = a2 + kstep; const char* b3 = b2 + kstep; const size_t k2b = last ? (size_t)0 : (size_t)(t + 2) * kstep; \
            PG8_LDB(B0, 0, 0); PG8_SCHED; PG8_LDA(At, 0, 0); PG8_STAGE_A(PG8_SA(1, 1), a1, 1, false, (size_t)(t + 1) * kstep); \
            PG8_WAIT_L(8); PG8_BAR; PG8_WAIT_L(0); PG8_MMA(0, 0, At, B0); PG8_BAR; PG8_SCHED; \
            PG8_LDB(B1, 0, 1); PG8_STAGE(PG8_SB(0, 0), b2, voffB); \
            PG8_BAR; PG8_WAIT_L(0); PG8_MMA(0, 1, At, B1); PG8_BAR; \
            PG8_LDA(At, 0, 1); PG8_STAGE_A(PG8_SA(0, 0), a2, 0, last, k2b); \
            PG8_BAR; PG8_WAIT_L(0); PG8_MMA(1, 0, At, B0); PG8_BAR; PG8_SCHED; \
            PG8_STAGE(PG8_SB(0, 1), b2 + hstepB, voffB); \
            PG8_WAIT_V(6); PG8_BAR; PG8_MMA(1, 1, At, B1); PG8_BAR; \
            PG8_LDB(B0, 1, 0); PG8_SCHED; PG8_LDA(At, 1, 0); PG8_STAGE_A(PG8_SA(0, 1), a2, 1, last, k2b); \
            PG8_WAIT_L(8); PG8_BAR; PG8_WAIT_L(0); PG8_MMA(0, 0, At, B0); PG8_BAR; PG8_SCHED; \
            PG8_LDB(B1, 1, 1); PG8_STAGE(PG8_SB(1, 0), b3, voffB); \
            PG8_BAR; PG8_WAIT_L(0); PG8_MMA(0, 1, At, B1); PG8_BAR; \
            PG8_LDA(At, 1, 1); PG8_STAGE_A(PG8_SA(1, 0), a3, 0, last, k2b + kstep); \
            PG8_BAR; PG8_WAIT_L(0); PG8_MMA(1, 0, At, B0); PG8_BAR; PG8_SCHED; \
            PG8_STAGE(PG8_SB(1, 1), b3 + hstepB, voffB); \
            PG8_WAIT_V(6); PG8_BAR; PG8_MMA(1, 1, At, B1); PG8_BAR;
    constexpr bool GATHER = Sched::GATHER;
    unsigned vgC[2][2], vgN[2][2];
#define PG8_GOFFS(dst, unit_, li_) do { if constexpr (GATHER) { _Pragma("unroll") for (int h_ = 0; h_ < 2; ++h_) _Pragma("unroll") for (int i_ = 0; i_ < 2; ++i_) { int R_, C_; stage_rc(tid * 16 + i_ * 8192, R_, C_); \
        dst[h_][i_] = S.rowtok(li_, h_ * HALF + R_) * (unsigned)lda + (unsigned)C_ * 2u; } } } while (0)
#define PG8_STAGE_A(bufoff, ptr_, h_, use_next_, kbyte_) do { if constexpr (GATHER) { _Pragma("unroll") for (int _i = 0; _i < 2; ++_i) \
        __builtin_amdgcn_global_load_lds((const unsigned*)((const char*)g.A + (kbyte_) + ((use_next_) ? vgN[h_][_i] : vgC[h_][_i])), (LAS unsigned*)(lds + (bufoff) + ldsw + _i * 8192), 16, 0, 0); } \
        else { PG8_STAGE(bufoff, (ptr_) + (h_) * hstepA, voffA); } } while (0)
    Unit cur, nxt; int ui = 0;
    if (!S.next(0, cur)) return;
    f32x4 acc[2][2][4][2];
#pragma unroll
    for (int a = 0; a < 2; ++a)
#pragma unroll
        for (int b = 0; b < 2; ++b)
#pragma unroll
            for (int m = 0; m < 4; ++m)
#pragma unroll
                for (int n = 0; n < 2; ++n) acc[a][b][m][n] = (f32x4){0.f, 0.f, 0.f, 0.f};
    bf16x8 At[4][2], B0[2][2], B1[2][2];
    const char* cA = (const char*)g.A + (size_t)cur.pm * tstepA; const char* cB = (const char*)g.Bt + cur.boff + (size_t)cur.pn * tstepB;
    PG8_GOFFS(vgC, cur, 0);
    PG8_STAGE(PG8_SB(0, 0), cB, voffB); PG8_STAGE_A(PG8_SA(0, 0), cA, 0, false, (size_t)0); PG8_STAGE(PG8_SB(0, 1), cB + hstepB, voffB); PG8_STAGE_A(PG8_SA(0, 1), cA, 1, false, (size_t)0);
    if (wr == 1) PG8_BAR;
    PG8_WAIT_V(4); PG8_BAR;
    PG8_STAGE(PG8_SB(1, 0), cB + kstep, voffB); PG8_STAGE_A(PG8_SA(1, 0), cA + kstep, 0, false, kstep); PG8_STAGE(PG8_SB(1, 1), cB + hstepB + kstep, voffB);
    PG8_WAIT_V(6); PG8_BAR;
    for (;;) {
        const bool has_next = S.next(ui + 1, nxt);
        if (has_next) PG8_GOFFS(vgN, nxt, ui + 1); else { if constexpr (GATHER) { _Pragma("unroll") for (int h_ = 0; h_ < 2; ++h_) _Pragma("unroll") for (int i_ = 0; i_ < 2; ++i_) vgN[h_][i_] = vgC[h_][i_]; } }
        const char* nA = has_next ? (const char*)g.A + (size_t)nxt.pm * tstepA : cA; const char* nB = has_next ? (const char*)g.Bt + nxt.boff + (size_t)nxt.pn * tstepB : cB;
        if constexpr (Epi::MID_T > 0) {
#pragma clang loop unroll(disable)
            for (int part = 0; part < 2; ++part) { const int t1 = part ? nt : Epi::MID_T;
#pragma clang loop unroll(disable)
                for (int t = part ? Epi::MID_T : 0; t < t1; t += 2) { PG8_KBODY }
                if (part == 0) E.mid(acc, cur, wr, wc, fr, fq); }
        } else if constexpr (Epi::FP8 || Epi::I8) {
#pragma clang loop unroll(disable)
            for (int t = 0; t < nt; t += 2) { PG8_KBODY }
        } else {
            for (int t = 0; t < nt; t += 2) { PG8_KBODY }
        }
        if constexpr (Epi::FP8) { F8_ACC_SETTLE();
#pragma unroll
            for (int a = 0; a < 2; ++a)
#pragma unroll
                for (int b = 0; b < 2; ++b)
#pragma unroll
                    for (int m = 0; m < 4; ++m)
#pragma unroll
                        for (int n = 0; n < 2; ++n) asm volatile("" : "+v"(acc[a][b][m][n])); }
        E(acc, cur, wr, wc, fr, fq);
        if (!has_next) break;
#pragma unroll
        for (int a = 0; a < 2; ++a)
#pragma unroll
            for (int b = 0; b < 2; ++b)
#pragma unroll
                for (int m = 0; m < 4; ++m)
#pragma unroll
                    for (int n = 0; n < 2; ++n) acc[a][b][m][n] = (f32x4){0.f, 0.f, 0.f, 0.f};
        cur = nxt; cA = nA; cB = nB; ++ui;
        if constexpr (GATHER) { _Pragma("unroll") for (int h_ = 0; h_ < 2; ++h_) _Pragma("unroll") for (int i_ = 0; i_ < 2; ++i_) vgC[h_][i_] = vgN[h_][i_]; }
    }
    PG8_WAIT_V(0);
    if (wr == 0) PG8_BAR;
    PG8_BAR;
#undef PG8_KBODY
#undef PG8_GOFFS
#undef PG8_STAGE_A
#undef PG8_SA
#undef PG8_SB
#undef PG8_STAGE
#undef PG8_LDA
#undef PG8_LDB
#undef PG8_MMA
#undef PG8_CAT
#undef PG8_WAIT_V
#undef PG8_WAIT_L
#undef PG8_BAR
#undef PG8_SCHED
}

typedef f32x4 Acc[2][2][4][2];

template <int IN> __device__ __forceinline__ f32x4 accv(const f32x4 a, const float rsv, const f32x4 c) {
    if constexpr (IN == 2) { const i32x4 q = __builtin_bit_cast(i32x4, a); return (f32x4){(float)q[0] * (rsv * c[0]), (float)q[1] * (rsv * c[1]), (float)q[2] * (rsv * c[2]), (float)q[3] * (rsv * c[3])}; }
    else return a;
}
template <int IN> __device__ __forceinline__ void col_scales(const float* cs, const Unit& u, int wc, int fq, f32x4 (&c)[2][2]) {
    if constexpr (IN == 2) { const GAS f32x4* p = (const GAS f32x4*)(cs + u.pn * BM + wc * 32 + 8 * fq);
        c[0][0] = p[0]; c[0][1] = p[1]; c[1][0] = p[HALF / 4]; c[1][1] = p[HALF / 4 + 1]; }
    else { c[0][0] = c[0][1] = c[1][0] = c[1][1] = (f32x4){1.f, 1.f, 1.f, 1.f}; }
}
template <int IN> struct EpiBf16 {
    static constexpr bool PERM = true; static constexpr int MID_T = 0; static constexpr bool FP8 = IN == 1, I8 = IN == 2;
    bf16_t* O; int ldc; int prow0; float sc; const float* rs; const float* cs;
    __device__ __forceinline__ void operator()(const Acc& acc, const Unit& u, int wr, int wc, int fr, int fq) const {
        const int row0 = (u.pm - prow0) * BM + wr * 64 + fr, col0 = u.pn * BM + wc * 32 + 8 * fq;
        f32x4 cv[2][2]; col_scales<IN>(cs, u, wc, fq, cv);
        float rsa[2][4];
#pragma unroll
        for (int ai = 0; ai < 2; ++ai)
#pragma unroll
            for (int m = 0; m < 4; ++m) { rsa[ai][m] = 1.f; if constexpr (I8) rsa[ai][m] = ((const GAS float*)rs)[u.pm * BM + wr * 64 + fr + ai * HALF + m * 16]; }
        if constexpr (I8) __builtin_amdgcn_sched_barrier(0);
#pragma unroll
        for (int ai = 0; ai < 2; ++ai)
#pragma unroll
            for (int m = 0; m < 4; ++m) { bf16_t* rowp = O + (size_t)(row0 + ai * HALF + m * 16) * ldc + col0;
                const float rsv = rsa[ai][m];
#pragma unroll
                for (int bj = 0; bj < 2; ++bj) { f32x4 v0 = accv<IN>(acc[ai][bj][m][0], rsv, cv[bj][0]), v1 = accv<IN>(acc[ai][bj][m][1], rsv, cv[bj][1]);
                    if constexpr (FP8) { v0 *= sc; v1 *= sc; }
                    u32x4 w; w.x = pk2(v0[0], v0[1]); w.y = pk2(v0[2], v0[3]); w.z = pk2(v1[0], v1[1]); w.w = pk2(v1[2], v1[3]);
                    *(GAS u32x4*)(rowp + bj * HALF) = w; } }
    }
};
template <int IN> struct EpiTok {
    static constexpr bool PERM = true; static constexpr int MID_T = 0; static constexpr bool FP8 = false, I8 = IN == 2;
    bf16_t* qk; uchar* gates; const float* qn; const float* kn; const bf16_t* ct; const bf16_t* st; const float* rs; const float* cs;
    __device__ __forceinline__ void operator()(const Acc& acc, const Unit& u, int wr, int wc, int fr_in, int fq_in) const {
        int fr = fr_in, fq = fq_in; asm volatile("" : "+v"(fr), "+v"(fq));
        const int row0 = u.pm * BM + wr * 64 + fr;
        f32x4 cv[2][2]; col_scales<IN>(cs, u, wc, fq, cv);
        if (u.pn < 4) {
            const int G = 4 * u.pn + wc; const bool isq = G < 8; const GAS float* gn = (const GAS float*)(isq ? qn : kn);
            const float post = isq ? (0.125f * 1.44269504089f) : 1.0f;
            const int i0 = 8 * fq;
            unsigned gpa[4], gpb[4];
            { const f32x4 ga0 = *(const GAS f32x4*)(gn + i0), ga1 = *(const GAS f32x4*)(gn + i0 + 4), gb0 = *(const GAS f32x4*)(gn + 32 + i0), gb1 = *(const GAS f32x4*)(gn + 36 + i0);
              gpa[0] = pk2(ga0[0], ga0[1]); gpa[1] = pk2(ga0[2], ga0[3]); gpa[2] = pk2(ga1[0], ga1[1]); gpa[3] = pk2(ga1[2], ga1[3]);
              gpb[0] = pk2(gb0[0], gb0[1]); gpb[1] = pk2(gb0[2], gb0[3]); gpb[2] = pk2(gb1[0], gb1[1]); gpb[3] = pk2(gb1[2], gb1[3]);
#pragma unroll
              for (int e = 0; e < 4; ++e) asm volatile("" : "+v"(gpa[e]), "+v"(gpb[e])); }
#pragma unroll
            for (int ai = 0; ai < 2; ++ai)
#pragma unroll
                for (int mb = 0; mb < 4; mb += 2) {
                    u32x4 cc[2], sn[2]; float rsb[2];
#pragma unroll
                    for (int mm = 0; mm < 2; ++mm) { const int row = row0 + ai * HALF + (mb + mm) * 16, l = row & (SEQ - 1);
                        cc[mm] = *(const GAS u32x4*)(ct + l * 32 + i0); sn[mm] = *(const GAS u32x4*)(st + l * 32 + i0);
                        rsb[mm] = 1.f; if constexpr (I8) rsb[mm] = ((const GAS float*)rs)[row]; }
                    __builtin_amdgcn_sched_barrier(0);
#pragma unroll
                    for (int mm = 0; mm < 2; ++mm) { const int m = mb + mm, row = row0 + ai * HALF + m * 16;
                        f32x4 xa[2][2];
#pragma unroll
                        for (int bj = 0; bj < 2; ++bj)
#pragma unroll
                            for (int n = 0; n < 2; ++n) xa[bj][n] = accv<IN>(acc[ai][bj][m][n], rsb[mm], cv[bj][n]);
                        float ss = 0.f;
#pragma unroll
                        for (int bj = 0; bj < 2; ++bj)
#pragma unroll
                            for (int n = 0; n < 2; ++n) { const f32x4 x = xa[bj][n]; ss += (x[0] * x[0] + x[1] * x[1]) + (x[2] * x[2] + x[3] * x[3]); }
                        ss += xor_swz<16>(ss); ss += xor32(ss);
                        const float r = __builtin_amdgcn_rsqf(ss * (1.0f / 64.0f) + RMS_EPS) * post;
                        float oa[8], ob[8];
#pragma unroll
                        for (int e = 0; e < 8; ++e) { const float a = xa[0][e >> 2][e & 3] * ((e & 1) ? bfhi(gpa[e >> 1]) : bflo(gpa[e >> 1])), b = xa[1][e >> 2][e & 3] * ((e & 1) ? bfhi(gpb[e >> 1]) : bflo(gpb[e >> 1]));
                            const float c = (e & 1) ? bfhi(cc[mm][e >> 1]) : bflo(cc[mm][e >> 1]), sv = (e & 1) ? bfhi(sn[mm][e >> 1]) : bflo(sn[mm][e >> 1]);
                            oa[e] = (a * c - b * sv) * r; ob[e] = (a * sv + b * c) * r; }
                        GAS bf16_t* rowp = (GAS bf16_t*)qk + (size_t)row * 1024 + 64 * G + i0;
                        *(GAS u32x4*)(rowp) = (u32x4){pk2(oa[0], oa[1]), pk2(oa[2], oa[3]), pk2(oa[4], oa[5]), pk2(oa[6], oa[7])};
                        *(GAS u32x4*)(rowp + 32) = (u32x4){pk2(ob[0], ob[1]), pk2(ob[2], ob[3]), pk2(ob[4], ob[5]), pk2(ob[6], ob[7])}; }
                    __builtin_amdgcn_sched_barrier(0);
                }
        } else {
            const int col0 = (u.pn - 4) * HALF + wc * 32 + 8 * fq;
            float rsa[2][4];
#pragma unroll
            for (int ai = 0; ai < 2; ++ai)
#pragma unroll
                for (int m = 0; m < 4; ++m) { rsa[ai][m] = 1.f; if constexpr (I8) rsa[ai][m] = ((const GAS float*)rs)[row0 + ai * HALF + m * 16]; }
            if constexpr (I8) __builtin_amdgcn_sched_barrier(0);
#pragma unroll
            for (int ai = 0; ai < 2; ++ai)
#pragma unroll
                for (int m = 0; m < 4; ++m) {
                    const float rsv = rsa[ai][m];
                    f32x4 xa[2][2];
#pragma unroll
                    for (int bj = 0; bj < 2; ++bj)
#pragma unroll
                        for (int n = 0; n < 2; ++n) xa[bj][n] = accv<IN>(acc[ai][bj][m][n], rsv, cv[bj][n]);
                    unsigned qh[8], qa[8];
#pragma unroll
                    for (int e = 0; e < 8; ++e) { qh[e] = (unsigned)(fast_sigmoid(xa[0][e >> 2][e & 3]) * 255.0f + 0.5f); qa[e] = (unsigned)(fast_sigmoid(xa[1][e >> 2][e & 3]) * 255.0f + 0.5f); }
                    u32x4 w; w.x = qh[0] | (qh[1] << 8) | (qh[2] << 16) | (qh[3] << 24); w.y = qh[4] | (qh[5] << 8) | (qh[6] << 16) | (qh[7] << 24);
                    w.z = qa[0] | (qa[1] << 8) | (qa[2] << 16) | (qa[3] << 24); w.w = qa[4] | (qa[5] << 8) | (qa[6] << 16) | (qa[7] << 24);
                    *(GAS u32x4*)((GAS uchar*)gates + (size_t)(row0 + ai * HALF + m * 16) * 2048 + (size_t)col0 * 2) = w; }
        }
    }
};
__device__ __forceinline__ float ub0(unsigned w) { return (float)(w & 0xffu); }
__device__ __forceinline__ float ub1(unsigned w) { return (float)((w >> 8) & 0xffu); }
__device__ __forceinline__ float ub2(unsigned w) { return (float)((w >> 16) & 0xffu); }
__device__ __forceinline__ float ub3(unsigned w) { return (float)(w >> 24); }
struct EpiMergeF {
    static constexpr bool PERM = true; static constexpr int MID_T = 8; static constexpr bool FP8 = false, I8 = false;
    bf16_t* merged; const uchar* gates;
    __device__ __forceinline__ void mid(Acc& acc, const Unit& u, int wr, int wc, int fr_in, int fq_in) const {
        int fr = fr_in, fq = fq_in; asm volatile("" : "+v"(fr), "+v"(fq));
        const int row0 = u.pm * BM + wr * 64 + fr, col0 = u.pn * BM + wc * 32 + 8 * fq;
#pragma unroll
        for (int ai = 0; ai < 2; ++ai)
#pragma unroll
            for (int mp = 0; mp < 2; ++mp) {
                u32x4 gw[2][2];
#pragma unroll
                for (int mm = 0; mm < 2; ++mm)
#pragma unroll
                    for (int bj = 0; bj < 2; ++bj) gw[mm][bj] = *(const GAS u32x4*)((const GAS uchar*)gates + (size_t)(row0 + ai * HALF + (2 * mp + mm) * 16) * 2048 + (size_t)(col0 + bj * HALF) * 2);
                __builtin_amdgcn_sched_barrier(0);
#pragma unroll
                for (int mm = 0; mm < 2; ++mm)
#pragma unroll
                    for (int bj = 0; bj < 2; ++bj) { const int m = 2 * mp + mm; const u32x4 g = gw[mm][bj];
                        acc[ai][bj][m][0][0] *= ub0(g.x) * __builtin_amdgcn_rcpf(fmaxf(ub0(g.z), 1.0f)); acc[ai][bj][m][0][1] *= ub1(g.x) * __builtin_amdgcn_rcpf(fmaxf(ub1(g.z), 1.0f));
                        acc[ai][bj][m][0][2] *= ub2(g.x) * __builtin_amdgcn_rcpf(fmaxf(ub2(g.z), 1.0f)); acc[ai][bj][m][0][3] *= ub3(g.x) * __builtin_amdgcn_rcpf(fmaxf(ub3(g.z), 1.0f));
                        acc[ai][bj][m][1][0] *= ub0(g.y) * __builtin_amdgcn_rcpf(fmaxf(ub0(g.w), 1.0f)); acc[ai][bj][m][1][1] *= ub1(g.y) * __builtin_amdgcn_rcpf(fmaxf(ub1(g.w), 1.0f));
                        acc[ai][bj][m][1][2] *= ub2(g.y) * __builtin_amdgcn_rcpf(fmaxf(ub2(g.w), 1.0f)); acc[ai][bj][m][1][3] *= ub3(g.y) * __builtin_amdgcn_rcpf(fmaxf(ub3(g.w), 1.0f)); }
                __builtin_amdgcn_sched_barrier(0);
            }
    }
    __device__ __forceinline__ void operator()(const Acc& acc, const Unit& u, int wr, int wc, int fr, int fq) const {
        const int row0 = u.pm * BM + wr * 64 + fr, col0 = u.pn * BM + wc * 32 + 8 * fq;
        const float k = 1.0f / 255.0f;
        u32x2 gwv[2][4][2];
#pragma unroll
        for (int ai = 0; ai < 2; ++ai)
#pragma unroll
            for (int m = 0; m < 4; ++m)
#pragma unroll
                for (int bj = 0; bj < 2; ++bj) gwv[ai][m][bj] = *(const GAS u32x2*)((const GAS uchar*)gates + (size_t)(row0 + ai * HALF + m * 16) * 2048 + (size_t)(col0 + bj * HALF) * 2 + 8);
        __builtin_amdgcn_sched_barrier(0);
#pragma unroll
        for (int ai = 0; ai < 2; ++ai)
#pragma unroll
            for (int m = 0; m < 4; ++m) { const size_t row = (size_t)(row0 + ai * HALF + m * 16);
#pragma unroll
                for (int bj = 0; bj < 2; ++bj) { f32x4 v0 = acc[ai][bj][m][0], v1 = acc[ai][bj][m][1];
                    const u32x2 gw = gwv[ai][m][bj];
                    v0[0] *= fmaxf(ub0(gw.x), 1.0f) * k; v0[1] *= fmaxf(ub1(gw.x), 1.0f) * k; v0[2] *= fmaxf(ub2(gw.x), 1.0f) * k; v0[3] *= fmaxf(ub3(gw.x), 1.0f) * k;
                    v1[0] *= fmaxf(ub0(gw.y), 1.0f) * k; v1[1] *= fmaxf(ub1(gw.y), 1.0f) * k; v1[2] *= fmaxf(ub2(gw.y), 1.0f) * k; v1[3] *= fmaxf(ub3(gw.y), 1.0f) * k;
                    u32x4 w; w.x = pk2(v0[0], v0[1]); w.y = pk2(v0[2], v0[3]); w.z = pk2(v1[0], v1[1]); w.w = pk2(v1[2], v1[3]);
                    *(GAS u32x4*)(merged + row * 1024 + col0 + bj * HALF) = w; } }
    }
};
template <bool IN_F32, bool F8 = false> struct EpiRes {
    static constexpr bool PERM = true; static constexpr int MID_T = 0; static constexpr bool FP8 = F8, I8 = false;
    const float* xin; bf16_t* xr; float sc;
    __device__ __forceinline__ void operator()(const Acc& acc, const Unit& u, int wr, int wc, int fr, int fq) const {
        const int row0 = u.pm * BM + wr * 64 + fr, col0 = u.pn * BM + wc * 32 + 8 * fq;
        constexpr int MB = IN_F32 ? 2 : 4;
#pragma unroll
        for (int ai = 0; ai < 2; ++ai)
#pragma unroll
            for (int mb = 0; mb < 4; mb += MB) {
                f32x4 xa[IN_F32 ? MB : 1][2][2]; u32x4 pw[IN_F32 ? 1 : MB][2];
#pragma unroll
                for (int mm = 0; mm < MB; ++mm)
#pragma unroll
                    for (int bj = 0; bj < 2; ++bj) { const size_t row = (size_t)(row0 + ai * HALF + (mb + mm) * 16);
                        if constexpr (IN_F32) { const GAS f32x4* ip = (const GAS f32x4*)(xin + row * 1024 + col0 + bj * HALF); xa[mm][bj][0] = ip[0]; xa[mm][bj][1] = ip[1]; }
                        else pw[mm][bj] = *(const GAS u32x4*)((const GAS bf16_t*)xr + row * XR_LD + col0 + bj * HALF); }
                __builtin_amdgcn_sched_barrier(0);
#pragma unroll
                for (int mm = 0; mm < MB; ++mm)
#pragma unroll
                    for (int bj = 0; bj < 2; ++bj) { const int m = mb + mm; const size_t row = (size_t)(row0 + ai * HALF + m * 16);
                        f32x4 v0 = acc[ai][bj][m][0], v1 = acc[ai][bj][m][1];
                        if constexpr (F8) { v0 *= sc; v1 *= sc; }
                        GAS bf16_t* op = (GAS bf16_t*)xr + row * XR_LD + col0 + bj * HALF;
                        if constexpr (IN_F32) { v0 += xa[mm][bj][0]; v1 += xa[mm][bj][1]; }
                        else { const u32x4 q = pw[mm][bj];
                            v0[0] += bflo(q.x); v0[1] += bfhi(q.x); v0[2] += bflo(q.y); v0[3] += bfhi(q.y);
                            v1[0] += bflo(q.z); v1[1] += bfhi(q.z); v1[2] += bflo(q.w); v1[3] += bfhi(q.w); }
                        *(GAS u32x4*)op = (u32x4){pk2(v0[0], v0[1]), pk2(v0[2], v0[3]), pk2(v1[0], v1[1]), pk2(v1[2], v1[3])}; }
                __builtin_amdgcn_sched_barrier(0);
            }
    }
};
template <int IN, bool OUT8> struct EpiSwiglu {
    static constexpr bool PERM = true; static constexpr int MID_T = 0; static constexpr bool FP8 = IN == 1, I8 = IN == 2;
    bf16_t* act; int prow0; const float* rs; const float* cs;
    __device__ __forceinline__ void operator()(const Acc& acc, const Unit& u, int wr, int wc, int fr, int fq) const {
        const int row0 = (u.pm - prow0) * BM + wr * 64 + fr, col0 = u.pn * HALF + wc * 32 + 8 * fq;
        f32x4 cv[2][2]; col_scales<IN>(cs, u, wc, fq, cv);
        constexpr float kg = FP8 ? F8_UP_INV : 1.0f, ku = kg * (OUT8 ? F8_SACT : 1.0f);
        float rsa[2][4];
#pragma unroll
        for (int ai = 0; ai < 2; ++ai)
#pragma unroll
            for (int m = 0; m < 4; ++m) { rsa[ai][m] = 1.f; if constexpr (I8) rsa[ai][m] = ((const GAS float*)rs)[u.pm * BM + wr * 64 + fr + ai * HALF + m * 16]; }
        if constexpr (I8) __builtin_amdgcn_sched_barrier(0);
#pragma unroll
        for (int ai = 0; ai < 2; ++ai)
#pragma unroll
            for (int m = 0; m < 4; ++m) {
                const float rsv = rsa[ai][m];
                float g[8], up[8], e[8], o[8];
#pragma unroll
                for (int n = 0; n < 2; ++n) { const f32x4 g4 = accv<IN>(acc[ai][0][m][n], rsv, cv[0][n]), u4 = accv<IN>(acc[ai][1][m][n], rsv, cv[1][n]);
#pragma unroll
                    for (int j = 0; j < 4; ++j) { g[n * 4 + j] = g4[j] * kg; up[n * 4 + j] = u4[j] * ku; } }
#pragma unroll
                for (int j = 0; j < 8; ++j) e[j] = __builtin_amdgcn_exp2f(g[j] * -1.44269504089f);
#pragma unroll
                for (int j = 0; j < 8; ++j) asm volatile("" : "+v"(e[j]));
#pragma unroll
                for (int j = 0; j < 8; ++j) e[j] = __builtin_amdgcn_rcpf(1.0f + e[j]);
#pragma unroll
                for (int j = 0; j < 8; ++j) asm volatile("" : "+v"(e[j]));
#pragma unroll
                for (int j = 0; j < 8; ++j) { o[j] = (g[j] * up[j]) * e[j]; if constexpr (OUT8) o[j] = clamp_f8(o[j]); }
                if constexpr (OUT8) { u32x2 w; w.x = pk4_f8(o[0], o[1], o[2], o[3]); w.y = pk4_f8(o[4], o[5], o[6], o[7]);
                    *(GAS u32x2*)((GAS uchar*)act + (size_t)(row0 + ai * HALF + m * 16) * FFP + col0) = w; }
                else { u32x4 w; w.x = pk2(o[0], o[1]); w.y = pk2(o[2], o[3]); w.z = pk2(o[4], o[5]); w.w = pk2(o[6], o[7]);
                    *(GAS u32x4*)(act + (size_t)(row0 + ai * HALF + m * 16) * FFP + col0) = w; } }
    }
};
}
struct Frame {
    LAS uchar* lds;
    int tid, lane, wave, G, bid;
    uchar* ws; unsigned* ctl;
    float* out;
};
#define CAS __attribute__((address_space(4)))
typedef const float* cfptr_t;
__device__ __forceinline__ const float* argp(int k) { const CAS char* kp = (const CAS char*)__builtin_amdgcn_kernarg_segment_ptr(); asm volatile("" : "+s"(kp)); const float* p_ = *(const CAS cfptr_t*)(kp + 8 * k); ASSUME_GLOBAL(p_); return p_; }

template <bool F8 = false> __device__ __forceinline__ void xpose64w(const float* src, int N, int k0, int n0, typename OutT<F8>::t* dst, int ldd, LAS float* scr, int lane, int hi_off = 0, float sc = 1.0f) {
    const GAS char* base = (const GAS char*)(src + (size_t)k0 * N + n0);
    unsigned voff = (unsigned)lane * 4u; const unsigned rstep = (unsigned)N * 4u;
    float v[64];
#pragma unroll
    for (int k = 0; k < 64; ++k) { asm volatile("" : "+v"(voff)); v[k] = *(const GAS float*)(base + voff); voff += rstep; }
#pragma unroll
    for (int k = 0; k < 64; ++k) scr[k * 65 + lane] = v[k];
    asm volatile("s_waitcnt lgkmcnt(0)" ::: "memory"); __builtin_amdgcn_wave_barrier();
    const int kc = lane & 7;
#pragma unroll
    for (int i = 0; i < 8; ++i) { const int n = (lane >> 3) + 8 * i; const LAS float* s = scr + (8 * kc) * 65 + n;
        if constexpr (F8) { u32x2 o; o.x = pk4_f8(s[0] * sc, s[65] * sc, s[2 * 65] * sc, s[3 * 65] * sc); o.y = pk4_f8(s[4 * 65] * sc, s[5 * 65] * sc, s[6 * 65] * sc, s[7 * 65] * sc);
            *(GAS u32x2*)(dst + (size_t)n * ldd + 8 * kc + (n >= 32 ? hi_off : 0)) = o; }
        else { u32x4 o; o.x = pk2(s[0], s[65]); o.y = pk2(s[2 * 65], s[3 * 65]); o.z = pk2(s[4 * 65], s[5 * 65]); o.w = pk2(s[6 * 65], s[7 * 65]);
            *(GAS u32x4*)(dst + (size_t)n * ldd + 8 * kc + (n >= 32 ? hi_off : 0)) = o; } }
    asm volatile("s_waitcnt lgkmcnt(0)" ::: "memory"); __builtin_amdgcn_wave_barrier();
}
#define WAVE_SCR(F) ((LAS float*)((F).lds) + (F).wave * (64 * 65))
__device__ __forceinline__ void conv_win(Frame& F, const float* w, bf16_t* wtok, bf16_t* wch) {
    LAS float* scr = WAVE_SCR(F);
    for (int t = F.bid * NWAVES + F.wave; t < 16 * 80; t += F.G * NWAVES) {
        const int kb = t / 80, nb = t % 80, n0 = nb * 64;
        bf16_t* dst; int hi = 0;
        if (n0 < 1536) dst = wch + (size_t)n0 * 1024;
        else if (n0 < 2560) { const int G = (n0 - 1536) >> 6; dst = wtok + (size_t)(256 * (G >> 2) + 32 * (G & 3)) * 1024; hi = (128 - 32) * 1024; }
        else if (n0 < 3072) dst = wch + (size_t)(1536 + n0 - 2560) * 1024;
        else if (n0 < 4096) { const int c = n0 - 3072; dst = wtok + (size_t)(256 * (4 + (c >> 7)) + (c & 127)) * 1024; }
        else { const int c = n0 - 4096; dst = wtok + (size_t)(256 * (4 + (c >> 7)) + 128 + (c & 127)) * 1024; }
        xpose64w(w, INW, kb * 64, n0, dst + kb * 64, 1024, scr, F.lane, hi);
    }
}
__device__ __forceinline__ void conv_plain(Frame& F, const float* w, int K, int N, bf16_t* dst, int ldd) {
    LAS float* scr = WAVE_SCR(F);
    const int nkb = K / 64, nnb = N / 64;
    for (int t = F.bid * NWAVES + F.wave; t < nkb * nnb; t += F.G * NWAVES) { const int kb = t / nnb, nb = t % nnb;
        xpose64w(w, N, kb * 64, nb * 64, dst + (size_t)(nb * 64) * ldd + kb * 64, ldd, scr, F.lane); }
}
template <bool F8, bool F8DN = F8> __device__ __forceinline__ void conv_ffn(Frame& F, const float* wg, const float* wu, const float* wd, typename OutT<F8>::t* wgu, typename OutT<F8DN>::t* wdt, int nexp) {
    LAS float* scr = WAVE_SCR(F);
    constexpr int GUP = F8 ? P8 : 1024;
    const int per = 16 * 43;
    for (int t = F.bid * NWAVES + F.wave; t < nexp * 3 * per; t += F.G * NWAVES) {
        const int e = t / (3 * per), r = t % (3 * per), which = r / per, q = r % per;
        if (which < 2) { const int kb = q / 43, nb = q % 43, n0 = nb * 64; const float* src = (which ? wu : wg) + (size_t)e * 1024 * DFF;
            const int drow = (n0 / 128) * 256 + which * 128 + (n0 % 128);
            xpose64w<F8>(src, DFF, kb * 64, n0, wgu + (size_t)e * 5632 * GUP + (size_t)drow * GUP + kb * 64, GUP, scr, F.lane, 0, F8_SWGU);
        } else { const int kb = q / 16, nb = q % 16; const float* src = wd + (size_t)e * DFF * 1024;
            xpose64w<F8DN>(src, 1024, kb * 64, nb * 64, wdt + (size_t)e * 1024 * FFP + (size_t)(nb * 64) * FFP + kb * 64, FFP, scr, F.lane, 0, F8_SWD); }
    }
    constexpr int EPC = F8 ? 16 : 8, CR = 1024 / EPC, EPD = F8DN ? 16 : 8, CD = 64 / EPD;
    const int gt = F.bid * NTHR + F.tid, GT = F.G * NTHR;
    for (int i = gt; i < nexp * 128 * CR; i += GT) { const int e = i / (128 * CR), r = (i / CR) % 128, c8 = i % CR;
        const int row = 256 * 21 + (r < 64 ? 64 + r : 192 + (r - 64));
        *(GAS u32x4*)(wgu + (size_t)e * 5632 * GUP + (size_t)row * GUP + c8 * EPC) = (u32x4){0u, 0u, 0u, 0u}; }
    for (int i = gt; i < nexp * 1024 * CD; i += GT) { const int e = i / (1024 * CD), n = (i / CD) % 1024, c8 = i % CD;
        *(GAS u32x4*)(wdt + (size_t)e * 1024 * FFP + (size_t)n * FFP + DFF + c8 * EPD) = (u32x4){0u, 0u, 0u, 0u}; }
}

__device__ __forceinline__ void rope_tables(Frame& F) {
    GAS bf16_t* ct = (GAS bf16_t*)(F.ws + WS_ROPE); GAS bf16_t* st = ct + SEQ * 32;
    const int gt = F.bid * NTHR + F.tid, GT = F.G * NTHR;
    for (int i = gt; i < SEQ * 32; i += GT) { const int l = i >> 5, j = i & 31;
        const float inv_rev = __builtin_amdgcn_exp2f(-(float)j * (13.287712379549449f / 32.0f)) * 0.15915494309f;
        const float rev = (float)l * inv_rev;
        ct[i] = (bf16_t)f2bf(cos_rev(rev)); st[i] = (bf16_t)f2bf(sin_rev(rev)); }
}

__device__ __forceinline__ void norm_row_load(const float* xrow, int lane, f32x4 (&v)[4]) {
    const GAS f32x4* xr = (const GAS f32x4*)xrow + lane;
#pragma unroll
    for (int j = 0; j < 4; ++j) v[j] = xr[64 * j];
}
template <int OM> __device__ __forceinline__ void norm_row(f32x4 (&v)[4], const float* g, typename OutT<(OM != 0)>::t* orow, float* srow, int lane) {
    const GAS f32x4* gr = (const GAS f32x4*)g + lane;
    float s = 0.f;
#pragma unroll
    for (int j = 0; j < 4; ++j) s += (v[j].x * v[j].x + v[j].y * v[j].y) + (v[j].z * v[j].z + v[j].w * v[j].w);
    const float r = __builtin_amdgcn_rsqf(wave_sum(s) * (1.0f / DM) + RMS_EPS);
    if constexpr (OM == 2) {
        float mx = 0.f;
#pragma unroll
        for (int j = 0; j < 4; ++j) { const f32x4 gg = gr[64 * j]; v[j].x *= r * gg.x; v[j].y *= r * gg.y; v[j].z *= r * gg.z; v[j].w *= r * gg.w;
            mx = fmaxf(fmaxf(mx, fmaxf(fabsf(v[j].x), fabsf(v[j].y))), fmaxf(fabsf(v[j].z), fabsf(v[j].w))); }
        mx = fmaxf(wave_max(mx), 1e-30f); const float inv = 127.0f * __builtin_amdgcn_rcpf(mx);
#pragma unroll
        for (int j = 0; j < 4; ++j) ((GAS unsigned*)orow + lane)[64 * j] = pk4_i8(v[j].x * inv, v[j].y * inv, v[j].z * inv, v[j].w * inv);
        if (lane == 0) *(GAS float*)srow = mx * (1.0f / 127.0f);
    } else {
        GAS u32x2* o8 = (GAS u32x2*)orow + lane;
#pragma unroll
        for (int j = 0; j < 4; ++j) { const f32x4 gg = gr[64 * j]; u32x2 w; w.x = pk2(v[j].x * r * gg.x, v[j].y * r * gg.y); w.y = pk2(v[j].z * r * gg.z, v[j].w * r * gg.w); o8[64 * j] = w; }
    }
}
template <int OM> __device__ __forceinline__ void norm_row_bf(const u32x4 (&xw)[2], const float* g, typename OutT<(OM != 0)>::t* orow, float* srow, int lane) {
    const GAS f32x4* gr = (const GAS f32x4*)g + 2 * lane;
    float v[2][8]; float s = 0.f;
#pragma unroll
    for (int j = 0; j < 2; ++j) { const u32x4 w = xw[j]; v[j][0] = bflo(w.x); v[j][1] = bfhi(w.x); v[j][2] = bflo(w.y); v[j][3] = bfhi(w.y); v[j][4] = bflo(w.z); v[j][5] = bfhi(w.z); v[j][6] = bflo(w.w); v[j][7] = bfhi(w.w);
#pragma unroll
        for (int e = 0; e < 8; ++e) s += v[j][e] * v[j][e]; }
    const float r = __builtin_amdgcn_rsqf(wave_sum(s) * (1.0f / DM) + RMS_EPS) * (OM == 1 ? F8_SH : 1.0f);
    if constexpr (OM == 2) {
        float mx = 0.f;
#pragma unroll
        for (int j = 0; j < 2; ++j) { const f32x4 ga = gr[128 * j], gb = gr[128 * j + 1];
            v[j][0] *= r * ga.x; v[j][1] *= r * ga.y; v[j][2] *= r * ga.z; v[j][3] *= r * ga.w; v[j][4] *= r * gb.x; v[j][5] *= r * gb.y; v[j][6] *= r * gb.z; v[j][7] *= r * gb.w;
#pragma unroll
            for (int e = 0; e < 8; ++e) mx = fmaxf(mx, fabsf(v[j][e])); }
        mx = fmaxf(wave_max(mx), 1e-30f); const float inv = 127.0f * __builtin_amdgcn_rcpf(mx);
#pragma unroll
        for (int j = 0; j < 2; ++j) ((GAS u32x2*)orow + lane)[64 * j] = (u32x2){pk4_i8(v[j][0] * inv, v[j][1] * inv, v[j][2] * inv, v[j][3] * inv), pk4_i8(v[j][4] * inv, v[j][5] * inv, v[j][6] * inv, v[j][7] * inv)};
        if (lane == 0) *(GAS float*)srow = mx * (1.0f / 127.0f);
    } else {
#pragma unroll
        for (int j = 0; j < 2; ++j) { const f32x4 ga = gr[128 * j], gb = gr[128 * j + 1];
            if constexpr (OM == 1) ((GAS u32x2*)orow + lane)[64 * j] = (u32x2){pk4_f8(v[j][0] * r * ga.x, v[j][1] * r * ga.y, v[j][2] * r * ga.z, v[j][3] * r * ga.w), pk4_f8(v[j][4] * r * gb.x, v[j][5] * r * gb.y, v[j][6] * r * gb.z, v[j][7] * r * gb.w)};
            else ((GAS u32x4*)orow + lane)[64 * j] = (u32x4){pk2(v[j][0] * r * ga.x, v[j][1] * r * ga.y), pk2(v[j][2] * r * ga.z, v[j][3] * r * ga.w), pk2(v[j][4] * r * gb.x, v[j][5] * r * gb.y), pk2(v[j][6] * r * gb.z, v[j][7] * r * gb.w)}; }
    }
}
template <int OM> __device__ __forceinline__ void phase_norm_bf(Frame& F, const bf16_t* xr, const float* g, typename OutT<(OM != 0)>::t* h, float* hs) {
    const int gw = F.bid * NWAVES + F.wave, NGW = F.G * NWAVES;
    u32x4 xw[2], nw[2];
    if (gw < NTOK) { xw[0] = ((const GAS u32x4*)(xr + (size_t)gw * XR_LD) + F.lane)[0]; xw[1] = ((const GAS u32x4*)(xr + (size_t)gw * XR_LD) + F.lane)[64]; }
    for (int m = gw; m < NTOK; m += NGW) { const int mn = m + NGW < NTOK ? m + NGW : m;
        nw[0] = ((const GAS u32x4*)(xr + (size_t)mn * XR_LD) + F.lane)[0]; nw[1] = ((const GAS u32x4*)(xr + (size_t)mn * XR_LD) + F.lane)[64];
        norm_row_bf<OM>(xw, g, h + (size_t)m * (OM == 2 ? P8 : DM), hs + m, F.lane);
        xw[0] = nw[0]; xw[1] = nw[1]; }
}
template <int OM> __device__ __forceinline__ void phase_norm(Frame& F, const float* x, const float* g, typename OutT<(OM != 0)>::t* h, float* hs) {
    const int gw = F.bid * NWAVES + F.wave, NGW = F.G * NWAVES;
    f32x4 v[4], nv[4];
    if (gw < NTOK) norm_row_load(x + (size_t)gw * DM, F.lane, v);
    for (int m = gw; m < NTOK; m += NGW) { const int mn = m + NGW < NTOK ? m + NGW : m;
        norm_row_load(x + (size_t)mn * DM, F.lane, nv);
        norm_row<OM>(v, g, h + (size_t)m * (OM == 2 ? P8 : DM), hs + m, F.lane);
#pragma unroll
        for (int j = 0; j < 4; ++j) v[j] = nv[j]; }
}
__device__ __forceinline__ void quant_rows(Frame& F, const bf16_t* src, uchar* dst, float* sc, int R) {
    const int gw = F.bid * NWAVES + F.wave, NGW = F.G * NWAVES;
    for (int r = gw; r < R; r += NGW) {
        const GAS u32x4* sp = (const GAS u32x4*)(src + (size_t)r * 1024) + 2 * F.lane;
        const u32x4 a = sp[0], b = sp[1];
        const unsigned w[8] = {a.x, a.y, a.z, a.w, b.x, b.y, b.z, b.w};
        float v[16]; float mx = 0.f;
#pragma unroll
        for (int e = 0; e < 8; ++e) { v[2 * e] = bflo(w[e]); v[2 * e + 1] = bfhi(w[e]); mx = fmaxf(mx, fmaxf(fabsf(v[2 * e]), fabsf(v[2 * e + 1]))); }
        mx = fmaxf(wave_max(mx), 1e-30f); const float inv = 127.0f * __builtin_amdgcn_rcpf(mx);
        *((GAS u32x4*)(dst + (size_t)r * P8) + F.lane) = (u32x4){pk4_i8(v[0] * inv, v[1] * inv, v[2] * inv, v[3] * inv), pk4_i8(v[4] * inv, v[5] * inv, v[6] * inv, v[7] * inv),
                                                                   pk4_i8(v[8] * inv, v[9] * inv, v[10] * inv, v[11] * inv), pk4_i8(v[12] * inv, v[13] * inv, v[14] * inv, v[15] * inv)};
        if (F.lane == 0) ((GAS float*)sc)[r] = mx * (1.0f / 127.0f);
    }
}

__device__ __forceinline__ void phase_hdn(Frame& F, int layer) {
    const GAS float* w1 = (const GAS float*)argp(4) + (size_t)layer * FEMB * FHID; const GAS float* b1 = (const GAS float*)argp(5) + layer * FHID; const GAS float* fr1 = (const GAS float*)argp(6) + layer * FHID;
    const GAS float* w2 = (const GAS float*)argp(7) + (size_t)layer * FHID * FHID; const GAS float* b2 = (const GAS float*)argp(8) + layer * FHID; const GAS float* fr2 = (const GAS float*)argp(9) + layer * FHID;
    GAS float* hdn = (GAS float*)(F.ws + WS_HDN) + (size_t)layer * SEQ * FHID;
    LAS float* scr = (LAS float*)(F.lds + 136 * 1024) + F.wave * 128;
    const int gw = F.bid * NWAVES + F.wave, NGW = F.G * NWAVES, j = F.lane;
    for (int l = gw; l < SEQ; l += NGW) {
        float z = 0.f;
        if (j == 0) z = (float)l * (1.0f / (float)(SEQ - 1));
        else if (j < FEMB) { const int i = (j - 1) & 15; const float f = 1e-4f + (float)i * ((15.0f - 1e-4f) / 15.0f);
            const float rev = f * ((float)l * (1.0f / (float)SEQ)); z = (j <= 16) ? cos_rev(rev) : -sin_rev(rev); }
        scr[j] = z;
        __builtin_amdgcn_wave_barrier(); asm volatile("s_waitcnt lgkmcnt(0)" ::: "memory");
        float a1 = b1[j];
        for (int i = 0; i < FEMB; ++i) a1 += scr[i] * w1[i * FHID + j];
        const float h1 = fast_sin(fr1[j] * a1);
        scr[64 + j] = h1;
        __builtin_amdgcn_wave_barrier(); asm volatile("s_waitcnt lgkmcnt(0)" ::: "memory");
        float a2 = b2[j];
        for (int i = 0; i < FHID; ++i) a2 += scr[64 + i] * w2[i * FHID + j];
        hdn[(size_t)l * FHID + j] = fast_sin(fr2[j] * a2);
        __builtin_amdgcn_wave_barrier(); asm volatile("s_waitcnt lgkmcnt(0)" ::: "memory");
    }
}

__device__ __forceinline__ void phase_fimg(Frame& F, int layer) {
    const GAS float* hdn = (const GAS float*)(F.ws + WS_HDN) + (size_t)layer * SEQ * FHID;
    const GAS float* w3 = (const GAS float*)argp(10) + (size_t)layer * FHID * 2048;
    GAS bf16_t* gimg = (GAS bf16_t*)(F.ws + WS_FIMG);
    const int gw = F.bid * NWAVES + F.wave, NGW = F.G * NWAVES;
    const float min_decay = -4.605170185988091f / 1.5f, max_decay = -4.605170185988091f / 0.3f;
    for (int it = gw; it < 32 * 64; it += NGW) {
        const int lbp = it >> 6, cb = it & 63;
        const int o = cb >> 5, dir = (cb >> 4) & 1;
        int l[2], u[2], lc[2];
#pragma unroll
        for (int h = 0; h < 2; ++h) { const int lb = 2 * lbp + h; l[h] = dir ? (64 * lb + 1 + F.lane) : (64 * lb + 63 - F.lane); u[h] = dir ? (4160 + 64 * lb + F.lane) : (4096 - 64 * lb + F.lane); lc[h] = l[h] < SEQ ? l[h] : SEQ - 1; }
        f32x2 hv[FHID];
        { const GAS f32x4* hp0 = (const GAS f32x4*)(hdn + (size_t)lc[0] * FHID); const GAS f32x4* hp1 = (const GAS f32x4*)(hdn + (size_t)lc[1] * FHID);
#pragma unroll
          for (int i = 0; i < 16; ++i) { const f32x4 a = hp0[i], b = hp1[i]; hv[4 * i] = (f32x2){a.x, b.x}; hv[4 * i + 1] = (f32x2){a.y, b.y}; hv[4 * i + 2] = (f32x2){a.z, b.z}; hv[4 * i + 3] = (f32x2){a.w, b.w}; } }
        LAS float* wt = (LAS float*)(F.lds) + F.wave * 2048;
        { const GAS f32x4* wp = (const GAS f32x4*)(w3 + (size_t)F.lane * 2048 + cb * 32);
#pragma unroll
          for (int q = 0; q < 8; ++q) { const f32x4 t = wp[q]; wt[(4 * q) * 64 + F.lane] = t.x; wt[(4 * q + 1) * 64 + F.lane] = t.y; wt[(4 * q + 2) * 64 + F.lane] = t.z; wt[(4 * q + 3) * 64 + F.lane] = t.w; } }
        asm volatile("s_waitcnt lgkmcnt(0)" ::: "memory"); __builtin_amdgcn_wave_barrier();
        const f32x2 tl = {(float)lc[0] * (1.0f / (float)(SEQ - 1)), (float)lc[1] * (1.0f / (float)(SEQ - 1))};
        for (int cc = 0; cc < 32; ++cc) {
            const int col = cb * 32 + cc, c = col & 511;
            f32x2 acc = {0.f, 0.f};
            const LAS f32x4* wc4 = (const LAS f32x4*)(wt + cc * 64);
#pragma unroll
            for (int i = 0; i < 16; ++i) { const f32x4 w4 = wc4[i];
                acc += hv[4 * i] * (f32x2){w4.x, w4.x}; acc += hv[4 * i + 1] * (f32x2){w4.y, w4.y}; acc += hv[4 * i + 2] * (f32x2){w4.z, w4.z}; acc += hv[4 * i + 3] * (f32x2){w4.w, w4.w}; }
            const float delta = fabsf(min_decay + (float)c * ((max_decay - min_decay) / 511.0f));
#pragma unroll
            for (int h = 0; h < 2; ++h) { const float val = l[h] < SEQ ? acc[h] * fast_exp(-tl[h] * delta) : 0.f;
                gimg[(size_t)(o * 512 + c) * GIMG_LEN + u[h]] = (unsigned short)f2bf(val); }
        }
        asm volatile("s_waitcnt lgkmcnt(0)" ::: "memory"); __builtin_amdgcn_wave_barrier();
    }
}

typedef short s16x4 __attribute__((ext_vector_type(4)));
__device__ __forceinline__ void phase_transpose_y(Frame& F) {
    const GAS bf16_t* yT = (const GAS bf16_t*)(F.ws + WS_YT); GAS bf16_t* yh = (GAS bf16_t*)(F.ws + WS_YCAT);
    constexpr int RB = 144;
    const int r = F.tid >> 3, c8 = F.tid & 7;
    const int w = F.wave, g = F.lane >> 4, i = F.lane & 15, q = i >> 2, p = i & 3;
    u32x4 nx = *(const GAS u32x4*)(yT + (size_t)((F.bid & 7) * 64 + r) * NTOK + (F.bid >> 3) * 64 + c8 * 8);
    int par = 0;
    for (int t = F.bid; t < 8 * 512; t += F.G) {
        const int cb = t & 7, tb = t >> 3;
        LAS uchar* buf = F.lds + par * (64 * RB); par ^= 1;
        *(LAS u32x4*)(buf + r * RB + c8 * 16) = nx;
        { const int tn = t + F.G < 8 * 512 ? t + F.G : t; nx = *(const GAS u32x4*)(yT + (size_t)((tn & 7) * 64 + r) * NTOK + (tn >> 3) * 64 + c8 * 8); }
        __syncthreads();
        const s16x4 va = __builtin_amdgcn_ds_read_tr16_b64_v4i16((LAS s16x4*)(buf + (8 * w + q) * RB + (16 * g + 4 * p) * 2));
        const s16x4 vb = __builtin_amdgcn_ds_read_tr16_b64_v4i16((LAS s16x4*)(buf + (8 * w + 4 + q) * RB + (16 * g + 4 * p) * 2));
        const bf16x8 o = __builtin_shufflevector(va, vb, 0, 1, 2, 3, 4, 5, 6, 7);
        *(GAS bf16x8*)(yh + (size_t)(tb * 64 + 16 * g + i) * 1024 + cb * 64 + 8 * w) = o;
    }
    __syncthreads();
}
constexpr int HY_F = 0, HY_V = FIMG_BYTES, HY_VROW = 144, HY_VROWS = 78 * 8;
static_assert(HY_V + HY_VROWS * HY_VROW <= LDS_MISC, "hyena LDS");

__device__ __forceinline__ void hy_load_fimg(Frame& F, const GAS bf16_t* g) {
    const GAS u32x4* src = (const GAS u32x4*)g;
    constexpr int NJ = FIMG_LEN / 8, NQ = (NJ + NTHR - 1) / NTHR;
    u32x4 av[NQ], bv[NQ];
#pragma unroll
    for (int q = 0; q < NQ; ++q) { const int j0 = F.tid + q * NTHR, j = j0 < NJ ? j0 : NJ - 1; av[q] = src[j + 7]; bv[q] = src[j + 8]; }
#pragma unroll
    for (int q = 0; q < NQ; ++q) { const int j = F.tid + q * NTHR; if (j < NJ) {
        const u32x4 a = av[q], b = bv[q];
        const unsigned d2 = a.z, d3 = a.w, d4 = b.x, d5 = b.y, d6 = b.z, d7 = b.w;
        LAS uchar* dst = F.lds + HY_F + j * 16;
        *(LAS u32x4*)(dst) = (u32x4){__builtin_amdgcn_alignbit(d4, d3, 16), __builtin_amdgcn_alignbit(d5, d4, 16), __builtin_amdgcn_alignbit(d6, d5, 16), __builtin_amdgcn_alignbit(d7, d6, 16)};
        *(LAS u32x4*)(dst + FIMG_LEN * 2) = (u32x4){d3, d4, d5, d6};
        *(LAS u32x4*)(dst + 2 * FIMG_LEN * 2) = (u32x4){__builtin_amdgcn_alignbit(d3, d2, 16), __builtin_amdgcn_alignbit(d4, d3, 16), __builtin_amdgcn_alignbit(d5, d4, 16), __builtin_amdgcn_alignbit(d6, d5, 16)};
        *(LAS u32x4*)(dst + 3 * FIMG_LEN * 2) = (u32x4){d2, d3, d4, d5}; } }
}
__device__ __forceinline__ bf16x8 hy_lda(const LAS uchar* p) { const bf16x4 lo = *(const volatile LAS bf16x4*)p; const bf16x4 hi = *(const volatile LAS bf16x4*)(p + 8); return __builtin_shufflevector(lo, hi, 0, 1, 2, 3, 4, 5, 6, 7); }
template <int N0, int N1> __device__ __forceinline__ void hy_step(const LAS uchar*& pA, const LAS uchar*& pB, bf16x8 (&a0)[4], bf16x8 (&a1)[4], bf16x8 (&b0)[4], bf16x8 (&b1)[4], f32x4 (&acc)[4][4]) {
#pragma unroll
    for (int r = 0; r < 4; ++r) { a1[r] = hy_lda(pA + r * (FIMG_LEN * 2) + 64); b1[r] = *(const LAS bf16x8*)(pB + r * (16 * HY_VROW) + 64);
#pragma unroll
        for (int nt = N0; nt < N1; ++nt) acc[r][nt] = __builtin_amdgcn_mfma_f32_16x16x32_bf16(a0[r], b0[nt], acc[r][nt], 0, 0, 0);
        __builtin_amdgcn_sched_barrier(0); }
#pragma unroll
    for (int r = 0; r < 4; ++r) { a0[r] = hy_lda(pA + r * (FIMG_LEN * 2) + 128); b0[r] = *(const LAS bf16x8*)(pB + r * (16 * HY_VROW) + 8 * HY_VROW);
#pragma unroll
        for (int nt = N0; nt < N1; ++nt) acc[r][nt] = __builtin_amdgcn_mfma_f32_16x16x32_bf16(a1[r], b1[nt], acc[r][nt], 0, 0, 0);
        __builtin_amdgcn_sched_barrier(0); }
    pA += 128; pB += 8 * HY_VROW;
}
__device__ __forceinline__ void hy_conv(Frame& F, f32x4 (&acc)[4][4]) {
    const int q = F.wave, i = F.lane & 15, g = F.lane >> 4;
#pragma unroll
    for (int r = 0; r < 4; ++r)
#pragma unroll
        for (int nt = 0; nt < 4; ++nt) acc[r][nt] = (f32x4){0.f, 0.f, 0.f, 0.f};
    const int dhi = 8 * q + 7;
    const LAS uchar* pA = F.lds + (unsigned)(HY_F + 8192 - 8 * i + 16 * g - 128 * dhi);
    const LAS uchar* pB = F.lds + (unsigned)(HY_V + ((8 * q + (i >> 3) + 7) * 8 + (i & 7)) * HY_VROW + 16 * g - 8 * HY_VROW * dhi);
    bf16x8 a0[4], a1[4], b0[4], b1[4];
#pragma unroll
    for (int r = 0; r < 4; ++r) { a0[r] = hy_lda(pA + r * (FIMG_LEN * 2)); b0[r] = *(const LAS bf16x8*)(pB + r * (16 * HY_VROW)); }
    hy_step<3, 4>(pA, pB, a0, a1, b0, b1, acc); hy_step<3, 4>(pA, pB, a0, a1, b0, b1, acc);
    hy_step<2, 4>(pA, pB, a0, a1, b0, b1, acc); hy_step<2, 4>(pA, pB, a0, a1, b0, b1, acc);
    hy_step<1, 4>(pA, pB, a0, a1, b0, b1, acc); hy_step<1, 4>(pA, pB, a0, a1, b0, b1, acc);
#pragma clang loop unroll(disable)
    for (int m = 6; m < 65; ++m) hy_step<0, 4>(pA, pB, a0, a1, b0, b1, acc);
    hy_step<0, 3>(pA, pB, a0, a1, b0, b1, acc); hy_step<0, 3>(pA, pB, a0, a1, b0, b1, acc);
    hy_step<0, 2>(pA, pB, a0, a1, b0, b1, acc); hy_step<0, 2>(pA, pB, a0, a1, b0, b1, acc);
    hy_step<0, 1>(pA, pB, a0, a1, b0, b1, acc); hy_step<0, 1>(pA, pB, a0, a1, b0, b1, acc);
}
__device__ __forceinline__ void conv8(const u32x4 u, float left, float right, float w0, float w1, float w2, float (&y)[8]) {
    float x[10]; x[0] = left; x[1] = bflo(u.x); x[2] = bfhi(u.x); x[3] = bflo(u.y); x[4] = bfhi(u.y); x[5] = bflo(u.z); x[6] = bfhi(u.z); x[7] = bflo(u.w); x[8] = bfhi(u.w); x[9] = right;
#pragma unroll
    for (int e = 0; e < 8; ++e) y[e] = w0 * x[e] + w1 * x[e + 1] + w2 * x[e + 2];
}
struct Run16 { u32x4 a, b; unsigned short l, r; };
__device__ __forceinline__ Run16 run16_load(const GAS bf16_t* p, int t) { Run16 x; x.a = *(const GAS u32x4*)(p + t); x.b = *(const GAS u32x4*)(p + t + 8); x.l = p[t > 0 ? t - 1 : t]; x.r = p[t + 16 < SEQ ? t + 16 : t]; return x; }
__device__ __forceinline__ void run16_conv(const Run16& x, int t, float w0, float w1, float w2, float (&y)[16]) {
    const float left = t > 0 ? bf2f(x.l) : 0.f, right = t + 16 < SEQ ? bf2f(x.r) : 0.f;
    float ya[8], yb[8];
    conv8(x.a, left, bflo(x.b.x), w0, w1, w2, ya); conv8(x.b, bfhi(x.a.w), right, w0, w1, w2, yb);
#pragma unroll
    for (int e = 0; e < 8; ++e) { y[e] = ya[e]; y[8 + e] = yb[e]; }
}
__device__ __forceinline__ void phase_hyena(Frame& F, int layer) {
    const GAS bf16_t* hy = (const GAS bf16_t*)(F.ws + WS_CHT);
    GAS bf16_t* yT = (GAS bf16_t*)(F.ws + WS_YT);
    const GAS bf16_t* fimg = (const GAS bf16_t*)(F.ws + WS_FIMG);
    const GAS float* hb = (const GAS float*)argp(11) + (size_t)layer * 2 * HW;
    const GAS float* cw = (const GAS float*)argp(3) + (size_t)layer * 3 * 1536;
    const int q = F.wave, n = F.lane & 15, g = F.lane >> 4;
    for (int c = F.bid; c < HW; c += F.G) {
        for (int i = F.tid; i < 112 * (HY_VROW / 16); i += NTHR) { const int r = i / (HY_VROW / 16), k = i % (HY_VROW / 16); const int row = r < 56 ? r : (71 * 8 + r - 56);
            *(LAS u32x4*)(F.lds + HY_V + row * HY_VROW + k * 16) = (u32x4){0u, 0u, 0u, 0u}; }
        { const float w0 = cw[1024 + c], w1 = cw[1536 + 1024 + c], w2 = cw[2 * 1536 + 1024 + c];
          int tl = F.tid; asm volatile("" : "+v"(tl));
          const int k = tl & 7, b = (tl >> 3) & 7, sq = tl >> 6;
          const GAS char* pc = (const GAS char*)(hy + (size_t)(1024 + c) * NTOK); asm volatile("" : "+s"(pc));
          const unsigned ob = (unsigned)(b * SEQ + k * 8) * 2u;
#pragma unroll
          for (int jb = 0; jb < 8; jb += 4) {
          u32x4 uu[4]; unsigned short ll[4], rr[4];
#pragma unroll
          for (int j = 0; j < 4; ++j) { const int t = (sq + 8 * (jb + j)) * 64 + k * 8; const unsigned o = ob + (unsigned)(sq + 8 * (jb + j)) * 128u;
              uu[j] = *(const GAS u32x4*)(pc + o); ll[j] = *(const GAS unsigned short*)(pc + (t > 0 ? o - 2u : o)); rr[j] = *(const GAS unsigned short*)(pc + (t + 8 < SEQ ? o + 16u : o)); }
          __builtin_amdgcn_sched_barrier(0);
#pragma unroll
          for (int j = 0; j < 4; ++j) { const int s1 = sq + 8 * (jb + j), t = s1 * 64 + k * 8, r = s1 * 8 + b;
            const float left = t > 0 ? bf2f(ll[j]) : 0.f, right = t + 8 < SEQ ? bf2f(rr[j]) : 0.f;
            float y[8]; conv8(uu[j], left, right, w0, w1, w2, y);
            *(LAS u32x4*)(F.lds + HY_V + (r + 56) * HY_VROW + k * 16) = (u32x4){pk2(y[0], y[1]), pk2(y[2], y[3]), pk2(y[4], y[5]), pk2(y[6], y[7])}; }
          __builtin_amdgcn_sched_barrier(0);
          } }
        hy_load_fimg(F, fimg + (size_t)(0 * 512 + c) * GIMG_LEN);
        __syncthreads();
        f32x4 acc[4][4];
        Run16 xr[4];
        { const int b = n & 7;
#pragma unroll
          for (int nt = 0; nt < 4; ++nt) xr[nt] = run16_load(hy + (size_t)c * NTOK + b * SEQ, (8 * q + 2 * nt + (n >> 3)) * 64 + 16 * g); }
        hy_conv(F, acc);
        __syncthreads();
        {
            const float bias = hb[c]; const int b = n & 7;
            const float w0 = cw[c], w1 = cw[1536 + c], w2 = cw[2 * 1536 + c];
#pragma unroll
            for (int nt = 0; nt < 4; ++nt) {
                const int t1 = 8 * q + 2 * nt + (n >> 3), t0 = 16 * g;
                LAS u32x4* vp = (LAS u32x4*)(F.lds + HY_V + ((t1 + 7) * 8 + b) * HY_VROW + t0 * 2);
                float xv[16]; run16_conv(xr[nt], t1 * 64 + t0, w0, w1, w2, xv);
                const u32x4 v0 = vp[0], v1 = vp[1];
                const unsigned vw[8] = {v0.x, v0.y, v0.z, v0.w, v1.x, v1.y, v1.z, v1.w};
                unsigned ow[8];
#pragma unroll
                for (int p = 0; p < 8; ++p) {
                    const int e0 = 2 * p, e1 = 2 * p + 1;
                    const float z0 = xv[e0] * (acc[e0 & 3][nt][e0 >> 2] + bias * bflo(vw[p]));
                    const float z1 = xv[e1] * (acc[e1 & 3][nt][e1 >> 2] + bias * bfhi(vw[p]));
                    ow[p] = pk2(z0, z1); }
                vp[0] = (u32x4){ow[0], ow[1], ow[2], ow[3]}; vp[1] = (u32x4){ow[4], ow[5], ow[6], ow[7]};
            }
        }
        hy_load_fimg(F, fimg + (size_t)(1 * 512 + c) * GIMG_LEN);
        { const int b = n & 7;
#pragma unroll
          for (int nt = 0; nt < 4; ++nt) xr[nt] = run16_load(hy + (size_t)(512 + c) * NTOK + b * SEQ, (8 * q + 2 * nt + (n >> 3)) * 64 + 16 * g); }
        __syncthreads();
        hy_conv(F, acc);
        {
            const float bias = hb[HW + c]; const int b = n & 7;
            const float w0 = cw[512 + c], w1 = cw[1536 + 512 + c], w2 = cw[2 * 1536 + 512 + c];
#pragma unroll
            for (int nt = 0; nt < 4; ++nt) {
                const int t1 = 8 * q + 2 * nt + (n >> 3), t0 = 16 * g;
                const LAS u32x4* vp = (const LAS u32x4*)(F.lds + HY_V + ((t1 + 7) * 8 + b) * HY_VROW + t0 * 2);
                float xv[16]; run16_conv(xr[nt], t1 * 64 + t0, w0, w1, w2, xv);
                GAS u32x4* op = (GAS u32x4*)(yT + (size_t)c * NTOK + b * SEQ + t1 * 64 + t0);
                const u32x4 v0 = vp[0], v1 = vp[1];
                const unsigned vw[8] = {v0.x, v0.y, v0.z, v0.w, v1.x, v1.y, v1.z, v1.w};
                unsigned ow[8];
#pragma unroll
                for (int p = 0; p < 8; ++p) {
                    const int e0 = 2 * p, e1 = 2 * p + 1;
                    const float z0 = xv[e0] * (acc[e0 & 3][nt][e0 >> 2] + bias * bflo(vw[p]));
                    const float z1 = xv[e1] * (acc[e1 & 3][nt][e1 >> 2] + bias * bfhi(vw[p]));
                    ow[p] = pk2(z0, z1); }
                op[0] = (u32x4){ow[0], ow[1], ow[2], ow[3]}; op[1] = (u32x4){ow[4], ow[5], ow[6], ow[7]};
            }
        }
        __syncthreads();
    }
}

constexpr int AK_SLOT = 16384, AV_BASE = 65536, AV_SLOT = 16384;
constexpr int AT_X = 0, AT_XROW = 132 * 4, AT_Y = 4 * 32 * AT_XROW, AT_YROW = 272;
constexpr int AT_OFS = 131072;
static_assert(AT_Y + 128 * AT_YROW <= AT_OFS && AV_BASE + 4 * AV_SLOT <= AT_OFS && AT_OFS + 512 * 16 <= LDS_MISC, "attn LDS");
#define AT_SBAR() __builtin_amdgcn_sched_barrier(0)
#define AT_PIN(x) asm volatile("" : "+v"(x))
#define AT_MFMA(a_, b_, c_) __builtin_amdgcn_mfma_f32_32x32x16_bf16(a_, b_, c_, 0, 0, 0)
#define AT_LDK(slot_, mt_, kk_) (*(const LAS bf16x8*)(pk[kk_] + ((slot_) * AK_SLOT + (mt_) * 8192)))
#define AT_LDV(slot_, ks_, mv_) (*(const LAS bf16x8*)(pv[ks_] + ((slot_) * AV_SLOT + (mv_) * 4096)))
#define AT_QTR(SRC, SP, DST, KK0, CIN, KF0, KF1, VF0, VF1, VF2, VF3, PP, PC, NK0, NK1, NKS, NKM, NKK, NV0, NV1, NV2, NV3, NVS, NVK) do { \
        float e0_, e1_, e2_, e3_, e4_, e5_, e6_, e7_; unsigned w0_, w1_, w2_, w3_; \
        DST = AT_MFMA(KF0, qf[KK0], CIN); NK0 = AT_LDK(NKS, NKM, NKK); \
        e0_ = __builtin_amdgcn_exp2f(SRC[8 * (SP)]); e1_ = __builtin_amdgcn_exp2f(SRC[8 * (SP) + 1]); AT_PIN(e0_); AT_PIN(e1_); AT_SBAR(); \
        DST = AT_MFMA(KF1, qf[(KK0) + 1], DST); NK1 = AT_LDK(NKS, NKM, (NKK) + 1); \
        e2_ = __builtin_amdgcn_exp2f(SRC[8 * (SP) + 2]); e3_ = __builtin_amdgcn_exp2f(SRC[8 * (SP) + 3]); lsum += e0_; lsum += e1_; AT_PIN(e2_); AT_PIN(e3_); AT_PIN(lsum); AT_SBAR(); \
        o[0] = AT_MFMA(VF0, PP, o[0]); NV0 = AT_LDV(NVS, NVK, 0); \
        e4_ = __builtin_amdgcn_exp2f(SRC[8 * (SP) + 4]); e5_ = __builtin_amdgcn_exp2f(SRC[8 * (SP) + 5]); lsum += e2_; lsum += e3_; AT_PIN(e4_); AT_PIN(e5_); AT_PIN(lsum); AT_SBAR(); \
        o[1] = AT_MFMA(VF1, PP, o[1]); NV1 = AT_LDV(NVS, NVK, 1); \
        e6_ = __builtin_amdgcn_exp2f(SRC[8 * (SP) + 6]); e7_ = __builtin_amdgcn_exp2f(SRC[8 * (SP) + 7]); lsum += e4_; lsum += e5_; AT_PIN(e6_); AT_PIN(e7_); AT_PIN(lsum); AT_SBAR(); \
        o[2] = AT_MFMA(VF2, PP, o[2]); NV2 = AT_LDV(NVS, NVK, 2); \
        w0_ = pk2(e0_, e1_); w1_ = pk2(e2_, e3_); lsum += e6_; lsum += e7_; AT_PIN(w0_); AT_PIN(w1_); AT_PIN(lsum); AT_SBAR(); \
        o[3] = AT_MFMA(VF3, PP, o[3]); NV3 = AT_LDV(NVS, NVK, 3); \
        w2_ = pk2(e4_, e5_); w3_ = pk2(e6_, e7_); AT_PIN(w2_); AT_PIN(w3_); AT_SBAR(); \
        PC = __builtin_bit_cast(bf16x8, (u32x4){w0_, w1_, w2_, w3_}); } while (0)

__device__ __forceinline__ void phase_attn(Frame& F, int layer) {
    const GAS bf16_t* qk = (const GAS bf16_t*)(F.ws + WS_QK); const GAS bf16_t* vT = (const GAS bf16_t*)(F.ws + WS_CHT) + (size_t)1536 * NTOK;
    GAS bf16_t* ya = (GAS bf16_t*)(F.ws + WS_YCAT) + 512;
    const float lambda_init = 0.8f - 0.6f * fast_exp(-0.3f * (float)layer);
    float lam;
    {
        const GAS float* q1 = (const GAS float*)argp(14) + layer * HD; const GAS float* k1 = (const GAS float*)argp(15) + layer * HD; const GAS float* q2 = (const GAS float*)argp(16) + layer * HD; const GAS float* k2 = (const GAS float*)argp(17) + layer * HD;
        float s1 = 0.f, s2 = 0.f;
        for (int i = 0; i < HD; ++i) { s1 += q1[i] * k1[i]; s2 += q2[i] * k2[i]; }
        lam = fast_exp(s1) - fast_exp(s2) + lambda_init;
    }
    const GAS float* subg = (const GAS float*)argp(18) + layer * DV;
    const int w = F.wave, comp = w >> 2, qs = w & 3, i = F.lane & 31, hh = F.lane >> 5;
    const int pi_i = i ^ ((((i >> 2) ^ (i >> 3)) & 1) * 12);
    {
        u32x4 ofs;
        { const int key0 = 8 * w + (F.lane >> 4), key1 = key0 + 4; ofs.x = (unsigned)(key0 * 2048 + (((F.lane & 15) ^ (key0 & 15)) << 4)); ofs.y = (unsigned)(key1 * 2048 + (((F.lane & 15) ^ (key1 & 15)) << 4));
          const int dv0 = 16 * w + (F.lane >> 3), dv1 = dv0 + 8; ofs.z = (unsigned)dv0 * (unsigned)(NTOK * 2) + (unsigned)((((F.lane & 7) ^ ((dv0 >> 1) & 7))) << 4); ofs.w = (unsigned)dv1 * (unsigned)(NTOK * 2) + (unsigned)((((F.lane & 7) ^ ((dv1 >> 1) & 7))) << 4); }
        *(LAS u32x4*)(F.lds + AT_OFS + F.tid * 16) = ofs;
    }
    const LAS uchar* pk[4]; const LAS uchar* pv[4];
#pragma unroll
    for (int kk = 0; kk < 4; ++kk) { const int ch = comp * 8 + 2 * kk + hh; pk[kk] = F.lds + (unsigned)(pi_i * 256 + ((ch ^ (pi_i & 15)) << 4)); }
#pragma unroll
    for (int ks = 0; ks < 4; ++ks) { const int cv = 2 * ks + hh; pv[ks] = F.lds + (unsigned)(AV_BASE + i * 128 + ((cv ^ ((i >> 1) & 7)) << 4)); }
    const f32x16 negMv = {0.f, 0.f, 0.f, 0.f, 0.f, 0.f, 0.f, 0.f, 0.f, 0.f, 0.f, 0.f, 0.f, 0.f, 0.f, 0.f};
#define AT_ISSUE_KV(tk_, tv_) do { const int tk2_ = (tk_) < 64 ? (tk_) : 63, tv2_ = (tv_) < 64 ? (tv_) : 63; \
        const GAS char* kb_ = kbase + (size_t)tk2_ * 131072; const GAS char* vb_ = vbase + (size_t)tv2_ * 128; asm volatile("" : "+s"(kb_), "+s"(vb_));     \
        __builtin_amdgcn_global_load_lds((const GAS unsigned*)(kb_ + ofs.x), (LAS unsigned*)(F.lds + ((tk_) & 3) * AK_SLOT + (2 * w) * 1024), 16, 0, 0); \
        __builtin_amdgcn_global_load_lds((const GAS unsigned*)(kb_ + ofs.y), (LAS unsigned*)(F.lds + ((tk_) & 3) * AK_SLOT + (2 * w + 1) * 1024), 16, 0, 0); \
        __builtin_amdgcn_global_load_lds((const GAS unsigned*)(vb_ + ofs.z), (LAS unsigned*)(F.lds + AV_BASE + ((tv_) & 3) * AV_SLOT + (2 * w) * 1024), 16, 0, 0); \
        __builtin_amdgcn_global_load_lds((const GAS unsigned*)(vb_ + ofs.w), (LAS unsigned*)(F.lds + AV_BASE + ((tv_) & 3) * AV_SLOT + (2 * w + 1) * 1024), 16, 0, 0); } while (0)
#define AT_LOAD_OFS() (ofs = *(const LAS u32x4*)(F.lds + AT_OFS + F.tid * 16))
#define AT_ISSUE_K(t_) do { const int tt_ = (t_) < 64 ? (t_) : 63; const u32x2 ofs_ = *(const LAS u32x2*)(F.lds + AT_OFS + F.tid * 16); \
        __builtin_amdgcn_global_load_lds((const GAS unsigned*)(kbase + (size_t)tt_ * 131072 + ofs_.x), (LAS unsigned*)(F.lds + ((t_) & 3) * AK_SLOT + (2 * w) * 1024), 16, 0, 0); \
        __builtin_amdgcn_global_load_lds((const GAS unsigned*)(kbase + (size_t)tt_ * 131072 + ofs_.y), (LAS unsigned*)(F.lds + ((t_) & 3) * AK_SLOT + (2 * w + 1) * 1024), 16, 0, 0); } while (0)
#define AT_ISSUE_V(t_) do { const int tt_ = (t_) < 64 ? (t_) : 63; const u32x2 ofs_ = *(const LAS u32x2*)(F.lds + AT_OFS + F.tid * 16 + 8); \
        __builtin_amdgcn_global_load_lds((const GAS unsigned*)(vbase + (size_t)tt_ * 128 + ofs_.x), (LAS unsigned*)(F.lds + AV_BASE + ((t_) & 3) * AV_SLOT + (2 * w) * 1024), 16, 0, 0); \
        __builtin_amdgcn_global_load_lds((const GAS unsigned*)(vbase + (size_t)tt_ * 128 + ofs_.y), (LAS unsigned*)(F.lds + AV_BASE + ((t_) & 3) * AV_SLOT + (2 * w + 1) * 1024), 16, 0, 0); } while (0)
#define AT_TILE(t_, S_, N_) do { \
        if ((t_) > 0) { asm volatile("s_waitcnt vmcnt(4)\n\ts_barrier" ::: "memory"); } \
        AT_ISSUE_KV((t_) + 3, (t_) + 2); \
          \
        AT_QTR(sA, 0, sB, 0, negMv, kx0, kx1, vx0, vx1, vx2, vx3, pp, pc, ky0, ky1, S_, 1, 2, vy0, vy1, vy2, vy3, S_, 0); \
          \
        AT_QTR(sA, 1, sB, 2, sB, ky0, ky1, vy0, vy1, vy2, vy3, pc, pp, kx0, kx1, N_, 0, 0, vx0, vx1, vx2, vx3, S_, 1); \
          \
        AT_QTR(sB, 0, sA, 0, negMv, kx0, kx1, vx0, vx1, vx2, vx3, pp, pc, ky0, ky1, N_, 0, 2, vy0, vy1, vy2, vy3, S_, 2); \
          \
        AT_QTR(sB, 1, sA, 2, sA, ky0, ky1, vy0, vy1, vy2, vy3, pc, pp, kx0, kx1, N_, 1, 0, vx0, vx1, vx2, vx3, S_, 3); \
        AT_LOAD_OFS();        \
    } while (0)
    for (int r = 0; r < 4; ++r) {
        int bh, qb;
        if (F.G == 256) { bh = (F.bid & 7) + 8 * r; qb = F.bid >> 3; }
        else { const int u = F.bid + r * F.G; if (u >= 1024) break; bh = u >> 5; qb = u & 31; }
        const int b = bh >> 2, h = bh & 3;
        const size_t row0 = (size_t)b * SEQ;
        const GAS char* kbase = (const GAS char*)(qk + row0 * 1024 + 512 + h * 128);
        const GAS char* vbase = (const GAS char*)(vT + (size_t)(h * 128) * NTOK + row0);
        AT_ISSUE_K(0); AT_ISSUE_K(1); AT_ISSUE_V(0); AT_ISSUE_K(2); AT_ISSUE_V(1);
        bf16x8 qf[4];
        { const GAS bf16_t* qp = qk + (row0 + qb * 128 + qs * 32 + i) * 1024 + h * 128 + comp * 64 + 8 * hh;
#pragma unroll
          for (int kk = 0; kk < 4; ++kk) qf[kk] = *(const GAS bf16x8*)(qp + 16 * kk); }
        f32x16 o[4];
#pragma unroll
        for (int m = 0; m < 4; ++m)
#pragma unroll
            for (int e = 0; e < 16; ++e) o[m][e] = 0.f;
        float lsum = 0.f;
        asm volatile("s_waitcnt vmcnt(0)\n\ts_barrier" ::: "memory");
        f32x16 sA, sB;
        bf16x8 kx0, kx1, vx0, vx1, vx2, vx3, ky0, ky1, vy0, vy1, vy2, vy3, pp, pc;
        sA = negMv;
#pragma unroll
        for (int kk = 0; kk < 4; ++kk) sA = AT_MFMA(AT_LDK(0, 0, kk), qf[kk], sA);
        kx0 = AT_LDK(0, 1, 0); kx1 = AT_LDK(0, 1, 1);
        vx0 = AT_LDV(0, 3, 0); vx1 = AT_LDV(0, 3, 1); vx2 = AT_LDV(0, 3, 2); vx3 = AT_LDV(0, 3, 3);
        pp = (bf16x8){0, 0, 0, 0, 0, 0, 0, 0}; pc = pp; sB = negMv;
        u32x4 ofs; AT_LOAD_OFS();
        for (int t = 0; t < 64; t += 4) {
            AT_TILE(t, 0, 1); AT_TILE(t + 1, 1, 2); AT_TILE(t + 2, 2, 3); AT_TILE(t + 3, 3, 0);
        }
        o[0] = AT_MFMA(vx0, pp, o[0]); o[1] = AT_MFMA(vx1, pp, o[1]); o[2] = AT_MFMA(vx2, pp, o[2]); o[3] = AT_MFMA(vx3, pp, o[3]);
        asm volatile("s_waitcnt vmcnt(0)\n\ts_barrier" ::: "memory");
        const float ltot = lsum + xor32(lsum);
        const float inv = (comp ? lam : 1.0f) * __builtin_amdgcn_rcpf(ltot);
        if (comp == 1) {
#pragma unroll
            for (int mv = 0; mv < 4; ++mv)
#pragma unroll
                for (int g = 0; g < 4; ++g) { const int dv = 32 * mv + 8 * g + 4 * hh;
                    *(LAS f32x4*)(F.lds + AT_X + (qs * 32 + i) * AT_XROW + dv * 4) = (f32x4){o[mv][4 * g] * inv, o[mv][4 * g + 1] * inv, o[mv][4 * g + 2] * inv, o[mv][4 * g + 3] * inv}; }
        }
        __syncthreads();
        if (comp == 0) {
            float ss = 0.f;
#pragma unroll
            for (int mv = 0; mv < 4; ++mv)
#pragma unroll
                for (int g = 0; g < 4; ++g) { const int dv = 32 * mv + 8 * g + 4 * hh;
                    const f32x4 x = *(const LAS f32x4*)(F.lds + AT_X + (qs * 32 + i) * AT_XROW + dv * 4);
#pragma unroll
                    for (int j = 0; j < 4; ++j) { const float v = o[mv][4 * g + j] * inv - x[j]; o[mv][4 * g + j] = v; ss += v * v; } }
            ss += xor32(ss);
            const float rn = (1.0f - lambda_init) * __builtin_amdgcn_rsqf(ss * (1.0f / DV) + RMS_EPS);
#pragma unroll
            for (int mv = 0; mv < 4; ++mv)
#pragma unroll
                for (int g = 0; g < 4; ++g) { const int dv = 32 * mv + 8 * g + 4 * hh; const f32x4 gg = *(const GAS f32x4*)(subg + dv);
                    u32x2 wv; wv.x = pk2(o[mv][4 * g] * rn * gg.x, o[mv][4 * g + 1] * rn * gg.y); wv.y = pk2(o[mv][4 * g + 2] * rn * gg.z, o[mv][4 * g + 3] * rn * gg.w);
                    *(LAS u32x2*)(F.lds + AT_Y + (qs * 32 + i) * AT_YROW + dv * 2) = wv; }
        }
        __syncthreads();
#pragma unroll
        for (int p2 = 0; p2 < 4; ++p2) { const int p = F.tid + 512 * p2, qq = p >> 4, c8 = p & 15;
            *(GAS u32x4*)(ya + (row0 + qb * 128 + qq) * 1024 + h * 128 + c8 * 8) = *(const LAS u32x4*)(F.lds + AT_Y + qq * AT_YROW + c8 * 16); }
        __syncthreads();
    }
#undef AT_ISSUE_K
#undef AT_ISSUE_KV
#undef AT_LOAD_OFS
#undef AT_ISSUE_V
#undef AT_TILE
}
template <bool F8> __device__ __forceinline__ void phase_norm_router(Frame& F, const bf16_t* x, const float* g, typename OutT<F8>::t* h2) {
    const GAS float* wr = (const GAS float*)argp(26);
    GAS int* topi = (GAS int*)(F.ws + WS_TOPI); GAS float* topw = (GAS float*)(F.ws + WS_TOPW); GAS int* counts = (GAS int*)(F.ws + WS_COUNTS);
    LAS int* hist = (LAS int*)(F.lds + 65536);
    for (int rb = F.bid; rb < 256; rb += F.G) {
        if (F.tid < 8) hist[F.tid] = 0;
        __syncthreads();
        int ln = F.lane; asm volatile("" : "+v"(ln));
        f32x4 wreg[2][8][2], gg[2][2];
#pragma unroll
        for (int j = 0; j < 2; ++j) { gg[j][0] = ((const GAS f32x4*)g)[2 * ln + 128 * j]; gg[j][1] = ((const GAS f32x4*)g)[2 * ln + 128 * j + 1];
#pragma unroll
            for (int t = 0; t < 8; ++t) { const GAS f32x4* wp = (const GAS f32x4*)(wr + (size_t)(512 * j + 8 * ln + t) * 8); wreg[j][t][0] = wp[0]; wreg[j][t][1] = wp[1]; } }
        const bool b0 = (ln & 1) != 0, b1 = (ln & 2) != 0, b2 = (ln & 4) != 0;
        const int m0 = rb * 128 + F.wave * 16;
        u32x4 nx[2];
#pragma unroll
        for (int j = 0; j < 2; ++j) nx[j] = ((const GAS u32x4*)(x + (size_t)m0 * XR_LD) + ln)[64 * j];
#pragma clang loop unroll(disable)
        for (int rr = 0; rr < 16; ++rr) {
            const int m = m0 + rr, mn = m + (rr < 15 ? 1 : 0);
            const u32x4 cw[2] = {nx[0], nx[1]};
#pragma unroll
            for (int j = 0; j < 2; ++j) nx[j] = ((const GAS u32x4*)(x + (size_t)mn * XR_LD) + ln)[64 * j];
            float v[2][8]; float s = 0.f;
#pragma unroll
            for (int j = 0; j < 2; ++j) { const u32x4 w = cw[j]; v[j][0] = bflo(w.x); v[j][1] = bfhi(w.x); v[j][2] = bflo(w.y); v[j][3] = bfhi(w.y); v[j][4] = bflo(w.z); v[j][5] = bfhi(w.z); v[j][6] = bflo(w.w); v[j][7] = bfhi(w.w);
#pragma unroll
                for (int e = 0; e < 8; ++e) s += v[j][e] * v[j][e]; }
            const float r = __builtin_amdgcn_rsqf(wave_sum(s) * (1.0f / DM) + RMS_EPS);
            float lg[8];
#pragma unroll
            for (int e = 0; e < 8; ++e) lg[e] = 0.f;
            typename OutT<F8>::t* o8 = h2 + (size_t)m * (F8 ? P8 : DM);
#pragma unroll
            for (int j = 0; j < 2; ++j) { const f32x4 ga = gg[j][0], gb = gg[j][1]; float hv[8];
                hv[0] = v[j][0] * r * ga.x; hv[1] = v[j][1] * r * ga.y; hv[2] = v[j][2] * r * ga.z; hv[3] = v[j][3] * r * ga.w; hv[4] = v[j][4] * r * gb.x; hv[5] = v[j][5] * r * gb.y; hv[6] = v[j][6] * r * gb.z; hv[7] = v[j][7] * r * gb.w;
                if constexpr (F8) ((GAS u32x2*)o8 + ln)[64 * j] = (u32x2){pk4_f8(clamp_f8(hv[0] * F8_SH), clamp_f8(hv[1] * F8_SH), clamp_f8(hv[2] * F8_SH), clamp_f8(hv[3] * F8_SH)), pk4_f8(clamp_f8(hv[4] * F8_SH), clamp_f8(hv[5] * F8_SH), clamp_f8(hv[6] * F8_SH), clamp_f8(hv[7] * F8_SH))};
                else ((GAS u32x4*)o8 + ln)[64 * j] = (u32x4){pk2(hv[0], hv[1]), pk2(hv[2], hv[3]), pk2(hv[4], hv[5]), pk2(hv[6], hv[7])};
#pragma unroll
                for (int t = 0; t < 8; ++t) { const f32x4 wa = wreg[j][t][0], wb = wreg[j][t][1]; const float hx = hv[t];
                    lg[0] += hx * wa.x; lg[1] += hx * wa.y; lg[2] += hx * wa.z; lg[3] += hx * wa.w; lg[4] += hx * wb.x; lg[5] += hx * wb.y; lg[6] += hx * wb.z; lg[7] += hx * wb.w; } }
            float q4[4], q2[2], q1;
#pragma unroll
            for (int i = 0; i < 4; ++i) { const float keep = b0 ? lg[i + 4] : lg[i], send = b0 ? lg[i] : lg[i + 4]; q4[i] = keep + xor_swz<1>(send); }
#pragma unroll
            for (int i = 0; i < 2; ++i) { const float keep = b1 ? q4[i + 2] : q4[i], send = b1 ? q4[i] : q4[i + 2]; q2[i] = keep + xor_swz<2>(send); }
            { const float keep = b2 ? q2[1] : q2[0], send = b2 ? q2[0] : q2[1]; q1 = keep + xor_swz<4>(send); }
            q1 += xor_swz<8>(q1); q1 += xor_swz<16>(q1); q1 += xor32(q1);
#pragma unroll
            for (int e = 0; e < 8; ++e) lg[e] = __builtin_bit_cast(float, __builtin_amdgcn_readlane(__builtin_bit_cast(int, q1), ((e >> 2) & 1) | (((e >> 1) & 1) << 1) | ((e & 1) << 2)));
            int i0 = 0; float v0 = lg[0];
#pragma unroll
            for (int e = 1; e < 8; ++e) if (lg[e] > v0) { v0 = lg[e]; i0 = e; }
            int i1 = -1; float v1 = -3.0e38f;
#pragma unroll
            for (int e = 0; e < 8; ++e) if (e != i0 && lg[e] > v1) { v1 = lg[e]; i1 = e; }
            if (ln == 0) { const float e1 = fast_exp(v1 - v0), w0 = __builtin_amdgcn_rcpf(1.0f + e1);
                topi[2 * m] = i0; topi[2 * m + 1] = i1; topw[2 * m] = w0; topw[2 * m + 1] = e1 * w0;
                atomicAdd((int*)&hist[i0], 1); atomicAdd((int*)&hist[i1], 1); }
        }
        __syncthreads();
        if (F.tid < 8) counts[rb * 8 + F.tid] = hist[F.tid];
        __syncthreads();
    }
    GAS int* tokof = (GAS int*)(F.ws + WS_TOKOF);
    for (int i = F.bid * NTHR + F.tid; i < PSLOTS; i += F.G * NTHR) tokof[i] = -1;
}
constexpr int MOE_TAB = 140000, MOE_TOKL = 144 * 1024;
static_assert(MOE_TOKL + 12 * 1024 <= LDS_MISC, "moe lds");
__device__ __forceinline__ void moe_tables(Frame& F) {
    const GAS int* counts = (const GAS int*)(F.ws + WS_COUNTS);
    LAS int* tab = (LAS int*)(F.lds + MOE_TAB);
    __syncthreads();
    if (F.tid < 8) tab[F.tid] = 0;
    __syncthreads();
    for (int i = F.tid; i < 2048; i += NTHR) atomicAdd((int*)&tab[i & 7], counts[i]);
    __syncthreads();
    if (F.tid == 0) { int off = 0; for (int e = 0; e < 8; ++e) { tab[8 + e] = off; const int np = (tab[e] + 255) >> 8; for (int p = 0; p < np; ++p) tab[32 + (off >> 8) + p] = e; off += np << 8; } tab[16] = off >> 8; }
    __syncthreads();
}
__device__ __forceinline__ void phase_moe_assign(Frame& F) {
    const GAS int* counts = (const GAS int*)(F.ws + WS_COUNTS); const GAS int* topi = (const GAS int*)(F.ws + WS_TOPI);
    GAS int* slotof = (GAS int*)(F.ws + WS_SLOT); GAS int* tokof = (GAS int*)(F.ws + WS_TOKOF);
    moe_tables(F);
    LAS int* tab = (LAS int*)(F.lds + MOE_TAB);
    LAS int* sc = (LAS int*)(F.lds + 65536);
    for (int rb = F.bid; rb < 256; rb += F.G) {
        if (F.tid < 8) sc[F.tid] = tab[8 + F.tid];
        __syncthreads();
        for (int i2 = F.tid; i2 < rb * 8; i2 += NTHR) atomicAdd((int*)&sc[i2 & 7], counts[i2]);
        int e = -1, rank = 0;
        if (F.tid < 256) { e = topi[rb * 256 + F.tid];
            for (int ee = 0; ee < 8; ++ee) { const unsigned long long mk = __ballot(e == ee); if (e == ee) rank = __popcll(mk & ((1ull << F.lane) - 1ull)); if (F.lane == 0) sc[8 + F.wave * 8 + ee] = __popcll(mk); } }
        __syncthreads();
        if (F.tid < 256) { int pre = 0; for (int w2 = 0; w2 < F.wave; ++w2) pre += sc[8 + w2 * 8 + e];
            const int slot = sc[e] + pre + rank; const int tok = rb * 128 + (F.tid >> 1);
            slotof[rb * 256 + F.tid] = slot; tokof[slot] = tok; }
        __syncthreads();
    }
}
constexpr int REM_SLOT0 = 256 * 256;
__device__ __forceinline__ void phase_moe_combine(Frame& F, int bid0) {
    const GAS int* slotof = (const GAS int*)(F.ws + WS_SLOT); const GAS float* topw = (const GAS float*)(F.ws + WS_TOPW); const GAS bf16_t* yp = (const GAS bf16_t*)(F.ws + WS_XP);
    const int gw = (F.bid - bid0) * NWAVES + F.wave, NGW = (F.G - bid0) * NWAVES;
    int sa0, sa1; float wa0, wa1;
    u32x4 x0, x1, a0, a1, b0, b1; float w0 = 0.f, w1 = 0.f;
#define CMB_A(tok_) do { const int t_ = (tok_) < NTOK ? (tok_) : NTOK - 1; sa0 = slotof[2 * t_]; sa1 = slotof[2 * t_ + 1]; wa0 = topw[2 * t_]; wa1 = topw[2 * t_ + 1]; } while (0)
#define CMB_B(tok_) do { const int t_ = (tok_) < NTOK ? (tok_) : NTOK - 1; const int r0 = sa0 < REM_SLOT0 ? sa0 : 0, r1 = sa1 < REM_SLOT0 ? sa1 : 0;        \
        w0 = sa0 < REM_SLOT0 ? wa0 : 0.f; w1 = sa1 < REM_SLOT0 ? wa1 : 0.f; \
        const GAS u32x4* xp = (const GAS u32x4*)((const GAS bf16_t*)F.out + (size_t)t_ * XR_LD) + 2 * F.lane;       \
        const GAS u32x4* ap = (const GAS u32x4*)(yp + (size_t)r0 * DM) + 2 * F.lane; const GAS u32x4* bp = (const GAS u32x4*)(yp + (size_t)r1 * DM) + 2 * F.lane; \
        x0 = xp[0]; x1 = xp[1]; a0 = ap[0]; a1 = ap[1]; b0 = bp[0]; b1 = bp[1]; } while (0)
    if (gw >= NTOK) return;
    CMB_A(gw); CMB_B(gw); CMB_A(gw + NGW);
    for (int tok = gw; tok < NTOK; tok += NGW) {
        const unsigned xw[8] = {x0.x, x0.y, x0.z, x0.w, x1.x, x1.y, x1.z, x1.w}, aw[8] = {a0.x, a0.y, a0.z, a0.w, a1.x, a1.y, a1.z, a1.w}, bw[8] = {b0.x, b0.y, b0.z, b0.w, b1.x, b1.y, b1.z, b1.w};
        float o[16];
#pragma unroll
        for (int p = 0; p < 8; ++p) { o[2 * p] = bflo(xw[p]) + w0 * bflo(aw[p]) + w1 * bflo(bw[p]); o[2 * p + 1] = bfhi(xw[p]) + w0 * bfhi(aw[p]) + w1 * bfhi(bw[p]); }
        __builtin_amdgcn_sched_barrier(0);
        CMB_B(tok + NGW);
        CMB_A(tok + 2 * NGW);
        __builtin_amdgcn_sched_barrier(0);
        GAS f32x4* op = (GAS f32x4*)(F.out + (size_t)tok * DM) + 4 * F.lane;
#pragma unroll
        for (int p = 0; p < 4; ++p) op[p] = (f32x4){o[4 * p], o[4 * p + 1], o[4 * p + 2], o[4 * p + 3]};
    }
#undef CMB_A
#undef CMB_B
}
__device__ __forceinline__ void phase_moe_fixup(Frame& F, int np) {
    const GAS int* slotof = (const GAS int*)(F.ws + WS_SLOT); const GAS int* tokof = (const GAS int*)(F.ws + WS_TOKOF); const GAS float* topw = (const GAS float*)(F.ws + WS_TOPW); const GAS bf16_t* yp = (const GAS bf16_t*)(F.ws + WS_XP);
    const int gw = F.bid * NWAVES + F.wave, NGW = F.G * NWAVES;
    for (int s = REM_SLOT0 + gw; s < np * 256; s += NGW) {
        const int tok = tokof[s]; if (tok < 0) continue;
        const int sa = slotof[2 * tok], sb = slotof[2 * tok + 1]; const int k = (sa == s) ? 0 : 1; const int other = k ? sa : sb;
        if (other >= REM_SLOT0 && other < s) continue;
        const float wk = topw[2 * tok + k], wo = other >= REM_SLOT0 ? topw[2 * tok + 1 - k] : 0.f; const int ro = other >= REM_SLOT0 ? other : s;
        const GAS u32x4* ap = (const GAS u32x4*)(yp + (size_t)s * DM) + 2 * F.lane; const GAS u32x4* bp = (const GAS u32x4*)(yp + (size_t)ro * DM) + 2 * F.lane;
        const u32x4 a0 = ap[0], a1 = ap[1], b0 = bp[0], b1 = bp[1];
        const unsigned aw[8] = {a0.x, a0.y, a0.z, a0.w, a1.x, a1.y, a1.z, a1.w}, bw[8] = {b0.x, b0.y, b0.z, b0.w, b1.x, b1.y, b1.z, b1.w};
        GAS f32x4* op = (GAS f32x4*)(F.out + (size_t)tok * DM) + 4 * F.lane;
#pragma unroll
        for (int p = 0; p < 4; ++p) { f32x4 o = op[p];
            o.x += wk * bflo(aw[2 * p]) + wo * bflo(bw[2 * p]); o.y += wk * bfhi(aw[2 * p]) + wo * bfhi(bw[2 * p]); o.z += wk * bflo(aw[2 * p + 1]) + wo * bflo(bw[2 * p + 1]); o.w += wk * bfhi(aw[2 * p + 1]) + wo * bfhi(bw[2 * p + 1]);
            op[p] = o; }
    }
}
constexpr int NPL = 16, NPHASE = 2 * NPL;
constexpr bool F8M = FP8_MOE != 0;
constexpr int MOE_DMK = F8M ? DM / 2 : DM, MOE_FFK = F8M ? FFP / 2 : FFP, MOE_EB = F8M ? 1 : 2;
constexpr int INP = I8_INPROJ ? 2 : 0;
constexpr int DUP = I8_DENSE_UP ? 2 : (FP8_DENSE ? 1 : 0);
constexpr bool DDN8 = FP8_DENSE != 0;
constexpr int INP_DMK = INP ? DM / 2 : DM, DUP_DMK = DUP ? DM / 2 : DM, DDN_FFK = DDN8 ? FFP / 2 : FFP;
static_assert(!(I8_INPROJ || I8_DENSE_UP) || FP8_MOE, "the int8 weights live where the bf16 MoE activations would end");
typedef OutT<F8M>::t moe_t; typedef OutT<(DUP == 1)>::t dgu_t; typedef OutT<DDN8>::t ddn_t;
struct Args { const float* in[30]; float* out; uchar* ws; int ph_lo, ph_hi, li, use_bar; };

__global__ void __launch_bounds__(NTHR, 2) mk_fwd(Args args) {
    extern __shared__ __attribute__((aligned(16))) uchar lds_raw[];
    Frame F;
    F.lds = (LAS uchar*)lds_raw;
    F.tid = threadIdx.x; F.lane = F.tid & 63; F.wave = __builtin_amdgcn_readfirstlane(F.tid >> 6);
    const int wave_s = F.wave;
    F.G = gridDim.x; F.bid = blockIdx.x;
    F.ws = args.ws; F.ctl = (unsigned*)(args.ws + WS_CTL); F.out = args.out;
    volatile LAS unsigned* misc = (volatile LAS unsigned*)(F.lds + LDS_MISC);
    if (F.tid < 64) misc[F.tid] = 0u;
    __syncthreads();
    XcdBarrier bar; bar.bar = F.ctl + CW_BAR + args.li * XCD_BAR_WORDS; bar.x = 0; bar.st = misc + 8;
    if (args.use_bar) bar = xcd_barrier_post(F.ctl + CW_BAR + args.li * XCD_BAR_WORDS, misc + 8);
    const int lo = args.ph_lo, hi = args.ph_hi;
    bool started = false;
#define PH_BEGIN(id) if (lo <= (id) && (id) < hi) { if (started) xcd_barrier(bar); started = true; \
    { int ws_ = wave_s; asm volatile("" : "+s"(ws_)); int ln_; asm volatile("v_mbcnt_lo_u32_b32 %0, -1, 0\n\tv_mbcnt_hi_u32_b32 %0, -1, %0" : "=v"(ln_));     F.lane = ln_; F.wave = ws_; F.tid = ws_ * 64 + ln_; \
      int b_ = blockIdx.x, g_ = gridDim.x; uchar* w_ = args.ws; float* o_ = args.out; asm volatile("" : "+s"(b_), "+s"(g_), "+s"(w_), "+s"(o_)); ASSUME_GLOBAL(w_); ASSUME_GLOBAL(o_); F.bid = b_; F.G = g_; F.ws = w_; F.out = o_; F.ctl = (unsigned*)w_; }
#define PH_END }
#define RELOAD_ID() do { int ws_ = wave_s; asm volatile("" : "+s"(ws_)); int ln_; asm volatile("v_mbcnt_lo_u32_b32 %0, -1, 0\n\tv_mbcnt_hi_u32_b32 %0, -1, %0" : "=v"(ln_));     F.lane = ln_; F.wave = ws_; F.tid = ws_ * 64 + ln_; } while (0)
#ifndef REP_ID
#define REP_ID -1
#endif
#ifndef REP_N
#define REP_N 1
#endif
#define REPEAT(id) RELOAD_ID(); for (int rep_ = 0; rep_ < ((id) == REP_ID ? REP_N : 1); ++rep_)
#define SITE(id, ...) { RELOAD_ID(); __VA_ARGS__ } if (REP_ID >= 0 && REP_ID == (id)) { { __VA_ARGS__ } { __VA_ARGS__ } }
#if DBG_CHECKS
#define CHK(x) x
#else
#define CHK(x)
#endif

    for (int layer = 0; layer < 2; ++layer) {
        const int pb = layer * NPL;
#define WSM (F.ws + WS_WSMALL + (size_t)layer * WSMALL_STRIDE)
#define WtokT ((bf16_t*)(WSM + OFF_WTOK))
#define WchT ((bf16_t*)(WSM + OFF_WCH))
#define PhT ((bf16_t*)(WSM + OFF_PH))
#define PaT ((bf16_t*)(WSM + OFF_PA))
#define WoutT ((bf16_t*)(WSM + OFF_WOUT))
#define hbuf ((bf16_t*)(F.ws + WS_H))
#define XR ((bf16_t*)F.out)
        const bool moe = (layer & 1) != 0;

        PH_BEGIN(pb + 0)
            CHK(if (layer == 1) chk_dense_down(F, 12); xcd_barrier(bar);)
            if (layer == 0) {
                for (int l2 = 0; l2 < 2; ++l2) { uchar* w2 = F.ws + WS_WSMALL + (size_t)l2 * WSMALL_STRIDE;
                    conv_win(F, argp(2) + (size_t)l2 * DM * INW, (bf16_t*)(w2 + OFF_WTOK), (bf16_t*)(w2 + OFF_WCH));
                    conv_plain(F, argp(19) + (size_t)l2 * HW * DM, HW, DM, (bf16_t*)(w2 + OFF_PH), DM);
                    conv_plain(F, argp(20) + (size_t)l2 * HW * DM, HW, DM, (bf16_t*)(w2 + OFF_PH) + HW, DM);
                    conv_plain(F, argp(21) + (size_t)l2 * DM * DM, DM, DM, (bf16_t*)(w2 + OFF_WOUT), DM); }
                conv_ffn<(DUP == 1), DDN8>(F, argp(23), argp(24), argp(25), (dgu_t*)(F.ws + WS_WGU), (ddn_t*)(F.ws + WS_WD), 1);
                rope_tables(F);
            }
            if (layer == 0) phase_norm<INP>(F, argp(0), argp(1) + layer * DM, (OutT<(INP != 0)>::t*)(F.ws + WS_H), (float*)(F.ws + WS_SH));
            else phase_norm_bf<INP>(F, XR, argp(1) + layer * DM, (OutT<(INP != 0)>::t*)(F.ws + WS_H), (float*)(F.ws + WS_SH));
            phase_hdn(F, layer);
        PH_END
        if (layer == 0 && (INP == 2 || DUP == 2)) {
            PH_BEGIN(pb + 1)
                if (INP == 2) for (int l2 = 0; l2 < 2; ++l2) { uchar* w2 = F.ws + WS_WSMALL + (size_t)l2 * WSMALL_STRIDE;
                    quant_rows(F, (const bf16_t*)(w2 + OFF_WTOK), F.ws + WS_I8W + l2 * I8W_LAYER, (float*)(F.ws + WS_SW) + l2 * SW_LAYER, 3072);
                    quant_rows(F, (const bf16_t*)(w2 + OFF_WCH), F.ws + WS_I8W + l2 * I8W_LAYER + I8W_CH, (float*)(F.ws + WS_SW) + l2 * SW_LAYER + 3072, 2048); }
                if (DUP == 2) quant_rows(F, (const bf16_t*)(F.ws + WS_WGU), F.ws + WS_I8W + I8W_DENSE, (float*)(F.ws + WS_SW) + SW_DENSE, 5632);
            PH_END
        }
        PH_BEGIN(pb + 2)
            CHK(if (layer == 0) chk_norm(F, argp(0), argp(1) + layer * DM, hbuf, layer * 13 + 1); xcd_barrier(bar);)
            SITE(pb + 1, const bf16_t* wtk = INP == 2 ? (const bf16_t*)(F.ws + WS_I8W + layer * I8W_LAYER) : WtokT; const float* sw = (const float*)(F.ws + WS_SW) + layer * SW_LAYER;
              pg8::Gemm g{hbuf, wtk, NTOK, 3072, INP_DMK, INP == 2 ? P8 : 0, INP == 2 ? P8 : 0}; pg8::StaticOrder S; S.init(NTOK, 3072, F.G, F.bid);
              pg8::EpiTok<INP> E{(bf16_t*)(F.ws + WS_QK), (uchar*)(F.ws + WS_GATES), argp(12) + layer * HD, argp(13) + layer * HD, (const bf16_t*)(F.ws + WS_ROPE), (const bf16_t*)(F.ws + WS_ROPE) + SEQ * 32, (const float*)(F.ws + WS_SH), sw};
              pg8::gemm_phase(F.lds, g, S, E, F.tid);)
            SITE(300 + pb + 1, const bf16_t* wch = INP == 2 ? (const bf16_t*)(F.ws + WS_I8W + layer * I8W_LAYER + I8W_CH) : WchT; const float* sw = (const float*)(F.ws + WS_SW) + layer * SW_LAYER + 3072;
              pg8::Gemm g{wch, hbuf, 2048, NTOK, INP_DMK, INP == 2 ? P8 : 0, INP == 2 ? P8 : 0}; pg8::StaticOrder S; S.init(2048, NTOK, F.G, F.bid);
              pg8::EpiBf16<INP> E{(bf16_t*)(F.ws + WS_CHT), NTOK, 0, 1.0f, sw, (const float*)(F.ws + WS_SH)};
              pg8::gemm_phase(F.lds, g, S, E, F.tid);)
            REPEAT(pb + 2) phase_fimg(F, layer);
        PH_END
        PH_BEGIN(pb + 3)
            CHK(chk_inproj(F, layer, layer * 13 + 2); chk_qkprep(F, layer, layer * 13 + 3); chk_fimg(F, layer, layer * 13 + 5); xcd_barrier(bar);)
            REPEAT(100 + pb + 3) phase_hyena(F, layer);
            REPEAT(200 + pb + 3) phase_attn(F, layer);
        PH_END
        PH_BEGIN(pb + 4)
            CHK(chk_hyena(F, layer, layer * 13 + 6); chk_attn(F, layer, layer * 13 + 7); xcd_barrier(bar);)
            REPEAT(pb + 4) phase_transpose_y(F);
        PH_END
        PH_BEGIN(pb + 5)
            CHK(chk_transpose(F, layer * 13 + 8); xcd_barrier(bar);)
            SITE(pb + 5, pg8::Gemm g{(const bf16_t*)(F.ws + WS_YCAT), PhT, NTOK, DM, DM}; pg8::StaticOrder S; S.init(NTOK, DM, F.G, F.bid);
              pg8::EpiMergeF E{(bf16_t*)(F.ws + WS_MERGED), (const uchar*)(F.ws + WS_GATES)};
              pg8::gemm_phase(F.lds, g, S, E, F.tid);)
        PH_END
        PH_BEGIN(pb + 6)
            CHK(chk_merge(F, layer, layer * 13 + 9); xcd_barrier(bar);)
            SITE(pb + 6, pg8::Gemm g{(const bf16_t*)(F.ws + WS_MERGED), WoutT, NTOK, DM, DM}; pg8::StaticOrder S; S.init(NTOK, DM, F.G, F.bid);
              if (layer == 0) { pg8::EpiRes<true> E{argp(0), XR, 1.0f}; pg8::gemm_phase(F.lds, g, S, E, F.tid); }
              else { pg8::EpiRes<false> E{nullptr, XR, 1.0f}; pg8::gemm_phase(F.lds, g, S, E, F.tid); })
        PH_END
        PH_BEGIN(pb + 7)
            CHK(if (layer == 0) chk_outproj(F, layer, 10); xcd_barrier(bar);)
            if (!moe) phase_norm_bf<DUP>(F, XR, argp(22) + layer * DM, (OutT<(DUP != 0)>::t*)(F.ws + WS_H), (float*)(F.ws + WS_SH));
            else {
                phase_norm_router<F8M>(F, XR, argp(22) + layer * DM, (moe_t*)(F.ws + WS_H2_MOE));
                REPEAT(pb + 7) conv_ffn<F8M>(F, argp(27), argp(28), argp(29), (moe_t*)(F.ws + WS_MOE_WGU), (moe_t*)(F.ws + WS_MOE_WD), NEXP);
            }
        PH_END
        if (!moe) {
            PH_BEGIN(pb + 9)
                SITE(pb + 9, pg8::Gemm g{hbuf, (const bf16_t*)(F.ws + (DUP == 2 ? WS_I8W + I8W_DENSE : WS_WGU)), NTOK, 5632, DUP_DMK, DUP == 2 ? P8 : 0, DUP == 2 ? P8 : 0}; pg8::StaticOrder S; S.init(NTOK, 5632, F.G, F.bid);
                  pg8::EpiSwiglu<DUP, DDN8> E{(bf16_t*)(F.ws + WS_ACT_DENSE), 0, (const float*)(F.ws + WS_SH), (const float*)(F.ws + WS_SW) + SW_DENSE};
                  pg8::gemm_phase(F.lds, g, S, E, F.tid);)
            PH_END
            PH_BEGIN(pb + 10)
                CHK(chk_dense_up(F, 11); xcd_barrier(bar);)
                { pg8::Gemm g{(const bf16_t*)(F.ws + WS_ACT_DENSE), (const bf16_t*)(F.ws + WS_WD), NTOK, DM, DDN_FFK}; pg8::StaticOrder S; S.init(NTOK, DM, F.G, F.bid);
                  pg8::EpiRes<false, DDN8> E{nullptr, XR, F8_DN_INV};
                  pg8::gemm_phase(F.lds, g, S, E, F.tid); }
            PH_END
        } else {
            PH_BEGIN(pb + 8)
                CHK(chk_router(F, 13 + 11); xcd_barrier(bar);)
                phase_moe_assign(F);
            PH_END
            for (int chunk = 0; chunk < 2; ++chunk) {
                PH_BEGIN(pb + 9 + 2 * chunk)
                    moe_tables(F);
                    CHK(if (chunk == 0) chk_assign(F, 13 + 12); xcd_barrier(bar);)
                    SITE(pb + 9 + 2 * chunk, const LAS int* tab = (const LAS int*)(F.lds + MOE_TAB); const int p0 = chunk * 128;
                      pg8::Gemm g{(const bf16_t*)(F.ws + WS_H2_MOE), (const bf16_t*)(F.ws + WS_MOE_WGU), 128 * 256, 5632, MOE_DMK, F8M ? P8 : 0, F8M ? P8 : 0};
                      pg8::MoeGatherOrder S; S.init(128 * 256, 5632, F.G, F.bid); S.p0 = p0; S.pexp = tab + 32; S.estride = F8M ? (long)5632 * P8 : (long)5632 * DM * 2; S.tokof = (const int*)(F.ws + WS_TOKOF); S.fill_tokl((LAS int*)(F.lds + MOE_TOKL), F.tid);
                      pg8::EpiSwiglu<(F8M ? 1 : 0), F8M> E{(bf16_t*)(F.ws + WS_ACT_MOE), p0, nullptr, nullptr};
                      pg8::gemm_phase(F.lds, g, S, E, F.tid);)
                    if (chunk == 1) {
                      SITE(pb + 14, const LAS int* tab = (const LAS int*)(F.lds + MOE_TAB); const int np = tab[16], nm = np - 256;
                        pg8::Gemm g{(const bf16_t*)(F.ws + WS_H2_MOE), (const bf16_t*)(F.ws + WS_MOE_WGU), nm * 256, 5632, MOE_DMK, F8M ? P8 : 0, F8M ? P8 : 0};
                        pg8::MoeGatherOrder S; S.init(nm * 256, 5632, F.G, F.bid); S.p0 = 256; S.pexp = tab + 32; S.estride = F8M ? (long)5632 * P8 : (long)5632 * DM * 2; S.tokof = (const int*)(F.ws + WS_TOKOF); S.fill_tokl((LAS int*)(F.lds + MOE_TOKL), F.tid);
                        pg8::EpiSwiglu<(F8M ? 1 : 0), F8M> E{(bf16_t*)(F.ws + WS_ACT_MOE), 128, nullptr, nullptr};
                        pg8::gemm_phase(F.lds, g, S, E, F.tid);)
                    }
                PH_END
                PH_BEGIN(pb + 10 + 2 * chunk)
                    moe_tables(F);
                    SITE(pb + 10 + 2 * chunk, const LAS int* tab = (const LAS int*)(F.lds + MOE_TAB); const int p0 = chunk * 128;
                      pg8::Gemm g{(const bf16_t*)(F.ws + WS_ACT_MOE) - (size_t)p0 * 256 * MOE_FFK, (const bf16_t*)(F.ws + WS_MOE_WD), 128 * 256, DM, MOE_FFK};
                      pg8::MoeOrder S; S.init(128 * 256, DM, F.G, F.bid); S.p0 = p0; S.pexp = tab + 32; S.estride = (long)DM * FFP * MOE_EB;
                      pg8::EpiBf16<(F8M ? 1 : 0)> E{(bf16_t*)(F.ws + WS_XP), DM, 0, F8_DN_INV, nullptr, nullptr};
                      pg8::gemm_phase(F.lds, g, S, E, F.tid);)
                PH_END
            }
            PH_BEGIN(pb + 13)
                CHK(chk_moe_ffn(F, 13 + 13); xcd_barrier(bar);)
                moe_tables(F);
                if (F.G >= 64 && F.bid < 32) {
                    SITE(pb + 13, const LAS int* tab = (const LAS int*)(F.lds + MOE_TAB); const int np = tab[16], nm = np - 256;
                      pg8::Gemm g{(const bf16_t*)(F.ws + WS_ACT_MOE) - (size_t)128 * 256 * MOE_FFK, (const bf16_t*)(F.ws + WS_MOE_WD), nm * 256, DM, MOE_FFK};
                      pg8::MoeOrder S; S.init(nm * 256, DM, 32, F.bid); S.p0 = 256; S.pexp = tab + 32; S.estride = (long)DM * FFP * MOE_EB;
                      pg8::EpiBf16<(F8M ? 1 : 0)> E{(bf16_t*)(F.ws + WS_XP), DM, 0, F8_DN_INV, nullptr, nullptr};
                      pg8::gemm_phase(F.lds, g, S, E, F.tid);)
                } else if (F.G >= 64) phase_moe_combine(F, 32);
                else {
                    { const LAS int* tab = (const LAS int*)(F.lds + MOE_TAB); const int np = tab[16], nm = np - 256;
                      pg8::Gemm g{(const bf16_t*)(F.ws + WS_ACT_MOE) - (size_t)128 * 256 * MOE_FFK, (const bf16_t*)(F.ws + WS_MOE_WD), nm * 256, DM, MOE_FFK};
                      pg8::MoeOrder S; S.init(nm * 256, DM, F.G, F.bid); S.p0 = 256; S.pexp = tab + 32; S.estride = (long)DM * FFP * MOE_EB;
                      pg8::EpiBf16<(F8M ? 1 : 0)> E{(bf16_t*)(F.ws + WS_XP), DM, 0, F8_DN_INV, nullptr, nullptr};
                      pg8::gemm_phase(F.lds, g, S, E, F.tid); }
                    phase_moe_combine(F, 0);
                }
            PH_END
            PH_BEGIN(pb + 15)
                moe_tables(F);
                { const LAS int* tab = (const LAS int*)(F.lds + MOE_TAB); phase_moe_fixup(F, tab[16]); }
            PH_END
        }
    }
#if DBG_CHECKS
    if (hi == NPHASE) { if (started) xcd_barrier(bar); dbg_report(F); }
#endif
#undef PH_BEGIN
#undef PH_END
#undef WSM
#undef WtokT
#undef WchT
#undef PhT
#undef PaT
#undef WoutT
#undef hbuf
#undef XR
}

#ifndef MK_SPLIT
#define MK_SPLIT 0
#endif
extern "C" void kernel_launch(void* const* d_in, const int* in_sizes, int n_in, void* d_out, int out_size, void* d_ws, size_t ws_size, hipStream_t stream) {
    static int grid = 0;
    if (grid == 0) {
        if (n_in != 30 || out_size != NTOK * DM || ws_size < WS_NEED) { fprintf(stderr, "kernel_launch: unexpected sizes n_in %d out %d ws %zu\n", n_in, out_size, ws_size); grid = -1; return; }
        int dev = 0, cus = 0, per_cu = 0;
        if (hipGetDevice(&dev) != hipSuccess || hipDeviceGetAttribute(&cus, hipDeviceAttributeMultiprocessorCount, dev) != hipSuccess) { grid = -1; return; }
        if (hipFuncSetAttribute((const void*)mk_fwd, hipFuncAttributeMaxDynamicSharedMemorySize, LDS_BYTES) != hipSuccess) { fprintf(stderr, "kernel_launch: hipFuncSetAttribute failed\n"); grid = -1; return; }
        if (hipOccupancyMaxActiveBlocksPerMultiprocessor(&per_cu, (const void*)mk_fwd, NTHR, LDS_BYTES) != hipSuccess || per_cu < 1) { fprintf(stderr, "kernel_launch: occupancy query says %d\n", per_cu); }
        (void)hipGetLastError();
        grid = cus;
    }
    if (grid < 0) return;
    (void)hipMemsetAsync((char*)d_ws + WS_CTL, 0, CTL_ZERO_BYTES, stream);
    Args a{};
    for (int i = 0; i < 30; ++i) a.in[i] = (const float*)d_in[i];
    a.out = (float*)d_out; a.ws = (uchar*)d_ws;
#if MK_SPLIT
    int li = 0;
    for (int p = 0; p < NPHASE; ++p) { a.ph_lo = p; a.ph_hi = p + 1; a.li = 0; a.use_bar = 0; (void)li;
        hipLaunchKernelGGL(mk_fwd, dim3(grid), dim3(NTHR), LDS_BYTES, stream, a); }
#else
    a.ph_lo = 0; a.ph_hi = NPHASE; a.li = 0; a.use_bar = 1;
    hipLaunchKernelGGL(mk_fwd, dim3(grid), dim3(NTHR), LDS_BYTES, stream, a);
#endif
}
```

```cpp
#define DEF_WGM 4
#define TOK_WGM 4
#define CH_WGM 4
#define UP_WGM 8
#include <hip/hip_runtime.h>
#include <cstdio>
#include <cstdint>

#define GAS __attribute__((address_space(1)))
#define LAS __attribute__((address_space(3)))
typedef unsigned short bf16_t;
typedef unsigned char uchar;
typedef short bf16x8 __attribute__((ext_vector_type(8)));
typedef short bf16x4 __attribute__((ext_vector_type(4)));
typedef float f32x2 __attribute__((ext_vector_type(2)));
typedef float f32x4 __attribute__((ext_vector_type(4)));
typedef float f32x16 __attribute__((ext_vector_type(16)));
typedef unsigned u32x4 __attribute__((ext_vector_type(4)));
typedef unsigned u32x2 __attribute__((ext_vector_type(2)));

#if defined(__HIP_DEVICE_COMPILE__)
#define ASSUME_GLOBAL(p) __builtin_assume(!__builtin_amdgcn_is_shared((const __attribute__((address_space(0))) void*)(p)) && !__builtin_amdgcn_is_private((const __attribute__((address_space(0))) void*)(p)))
#else
#define ASSUME_GLOBAL(p) ((void)0)
#endif
#ifndef DBG_CHECKS
#define DBG_CHECKS 0
#endif

constexpr int NB = 8, SEQ = 4096, DM = 1024, NTOK = NB * SEQ;
constexpr int HW = 512, INW = 5120, NHEAD = 4, HD = 64, DV = 128;
constexpr int DFF = 2752, FFP = 2816, NEXP = 8;
constexpr int FEMB = 33, FHID = 64;
constexpr int XR_LD = 2048;
constexpr int NPANEL_MAX = 264, PSLOTS = NPANEL_MAX * 256;
constexpr float RMS_EPS = 1e-6f;
constexpr int NWAVES = 8, NTHR = 512;
constexpr int FIMG_LEN = 8200, FIMG_BYTES = 4 * FIMG_LEN * 2;
constexpr int GIMG_LEN = 8320;

constexpr size_t MiB = 1u << 20, KiB = 1u << 10;
constexpr size_t WS_CTL = 0, CTL_ZERO_BYTES = 256 * KiB;
constexpr size_t WS_COUNTS = 512 * KiB;
constexpr size_t WS_ROPE = 1 * MiB;
constexpr size_t WS_HDN = 2 * MiB;
constexpr size_t WS_TOPI = 4 * MiB, WS_TOPW = WS_TOPI + 256 * KiB, WS_SLOT = WS_TOPW + 256 * KiB, WS_TOKOF = WS_SLOT + 256 * KiB;
constexpr size_t WS_WSMALL = 6 * MiB, WSMALL_STRIDE = 14 * MiB;
constexpr size_t OFF_WTOK = 0, OFF_WCH = 6 * MiB, OFF_PH = 10 * MiB, OFF_PA = 11 * MiB, OFF_WOUT = 12 * MiB;
constexpr size_t WS_WGU = 34 * MiB, WS_WD = 45 * MiB;
constexpr size_t WS_H = 51 * MiB;
constexpr size_t WS_YCAT = 51 * MiB, WS_YT = 452 * MiB;
constexpr size_t WS_QK = 115 * MiB;
constexpr size_t WS_GATES = 179 * MiB;
constexpr size_t WS_CHT = 307 * MiB;
constexpr size_t WS_MERGED = 307 * MiB;
constexpr size_t WS_FIMG = 435 * MiB;
constexpr size_t WS_ACT_DENSE = 115 * MiB;
constexpr size_t WS_MOE_WGU = 51 * MiB, WS_MOE_WD = 139 * MiB;
constexpr size_t WS_XP = 183 * MiB;
constexpr size_t WS_ACT_MOE = 315 * MiB;
constexpr size_t WS_H2_MOE = 251 * MiB;
constexpr size_t WS_SH = 5 * MiB + 512 * KiB;
constexpr size_t WS_SW = 5 * MiB + 640 * KiB;
constexpr size_t WS_I8W = 484 * MiB;
constexpr int SW_LAYER = 5120, SW_DENSE = 2 * SW_LAYER;
constexpr int P8 = 1152;
constexpr size_t I8W_LAYER = 6 * MiB, I8W_CH = 3 * MiB + 512 * KiB, I8W_DENSE = 2 * I8W_LAYER;
static_assert((size_t)3072 * P8 <= I8W_CH && I8W_CH + (size_t)2048 * P8 <= I8W_LAYER && WS_I8W + I8W_DENSE + (size_t)5632 * P8 <= 512 * MiB && WS_SW + (size_t)(SW_DENSE + 5632) * 4 <= 6 * MiB, "int8 weights / scales");
constexpr size_t WS_NEED = 512 * MiB;
static_assert(WS_FIMG + (size_t)2 * 512 * GIMG_LEN * 2 <= 512 * MiB, "fimg");
static_assert(WS_ACT_MOE + (size_t)136 * 256 * FFP * 2 <= 512 * MiB, "act moe");
static_assert(WS_MOE_WD + (size_t)8 * 1024 * FFP * 2 <= WS_XP, "moe wd");

constexpr int CW_DBG = 64;
constexpr int CW_BAR = 4096;

constexpr int LDS_BYTES = 163840;
constexpr int LDS_MISC = 160 * 1024 - 256;

__device__ __forceinline__ unsigned f2bf(float f) { unsigned u = __builtin_bit_cast(unsigned, f); return (u + 0x7fffu + ((u >> 16) & 1u)) >> 16; }
typedef __bf16 bf16x2v __attribute__((ext_vector_type(2)));
__device__ __forceinline__ unsigned pk2(float lo, float hi) { const f32x2 v = {lo, hi}; return __builtin_bit_cast(unsigned, __builtin_convertvector(v, bf16x2v)); }
__device__ __forceinline__ float bf2f(unsigned short b) { return __builtin_bit_cast(float, ((unsigned)b) << 16); }
__device__ __forceinline__ float bflo(unsigned w) { return __builtin_bit_cast(float, w << 16); }
__device__ __forceinline__ float bfhi(unsigned w) { return __builtin_bit_cast(float, w & 0xffff0000u); }
template <int M> __device__ __forceinline__ float xor_swz(float v) { return __builtin_bit_cast(float, __builtin_amdgcn_ds_swizzle(__builtin_bit_cast(int, v), (M << 10) | 0x1f)); }
__device__ __forceinline__ float xor32(float v) { const unsigned u = __builtin_bit_cast(unsigned, v);
    const auto r = __builtin_amdgcn_permlane32_swap(u, u, false, false);
    return __builtin_bit_cast(float, r[0] ^ r[1] ^ u); }
__device__ __forceinline__ float wave_sum(float v) {
    v += xor_swz<1>(v); v += xor_swz<2>(v); v += xor_swz<4>(v); v += xor_swz<8>(v); v += xor_swz<16>(v); v += xor32(v);
    return v;
}
__device__ __forceinline__ f32x4 zerof4() { float z = 0.f; asm volatile("" : "+v"(z)); return (f32x4){z, z, z, z}; }
__device__ __forceinline__ u32x4 zero4() { unsigned z = 0u; asm volatile("" : "+v"(z)); return (u32x4){z, z, z, z}; }
__device__ __forceinline__ float fast_sin(float x) { return __builtin_amdgcn_sinf(x * 0.15915494309f); }
__device__ __forceinline__ float sin_rev(float r) { return __builtin_amdgcn_sinf(__builtin_amdgcn_fractf(r)); }
__device__ __forceinline__ float cos_rev(float r) { return __builtin_amdgcn_cosf(__builtin_amdgcn_fractf(r)); }
__device__ __forceinline__ float fast_exp(float x) { return __builtin_amdgcn_exp2f(x * 1.44269504089f); }
__device__ __forceinline__ float fast_sigmoid(float x) { return __builtin_amdgcn_rcpf(1.0f + __builtin_amdgcn_exp2f(-1.44269504089f * x)); }
#ifndef FP8_MOE
#define FP8_MOE 1
#endif
#ifndef FP8_DENSE
#define FP8_DENSE 1
#endif
typedef int i32x4 __attribute__((ext_vector_type(4)));
typedef int i32x8 __attribute__((ext_vector_type(8)));
constexpr float F8_SH = 16.0f, F8_SWGU = 64.0f, F8_SACT = 8.0f, F8_SWD = 128.0f;
constexpr float F8_UP_INV = 1.0f / (F8_SH * F8_SWGU), F8_DN_INV = 1.0f / (F8_SACT * F8_SWD);
__device__ __forceinline__ unsigned pk4_f8(float a, float b, float c, float d) { const int w = __builtin_amdgcn_cvt_pk_fp8_f32(a, b, 0, false); return (unsigned)__builtin_amdgcn_cvt_pk_fp8_f32(c, d, w, true); }
__device__ __forceinline__ float clamp_f8(float x) { return __builtin_amdgcn_fmed3f(x, -448.0f, 448.0f); }
__device__ __forceinline__ void mfma_f8(f32x4& c, const i32x8 a, const i32x8 b) { asm volatile("v_mfma_f32_16x16x128_f8f6f4 %0, %1, %2, %0" : "+v"(c) : "v"(a), "v"(b)); }
#define F8_ACC_SETTLE() asm volatile("s_nop 15\n\ts_nop 15" ::: "memory")
#ifndef I8_INPROJ
#define I8_INPROJ 1
#endif
#ifndef I8_DENSE_UP
#define I8_DENSE_UP 1
#endif
__device__ __forceinline__ float wave_max(float v) {
    v = fmaxf(v, xor_swz<1>(v)); v = fmaxf(v, xor_swz<2>(v)); v = fmaxf(v, xor_swz<4>(v)); v = fmaxf(v, xor_swz<8>(v)); v = fmaxf(v, xor_swz<16>(v)); v = fmaxf(v, xor32(v));
    return v;
}
__device__ __forceinline__ unsigned pk4_i8(float a, float b, float c, float d) {
    const int ia = (int)__builtin_rintf(a), ib = (int)__builtin_rintf(b), ic = (int)__builtin_rintf(c), id = (int)__builtin_rintf(d);
    return ((unsigned)ia & 255u) | (((unsigned)ib & 255u) << 8) | (((unsigned)ic & 255u) << 16) | ((unsigned)id << 24);
}
template <bool F8> struct OutT { typedef bf16_t t; };
template <> struct OutT<true> { typedef uchar t; };

#define XB_TMO      128
#define XB_XCNT(j)  (256  + 64 * (j))
#define XB_XSUB(j)  (1280 + 64 * (j))
#define XB_XGEN(j)  (2304 + 64 * (j))
#define XB_TOP      3328
#define XB_TOPGEN   3392
#define XCD_BAR_WORDS 3456
#define XB_SPIN_CAP (1u << 18)

__device__ __forceinline__ unsigned xb_ld(unsigned* p)              { return __hip_atomic_load(p, __ATOMIC_RELAXED, __HIP_MEMORY_SCOPE_AGENT); }
__device__ __forceinline__ unsigned xb_add(unsigned* p, unsigned v) { return __hip_atomic_fetch_add(p, v, __ATOMIC_RELAXED, __HIP_MEMORY_SCOPE_AGENT); }
__device__ __forceinline__ unsigned xb_xcc_id() { return (unsigned)__builtin_amdgcn_s_getreg((3 << 11) | 20) & 0xFu; }
#define XB_SPIN(cond, bar) do { unsigned _sp = 0; while (cond) { __builtin_amdgcn_s_sleep(1); \
    if ((++_sp & 255u) == 0u) { if (xb_ld(&(bar)[XB_TMO])) break; if (_sp > XB_SPIN_CAP) { atomicAdd(&(bar)[XB_TMO], 1u); break; } } } } while (0)

struct XcdBarrier {
    unsigned* bar; unsigned x;
    volatile LAS unsigned* st;
};

__device__ __forceinline__ XcdBarrier xcd_barrier_post(unsigned* bar, volatile LAS unsigned* st) {
    XcdBarrier b; b.bar = bar; b.x = xb_xcc_id(); b.st = st;
    if (threadIdx.x == 0) (void)xb_add(&bar[XB_XCNT(b.x)], 1u);
    return b;
}
__device__ __forceinline__ void xcd_barrier_complete(unsigned* bar, unsigned x, unsigned& nloc, unsigned& nx) {
    const unsigned G = gridDim.x * gridDim.y * gridDim.z;
    unsigned sum, cnt, mine, sp = 0u;
    for (;;) {
        sum = 0u; cnt = 0u; mine = 0u;
#pragma unroll
        for (unsigned j = 0; j < 16; ++j) { const unsigned c = xb_ld(&bar[XB_XCNT(j)]); sum += c; cnt += (c > 0u) ? 1u : 0u; mine = (j == x) ? c : mine; }
        if (sum == G) break;
        __builtin_amdgcn_s_sleep(1);
        if ((++sp & 255u) == 0u) { if (xb_ld(&bar[XB_TMO])) break; if (sp > XB_SPIN_CAP) { atomicAdd(&bar[XB_TMO], 1u); break; } }
    }
    nloc = mine > 0u ? mine : 1u; nx = cnt > 0u ? cnt : 1u;
}

__device__ __forceinline__ void xcd_barrier(const XcdBarrier& b) {
    asm volatile("s_waitcnt vmcnt(0)" ::: "memory");
    __syncthreads();
    if (threadIdx.x == 0) {
        unsigned* bar = b.bar;
        __builtin_amdgcn_s_waitcnt(0);
        unsigned nloc = b.st[0], nx = b.st[1];
        if (nloc == 0u) { xcd_barrier_complete(bar, b.x, nloc, nx); b.st[0] = nloc; b.st[1] = nx; }
        const unsigned old = xb_add(&bar[XB_XSUB(b.x)], 1u);
        const unsigned gen = old / nloc;
        if (old + 1u == (gen + 1u) * nloc) {
            __builtin_amdgcn_fence(__ATOMIC_RELEASE, "agent");
            asm volatile("s_waitcnt vmcnt(0)" ::: "memory");
            const unsigned og = xb_add(&bar[XB_TOP], 1u);
            const unsigned tg = og / nx;
            if (og + 1u == (tg + 1u) * nx) xb_add(&bar[XB_TOPGEN], 1u);
            else XB_SPIN(xb_ld(&bar[XB_TOPGEN]) == tg, bar);
            __builtin_amdgcn_fence(__ATOMIC_ACQUIRE, "agent");
            xb_add(&bar[XB_XGEN(b.x)], 1u);
            asm volatile("s_waitcnt vmcnt(0)" ::: "memory");
        } else {
            XB_SPIN(xb_ld(&bar[XB_XGEN(b.x)]) == gen, bar);
            __builtin_amdgcn_fence(__ATOMIC_ACQUIRE, "agent");
            asm volatile("s_waitcnt vmcnt(0)" ::: "memory");
        }
    }
    __syncthreads();
}

#ifndef DEF_WGM
#define DEF_WGM 4
#endif
#ifndef TOK_WGM
#define TOK_WGM 4
#endif
#ifndef CH_WGM
#define CH_WGM 4
#endif
#ifndef UP_WGM
#define UP_WGM 4
#endif
namespace pg8 {
constexpr int BM = 256, BK = 64, HALF = 128, HTB = HALF * BK * 2  , STAGE_BYTES = 8 * HTB, NXCD = 8, WGM = DEF_WGM;
__host__ __device__ __forceinline__ int lds_byte(int r, int c) { const int st = (r >> 4) * 2 + (c >> 5), rr = r & 15, cc = c & 31, ob = rr * 64 + cc * 2; return st * 1024 + (ob ^ (((ob >> 9) & 1) << 5)); }
__host__ __device__ __forceinline__ void stage_rc(int b, int& R, int& C) { const int st = b / 1024, sb = b % 1024, swz = sb ^ (((sb >> 9) & 1) << 5); R = (st >> 1) * 16 + swz / 64; C = (st & 1) * 32 + (swz % 64) / 2; }
__host__ __device__ __forceinline__ int perm32(int rho) { const int n = rho >> 4, i = rho & 15; return 8 * (i >> 2) + 4 * n + (i & 3); }

struct Unit { int pm, pn; long boff; };
struct Gemm { const bf16_t* A; const bf16_t* Bt; int M, N, K; int lda = 0, ldb = 0; };

template <int WG> struct StaticOrderT {
    static constexpr bool GATHER = false;
    int nM, nN, nwg, G, c;
    __device__ void init(int M, int N, int G_, int c_) { nM = M / BM; nN = N / BM; nwg = nM * nN; G = G_; c = c_; }
    __device__ bool next(int i, Unit& u) const {
        const int L = i * G + c; if (L >= nwg) return false;
        int wgid = L; { const int q = nwg / NXCD, r = nwg % NXCD, xcd = wgid % NXCD, off = wgid / NXCD; wgid = (xcd < r ? xcd * (q + 1) : r * (q + 1) + (xcd - r) * q) + off; }
        const int nig = WG * nN, gid = wgid / nig, fm = gid * WG, gsz = (nM - fm) < WG ? (nM - fm) : WG;
        u.pm = fm + ((wgid % nig) % gsz); u.pn = (wgid % nig) / gsz; u.boff = 0; return true;
    }
};
typedef StaticOrderT<WGM> StaticOrder;
struct MoeOrder : StaticOrderT<UP_WGM> {
    int p0; const LAS int* pexp; long estride;
    __device__ bool next(int i, Unit& u) const { if (!StaticOrderT<UP_WGM>::next(i, u)) return false; u.pm += p0; u.boff = (long)pexp[u.pm] * estride; return true; }
};

struct MoeGatherOrder : MoeOrder {
    static constexpr bool GATHER = true;
    const int* tokof;
    const LAS int* tokl;
    __device__ __forceinline__ unsigned rowtok(int li, int r) const { return (unsigned)tokl[li * 256 + r]; }
    __device__ __forceinline__ void fill_tokl(LAS int* dst, int tid) { Unit u; for (int i = 0; next(i, u); ++i) if (tid < 256) { const int t = ((const GAS int*)tokof)[u.pm * BM + tid]; dst[i * 256 + tid] = t < 0 ? 0 : t; }
        tokl = dst; __syncthreads(); }
};

template <class Epi, class Sched>
__device__ __forceinline__ void gemm_phase(LAS unsigned char* lds, const Gemm g, const Sched& S, const Epi& E, const int tid) {
    const int wid = __builtin_amdgcn_readfirstlane(tid >> 6), lane = tid & 63, wr = wid >> 2, wc = wid & 3, fr = lane & 15, fq = lane >> 4;
    const int K = g.K, nt = K / BK, lda = g.lda ? g.lda : 2 * K, ldb = g.ldb ? g.ldb : 2 * K;
    unsigned voffA[2], voffB[2];
#pragma unroll
    for (int i = 0; i < 2; ++i) { int R, C; stage_rc(tid * 16 + i * 8192, R, C); const int Rb = Epi::PERM ? ((R & ~31) + perm32(R & 31)) : R;
        voffA[i] = (unsigned)(R * lda + C * 2); voffB[i] = (unsigned)(Rb * ldb + C * 2); }
    const size_t kstep = (size_t)(BK * 2);
    const size_t hstepA = (size_t)HALF * lda, hstepB = (size_t)HALF * ldb;
    const size_t tstepA = 2 * hstepA, tstepB = 2 * hstepB;
    const unsigned ldsw = (unsigned)wid * 1024u;
    const int aoff = lds_byte(wr * 64 + fr, fq * 8), boff = lds_byte(wc * 32 + fr, fq * 8);
#define PG8_SA(b, h) (((b) * 2 + (h)) * HTB)
#define PG8_SB(b, h) ((4 + (b) * 2 + (h)) * HTB)
#define PG8_STAGE(bufoff, gbase, voff) do { const char* gb_ = (const char*)(gbase); asm volatile("" : "+s"(gb_));     \
        _Pragma("unroll") for (int _i = 0; _i < 2; ++_i) { unsigned vo_ = (voff)[_i]; asm volatile("" : "+v"(vo_)); \
        __builtin_amdgcn_global_load_lds((const unsigned*)(gb_ + vo_), (LAS unsigned*)(lds + (bufoff) + ldsw + _i * 8192), 16, 0, 0); } } while (0)
#define PG8_LDA(dst, b, h) do { _Pragma("unroll") for (int m = 0; m < 4; ++m) _Pragma("unroll") for (int k = 0; k < 2; ++k) dst[m][k] = *(const LAS bf16x8*)(lds + PG8_SA(b, h) + aoff + m * 2048 + k * 1024); } while (0)
#define PG8_LDB(dst, b, h) do { _Pragma("unroll") for (int n = 0; n < 2; ++n) _Pragma("unroll") for (int k = 0; k < 2; ++k) dst[n][k] = *(const LAS bf16x8*)(lds + PG8_SB(b, h) + boff + n * 2048 + k * 1024); } while (0)
#define PG8_CAT(x_, y_) __builtin_shufflevector(__builtin_bit_cast(i32x4, x_), __builtin_bit_cast(i32x4, y_), 0, 1, 2, 3, 4, 5, 6, 7)
#define PG8_MMA(ai, bj, At, Bt) do { __builtin_amdgcn_s_setprio(1); _Pragma("unroll") for (int m = 0; m < 4; ++m) _Pragma("unroll") for (int n = 0; n < 2; ++n) { \
        if constexpr (Epi::FP8) mfma_f8(acc[ai][bj][m][n], PG8_CAT(Bt[n][0], Bt[n][1]), PG8_CAT(At[m][0], At[m][1])); \
        else if constexpr (Epi::I8) { _Pragma("unroll") for (int k = 0; k < 2; ++k) acc[ai][bj][m][n] = __builtin_bit_cast(f32x4, __builtin_amdgcn_mfma_i32_16x16x64_i8(__builtin_bit_cast(i32x4, Bt[n][k]), __builtin_bit_cast(i32x4, At[m][k]), __builtin_bit_cast(i32x4, acc[ai][bj][m][n]), 0, 0, 0)); } \
        else { _Pragma("unroll") for (int k = 0; k < 2; ++k) acc[ai][bj][m][n] = __builtin_amdgcn_mfma_f32_16x16x32_bf16(Bt[n][k], At[m][k], acc[ai][bj][m][n], 0, 0, 0); } } \
        __builtin_amdgcn_s_setprio(0); } while (0)
#define PG8_WAIT_V(n) asm volatile("s_waitcnt vmcnt(" #n ")" ::: "memory")
#define PG8_WAIT_L(n) asm volatile("s_waitcnt lgkmcnt(" #n ")" ::: "memory")
#define PG8_BAR __builtin_amdgcn_s_barrier()
#define PG8_SCHED __builtin_amdgcn_sched_barrier(0)
#define PG8_KBODY \
            const bool last = (t == nt - 2); \
            const char* a1 = cA + (size_t)(t + 1) * kstep; \
            const char* a2 = last ? nA : cA + (size_t)(t + 2) * kstep; const char* b2 = last ? nB : cB + (size_t)(t + 2) * kstep; \
            const char* a3 = a2 + kstep; const char* b3 = b2 + kstep; const size_t k2b = last ? (size_t)0 : (size_t)(t + 2) * kstep; \
            PG8_LDB(B0, 0, 0); PG8_SCHED; PG8_LDA(At, 0, 0); PG8_STAGE_A(PG8_SA(1, 1), a1, 1, false, (size_t)(t + 1) * kstep); \
            PG8_WAIT_L(8); PG8_BAR; PG8_WAIT_L(0); PG8_MMA(0, 0, At, B0); PG8_BAR; PG8_SCHED; \
            PG8_LDB(B1, 0, 1); PG8_STAGE(PG8_SB(0, 0), b2, voffB); \
            PG8_BAR; PG8_WAIT_L(0); PG8_MMA(0, 1, At, B1); PG8_BAR; \
            PG8_LDA(At, 0, 1); PG8_STAGE_A(PG8_SA(0, 0), a2, 0, last, k2b); \
            PG8_BAR; PG8_WAIT_L(0); PG8_MMA(1, 0, At, B0); PG8_BAR; PG8_SCHED; \
            PG8_STAGE(PG8_SB(0, 1), b2 + hstepB, voffB); \
            PG8_WAIT_V(6); PG8_BAR; PG8_MMA(1, 1, At, B1); PG8_BAR; \
            PG8_LDB(B0, 1, 0); PG8_SCHED; PG8_LDA(At, 1, 0); PG8_STAGE_A(PG8_SA(0, 1), a2, 1, last, k2b); \
            PG8_WAIT_L(8); PG8_BAR; PG8_WAIT_L(0); PG8_MMA(0, 0, At, B0); PG8_BAR; PG8_SCHED; \
            PG8_LDB(B1, 1, 1); PG8_STAGE(PG8_SB(1, 0), b3, voffB); \
            PG8_BAR; PG8_WAIT_L(0); PG8_MMA(0, 1, At, B1); PG8_BAR; \
            PG8_LDA(At, 1, 1); PG8_STAGE_A(PG8_SA(1, 0), a3, 0, last, k2b + kstep); \
            PG8_BAR; PG8_WAIT_L(0); PG8_MMA(1, 0, At, B0); PG8_BAR; PG8_SCHED; \
            PG8_STAGE(PG8_SB(1, 1), b3 + hstepB, voffB); \
            PG8_WAIT_V(6); PG8_BAR; PG8_MMA(1, 1, At, B1); PG8_BAR;
    constexpr bool GATHER = Sched::GATHER;
    unsigned vgC[2][2], vgN[2][2];
#define PG8_GOFFS(dst, unit_, li_) do { if constexpr (GATHER) { _Pragma("unroll") for (int h_ = 0; h_ < 2; ++h_) _Pragma("unroll") for (int i_ = 0; i_ < 2; ++i_) { int R_, C_; stage_rc(tid * 16 + i_ * 8192, R_, C_); \
        dst[h_][i_] = S.rowtok(li_, h_ * HALF + R_) * (unsigned)lda + (unsigned)C_ * 2u; } } } while (0)
#define PG8_STAGE_A(bufoff, ptr_, h_, use_next_, kbyte_) do { if constexpr (GATHER) { const char* ga_ = (const char*)g.A + (kbyte_); asm volatile("" : "+s"(ga_)); _Pragma("unroll") for (int _i = 0; _i < 2; ++_i) { \
        unsigned vo_ = (use_next_) ? vgN[h_][_i] : vgC[h_][_i]; asm volatile("" : "+v"(vo_)); \
        __builtin_amdgcn_global_load_lds((const unsigned*)(ga_ + vo_), (LAS unsigned*)(lds + (bufoff) + ldsw + _i * 8192), 16, 0, 0); } } \
        else { PG8_STAGE(bufoff, (ptr_) + (h_) * hstepA, voffA); } } while (0)
    Unit cur, nxt; int ui = 0;
    if (!S.next(0, cur)) return;
    f32x4 acc[2][2][4][2];
#pragma unroll
    for (int a = 0; a < 2; ++a)
#pragma unroll
        for (int b = 0; b < 2; ++b)
#pragma unroll
            for (int m = 0; m < 4; ++m)
#pragma unroll
                for (int n = 0; n < 2; ++n) acc[a][b][m][n] = zerof4();
    bf16x8 At[4][2], B0[2][2], B1[2][2];
    const char* cA = (const char*)g.A + (size_t)cur.pm * tstepA; const char* cB = (const char*)g.Bt + cur.boff + (size_t)cur.pn * tstepB;
    PG8_GOFFS(vgC, cur, 0);
    PG8_STAGE(PG8_SB(0, 0), cB, voffB); PG8_STAGE_A(PG8_SA(0, 0), cA, 0, false, (size_t)0); PG8_STAGE(PG8_SB(0, 1), cB + hstepB, voffB); PG8_STAGE_A(PG8_SA(0, 1), cA, 1, false, (size_t)0);
    if (wr == 1) PG8_BAR;
    PG8_WAIT_V(4); PG8_BAR;
    PG8_STAGE(PG8_SB(1, 0), cB + kstep, voffB); PG8_STAGE_A(PG8_SA(1, 0), cA + kstep, 0, false, kstep); PG8_STAGE(PG8_SB(1, 1), cB + hstepB + kstep, voffB);
    PG8_WAIT_V(6); PG8_BAR;
    for (;;) {
        const bool has_next = S.next(ui + 1, nxt);
        if (has_next) PG8_GOFFS(vgN, nxt, ui + 1); else { if constexpr (GATHER) { _Pragma("unroll") for (int h_ = 0; h_ < 2; ++h_) _Pragma("unroll") for (int i_ = 0; i_ < 2; ++i_) vgN[h_][i_] = vgC[h_][i_]; } }
        const char* nA = has_next ? (const char*)g.A + (size_t)nxt.pm * tstepA : cA; const char* nB = has_next ? (const char*)g.Bt + nxt.boff + (size_t)nxt.pn * tstepB : cB;
        if constexpr (Epi::MID_T > 0) {
#pragma clang loop unroll(disable)
            for (int part = 0; part < 2; ++part) { const int t1 = part ? nt : Epi::MID_T;
#pragma clang loop unroll(disable)
                for (int t = part ? Epi::MID_T : 0; t < t1; t += 2) { PG8_KBODY }
                if (part == 0) E.mid(acc, cur, wr, wc, fr, fq); }
        } else if constexpr (Epi::FP8 || Epi::I8) {
#pragma clang loop unroll(disable)
            for (int t = 0; t < nt; t += 2) { PG8_KBODY }
        } else {
            for (int t = 0; t < nt; t += 2) { PG8_KBODY }
        }
        if constexpr (Epi::FP8) { F8_ACC_SETTLE();
#pragma unroll
            for (int a = 0; a < 2; ++a)
#pragma unroll
                for (int b = 0; b < 2; ++b)
#pragma unroll
                    for (int m = 0; m < 4; ++m)
#pragma unroll
                        for (int n = 0; n < 2; ++n) asm volatile("" : "+v"(acc[a][b][m][n])); }
        E(acc, cur, wr, wc, fr, fq);
        if (!has_next) break;
#pragma unroll
        for (int a = 0; a < 2; ++a)
#pragma unroll
            for (int b = 0; b < 2; ++b)
#pragma unroll
                for (int m = 0; m < 4; ++m)
#pragma unroll
                    for (int n = 0; n < 2; ++n) acc[a][b][m][n] = zerof4();
        cur = nxt; cA = nA; cB = nB; ++ui;
        if constexpr (GATHER) { _Pragma("unroll") for (int h_ = 0; h_ < 2; ++h_) _Pragma("unroll") for (int i_ = 0; i_ < 2; ++i_) vgC[h_][i_] = vgN[h_][i_]; }
    }
    PG8_WAIT_V(0);
    if (wr == 0) PG8_BAR;
    PG8_BAR;
#undef PG8_KBODY
#undef PG8_GOFFS
#undef PG8_STAGE_A
#undef PG8_SA
#undef PG8_SB
#undef PG8_STAGE
#undef PG8_LDA
#undef PG8_LDB
#undef PG8_MMA
#undef PG8_CAT
#undef PG8_WAIT_V
#undef PG8_WAIT_L
#undef PG8_BAR
#undef PG8_SCHED
}

typedef f32x4 Acc[2][2][4][2];

template <int IN> __device__ __forceinline__ f32x4 accv(const f32x4 a, const float rsv, const f32x4 c) {
    if constexpr (IN == 2) { const i32x4 q = __builtin_bit_cast(i32x4, a); return (f32x4){(float)q[0] * (rsv * c[0]), (float)q[1] * (rsv * c[1]), (float)q[2] * (rsv * c[2]), (float)q[3] * (rsv * c[3])}; }
    else return a;
}
template <int IN> __device__ __forceinline__ void col_scales(const float* cs, const Unit& u, int wc, int fq, f32x4 (&c)[2][2]) {
    if constexpr (IN == 2) { const GAS f32x4* p = (const GAS f32x4*)(cs + u.pn * BM + wc * 32 + 8 * fq);
        c[0][0] = p[0]; c[0][1] = p[1]; c[1][0] = p[HALF / 4]; c[1][1] = p[HALF / 4 + 1]; }
    else { c[0][0] = c[0][1] = c[1][0] = c[1][1] = (f32x4){1.f, 1.f, 1.f, 1.f}; }
}
template <int IN> struct EpiBf16 {
    static constexpr bool PERM = true; static constexpr int MID_T = 0; static constexpr bool FP8 = IN == 1, I8 = IN == 2;
    bf16_t* O; int ldc; int prow0; float sc; const float* rs; const float* cs;
    __device__ __forceinline__ void operator()(const Acc& acc, const Unit& u, int wr, int wc, int fr, int fq) const {
        const int row0 = (u.pm - prow0) * BM + wr * 64 + fr, col0 = u.pn * BM + wc * 32 + 8 * fq;
        f32x4 cv[2][2]; col_scales<IN>(cs, u, wc, fq, cv);
        float rsa[2][4];
#pragma unroll
        for (int ai = 0; ai < 2; ++ai)
#pragma unroll
            for (int m = 0; m < 4; ++m) { rsa[ai][m] = 1.f; if constexpr (I8) rsa[ai][m] = ((const GAS float*)rs)[u.pm * BM + wr * 64 + fr + ai * HALF + m * 16]; }
        if constexpr (I8) __builtin_amdgcn_sched_barrier(0);
#pragma unroll
        for (int ai = 0; ai < 2; ++ai)
#pragma unroll
            for (int m = 0; m < 4; ++m) { bf16_t* rowp = O + (size_t)(row0 + ai * HALF + m * 16) * ldc + col0;
                const float rsv = rsa[ai][m];
#pragma unroll
                for (int bj = 0; bj < 2; ++bj) { f32x4 v0 = accv<IN>(acc[ai][bj][m][0], rsv, cv[bj][0]), v1 = accv<IN>(acc[ai][bj][m][1], rsv, cv[bj][1]);
                    if constexpr (FP8) { v0 *= sc; v1 *= sc; }
                    u32x4 w; w.x = pk2(v0[0], v0[1]); w.y = pk2(v0[2], v0[3]); w.z = pk2(v1[0], v1[1]); w.w = pk2(v1[2], v1[3]);
                    *(GAS u32x4*)(rowp + bj * HALF) = w; } }
    }
};
template <int IN> struct EpiTok {
    static constexpr bool PERM = true; static constexpr int MID_T = 0; static constexpr bool FP8 = false, I8 = IN == 2;
    bf16_t* qk; uchar* gates; const float* qn; const float* kn; const bf16_t* ct; const bf16_t* st; const float* rs; const float* cs;
    __device__ __forceinline__ void operator()(const Acc& acc, const Unit& u, int wr, int wc, int fr_in, int fq_in) const {
        int fr = fr_in, fq = fq_in; asm volatile("" : "+v"(fr), "+v"(fq));
        const int row0 = u.pm * BM + wr * 64 + fr;
        f32x4 cv[2][2]; col_scales<IN>(cs, u, wc, fq, cv);
        if (u.pn < 4) {
            const int G = 4 * u.pn + wc; const bool isq = G < 8; const GAS float* gn = (const GAS float*)(isq ? qn : kn);
            const float post = isq ? (0.125f * 1.44269504089f) : 1.0f;
            const int i0 = 8 * fq;
            unsigned gpa[4], gpb[4];
            { const f32x4 ga0 = *(const GAS f32x4*)(gn + i0), ga1 = *(const GAS f32x4*)(gn + i0 + 4), gb0 = *(const GAS f32x4*)(gn + 32 + i0), gb1 = *(const GAS f32x4*)(gn + 36 + i0);
              gpa[0] = pk2(ga0[0], ga0[1]); gpa[1] = pk2(ga0[2], ga0[3]); gpa[2] = pk2(ga1[0], ga1[1]); gpa[3] = pk2(ga1[2], ga1[3]);
              gpb[0] = pk2(gb0[0], gb0[1]); gpb[1] = pk2(gb0[2], gb0[3]); gpb[2] = pk2(gb1[0], gb1[1]); gpb[3] = pk2(gb1[2], gb1[3]);
#pragma unroll
              for (int e = 0; e < 4; ++e) asm volatile("" : "+v"(gpa[e]), "+v"(gpb[e])); }
#pragma unroll
            for (int ai = 0; ai < 2; ++ai)
#pragma unroll
                for (int mb = 0; mb < 4; mb += 2) {
                    u32x4 cc[2], sn[2]; float rsb[2];
#pragma unroll
                    for (int mm = 0; mm < 2; ++mm) { const int row = row0 + ai * HALF + (mb + mm) * 16, l = row & (SEQ - 1);
                        cc[mm] = *(const GAS u32x4*)(ct + l * 32 + i0); sn[mm] = *(const GAS u32x4*)(st + l * 32 + i0);
                        rsb[mm] = 1.f; if constexpr (I8) rsb[mm] = ((const GAS float*)rs)[row]; }
                    __builtin_amdgcn_sched_barrier(0);
#pragma unroll
                    for (int mm = 0; mm < 2; ++mm) { const int m = mb + mm, row = row0 + ai * HALF + m * 16;
                        f32x4 xa[2][2];
#pragma unroll
                        for (int bj = 0; bj < 2; ++bj)
#pragma unroll
                            for (int n = 0; n < 2; ++n) xa[bj][n] = accv<IN>(acc[ai][bj][m][n], rsb[mm], cv[bj][n]);
                        float ss = 0.f;
#pragma unroll
                        for (int bj = 0; bj < 2; ++bj)
#pragma unroll
                            for (int n = 0; n < 2; ++n) { const f32x4 x = xa[bj][n]; ss += (x[0] * x[0] + x[1] * x[1]) + (x[2] * x[2] + x[3] * x[3]); }
                        ss += xor_swz<16>(ss); ss += xor32(ss);
                        const float r = __builtin_amdgcn_rsqf(ss * (1.0f / 64.0f) + RMS_EPS) * post;
                        float oa[8], ob[8];
#pragma unroll
                        for (int e = 0; e < 8; ++e) { const float a = xa[0][e >> 2][e & 3] * ((e & 1) ? bfhi(gpa[e >> 1]) : bflo(gpa[e >> 1])), b = xa[1][e >> 2][e & 3] * ((e & 1) ? bfhi(gpb[e >> 1]) : bflo(gpb[e >> 1]));
                            const float c = (e & 1) ? bfhi(cc[mm][e >> 1]) : bflo(cc[mm][e >> 1]), sv = (e & 1) ? bfhi(sn[mm][e >> 1]) : bflo(sn[mm][e >> 1]);
                            oa[e] = (a * c - b * sv) * r; ob[e] = (a * sv + b * c) * r; }
                        GAS bf16_t* rowp = (GAS bf16_t*)qk + (size_t)row * 1024 + 64 * G + i0;
                        *(GAS u32x4*)(rowp) = (u32x4){pk2(oa[0], oa[1]), pk2(oa[2], oa[3]), pk2(oa[4], oa[5]), pk2(oa[6], oa[7])};
                        *(GAS u32x4*)(rowp + 32) = (u32x4){pk2(ob[0], ob[1]), pk2(ob[2], ob[3]), pk2(ob[4], ob[5]), pk2(ob[6], ob[7])}; }
                    __builtin_amdgcn_sched_barrier(0);
                }
        } else {
            const int col0 = (u.pn - 4) * HALF + wc * 32 + 8 * fq;
            float rsa[2][4];
#pragma unroll
            for (int ai = 0; ai < 2; ++ai)
#pragma unroll
                for (int m = 0; m < 4; ++m) { rsa[ai][m] = 1.f; if constexpr (I8) rsa[ai][m] = ((const GAS float*)rs)[row0 + ai * HALF + m * 16]; }
            if constexpr (I8) __builtin_amdgcn_sched_barrier(0);
#pragma unroll
            for (int ai = 0; ai < 2; ++ai)
#pragma unroll
                for (int m = 0; m < 4; ++m) {
                    const float rsv = rsa[ai][m];
                    f32x4 xa[2][2];
#pragma unroll
                    for (int bj = 0; bj < 2; ++bj)
#pragma unroll
                        for (int n = 0; n < 2; ++n) xa[bj][n] = accv<IN>(acc[ai][bj][m][n], rsv, cv[bj][n]);
                    unsigned qh[8], qa[8];
#pragma unroll
                    for (int e = 0; e < 8; ++e) { qh[e] = (unsigned)(fast_sigmoid(xa[0][e >> 2][e & 3]) * 255.0f + 0.5f); qa[e] = (unsigned)(fast_sigmoid(xa[1][e >> 2][e & 3]) * 255.0f + 0.5f); }
                    u32x4 w; w.x = qh[0] | (qh[1] << 8) | (qh[2] << 16) | (qh[3] << 24); w.y = qh[4] | (qh[5] << 8) | (qh[6] << 16) | (qh[7] << 24);
                    w.z = qa[0] | (qa[1] << 8) | (qa[2] << 16) | (qa[3] << 24); w.w = qa[4] | (qa[5] << 8) | (qa[6] << 16) | (qa[7] << 24);
                    *(GAS u32x4*)((GAS uchar*)gates + (size_t)(row0 + ai * HALF + m * 16) * 2048 + (size_t)col0 * 2) = w; }
        }
    }
};
__device__ __forceinline__ float ub0(unsigned w) { return (float)(w & 0xffu); }
__device__ __forceinline__ float ub1(unsigned w) { return (float)((w >> 8) & 0xffu); }
__device__ __forceinline__ float ub2(unsigned w) { return (float)((w >> 16) & 0xffu); }
__device__ __forceinline__ float ub3(unsigned w) { return (float)(w >> 24); }
struct EpiMergeF {
    static constexpr bool PERM = true; static constexpr int MID_T = 8; static constexpr bool FP8 = false, I8 = false;
    bf16_t* merged; const uchar* gates;
    __device__ __forceinline__ void mid(Acc& acc, const Unit& u, int wr, int wc, int fr_in, int fq_in) const {
        int fr = fr_in, fq = fq_in; asm volatile("" : "+v"(fr), "+v"(fq));
        const int row0 = u.pm * BM + wr * 64 + fr, col0 = u.pn * BM + wc * 32 + 8 * fq;
#pragma unroll
        for (int ai = 0; ai < 2; ++ai)
#pragma unroll
            for (int mp = 0; mp < 2; ++mp) {
                u32x4 gw[2][2];
#pragma unroll
                for (int mm = 0; mm < 2; ++mm)
#pragma unroll
                    for (int bj = 0; bj < 2; ++bj) gw[mm][bj] = *(const GAS u32x4*)((const GAS uchar*)gates + (size_t)(row0 + ai * HALF + (2 * mp + mm) * 16) * 2048 + (size_t)(col0 + bj * HALF) * 2);
                __builtin_amdgcn_sched_barrier(0);
#pragma unroll
                for (int mm = 0; mm < 2; ++mm)
#pragma unroll
                    for (int bj = 0; bj < 2; ++bj) { const int m = 2 * mp + mm; const u32x4 g = gw[mm][bj];
                        acc[ai][bj][m][0][0] *= ub0(g.x) * __builtin_amdgcn_rcpf(fmaxf(ub0(g.z), 1.0f)); acc[ai][bj][m][0][1] *= ub1(g.x) * __builtin_amdgcn_rcpf(fmaxf(ub1(g.z), 1.0f));
                        acc[ai][bj][m][0][2] *= ub2(g.x) * __builtin_amdgcn_rcpf(fmaxf(ub2(g.z), 1.0f)); acc[ai][bj][m][0][3] *= ub3(g.x) * __builtin_amdgcn_rcpf(fmaxf(ub3(g.z), 1.0f));
                        acc[ai][bj][m][1][0] *= ub0(g.y) * __builtin_amdgcn_rcpf(fmaxf(ub0(g.w), 1.0f)); acc[ai][bj][m][1][1] *= ub1(g.y) * __builtin_amdgcn_rcpf(fmaxf(ub1(g.w), 1.0f));
                        acc[ai][bj][m][1][2] *= ub2(g.y) * __builtin_amdgcn_rcpf(fmaxf(ub2(g.w), 1.0f)); acc[ai][bj][m][1][3] *= ub3(g.y) * __builtin_amdgcn_rcpf(fmaxf(ub3(g.w), 1.0f)); }
                __builtin_amdgcn_sched_barrier(0);
            }
    }
    __device__ __forceinline__ void operator()(const Acc& acc, const Unit& u, int wr, int wc, int fr, int fq) const {
        const int row0 = u.pm * BM + wr * 64 + fr, col0 = u.pn * BM + wc * 32 + 8 * fq;
        const float k = 1.0f / 255.0f;
        u32x2 gwv[2][4][2];
#pragma unroll
        for (int ai = 0; ai < 2; ++ai)
#pragma unroll
            for (int m = 0; m < 4; ++m)
#pragma unroll
                for (int bj = 0; bj < 2; ++bj) gwv[ai][m][bj] = *(const GAS u32x2*)((const GAS uchar*)gates + (size_t)(row0 + ai * HALF + m * 16) * 2048 + (size_t)(col0 + bj * HALF) * 2 + 8);
        __builtin_amdgcn_sched_barrier(0);
#pragma unroll
        for (int ai = 0; ai < 2; ++ai)
#pragma unroll
            for (int m = 0; m < 4; ++m) { const size_t row = (size_t)(row0 + ai * HALF + m * 16);
#pragma unroll
                for (int bj = 0; bj < 2; ++bj) { f32x4 v0 = acc[ai][bj][m][0], v1 = acc[ai][bj][m][1];
                    const u32x2 gw = gwv[ai][m][bj];
                    v0[0] *= fmaxf(ub0(gw.x), 1.0f) * k; v0[1] *= fmaxf(ub1(gw.x), 1.0f) * k; v0[2] *= fmaxf(ub2(gw.x), 1.0f) * k; v0[3] *= fmaxf(ub3(gw.x), 1.0f) * k;
                    v1[0] *= fmaxf(ub0(gw.y), 1.0f) * k; v1[1] *= fmaxf(ub1(gw.y), 1.0f) * k; v1[2] *= fmaxf(ub2(gw.y), 1.0f) * k; v1[3] *= fmaxf(ub3(gw.y), 1.0f) * k;
                    u32x4 w; w.x = pk2(v0[0], v0[1]); w.y = pk2(v0[2], v0[3]); w.z = pk2(v1[0], v1[1]); w.w = pk2(v1[2], v1[3]);
                    *(GAS u32x4*)(merged + row * 1024 + col0 + bj * HALF) = w; } }
    }
};
template <bool IN_F32, bool F8 = false> struct EpiRes {
    static constexpr bool PERM = true; static constexpr int MID_T = 0; static constexpr bool FP8 = F8, I8 = false;
    const float* xin; bf16_t* xr; float sc;
    __device__ __forceinline__ void operator()(const Acc& acc, const Unit& u, int wr, int wc, int fr, int fq) const {
        const int row0 = u.pm * BM + wr * 64 + fr, col0 = u.pn * BM + wc * 32 + 8 * fq;
        constexpr int MB = IN_F32 ? 2 : 4;
#pragma unroll
        for (int ai = 0; ai < 2; ++ai)
#pragma unroll
            for (int mb = 0; mb < 4; mb += MB) {
                f32x4 xa[IN_F32 ? MB : 1][2][2]; u32x4 pw[IN_F32 ? 1 : MB][2];
#pragma unroll
                for (int mm = 0; mm < MB; ++mm)
#pragma unroll
                    for (int bj = 0; bj < 2; ++bj) { const size_t row = (size_t)(row0 + ai * HALF + (mb + mm) * 16);
                        if constexpr (IN_F32) { const GAS f32x4* ip = (const GAS f32x4*)(xin + row * 1024 + col0 + bj * HALF); xa[mm][bj][0] = ip[0]; xa[mm][bj][1] = ip[1]; }
                        else pw[mm][bj] = *(const GAS u32x4*)((const GAS bf16_t*)xr + row * XR_LD + col0 + bj * HALF); }
                __builtin_amdgcn_sched_barrier(0);
#pragma unroll
                for (int mm = 0; mm < MB; ++mm)
#pragma unroll
                    for (int bj = 0; bj < 2; ++bj) { const int m = mb + mm; const size_t row = (size_t)(row0 + ai * HALF + m * 16);
                        f32x4 v0 = acc[ai][bj][m][0], v1 = acc[ai][bj][m][1];
                        if constexpr (F8) { v0 *= sc; v1 *= sc; }
                        GAS bf16_t* op = (GAS bf16_t*)xr + row * XR_LD + col0 + bj * HALF;
                        if constexpr (IN_F32) { v0 += xa[mm][bj][0]; v1 += xa[mm][bj][1]; }
                        else { const u32x4 q = pw[mm][bj];
                            v0[0] += bflo(q.x); v0[1] += bfhi(q.x); v0[2] += bflo(q.y); v0[3] += bfhi(q.y);
                            v1[0] += bflo(q.z); v1[1] += bfhi(q.z); v1[2] += bflo(q.w); v1[3] += bfhi(q.w); }
                        *(GAS u32x4*)op = (u32x4){pk2(v0[0], v0[1]), pk2(v0[2], v0[3]), pk2(v1[0], v1[1]), pk2(v1[2], v1[3])}; }
                __builtin_amdgcn_sched_barrier(0);
            }
    }
};
template <int IN, bool OUT8> struct EpiSwiglu {
    static constexpr bool PERM = true; static constexpr int MID_T = 0; static constexpr bool FP8 = IN == 1, I8 = IN == 2;
    bf16_t* act; int prow0; const float* rs; const float* cs;
    __device__ __forceinline__ void operator()(const Acc& acc, const Unit& u, int wr, int wc, int fr, int fq) const {
        const int row0 = (u.pm - prow0) * BM + wr * 64 + fr, col0 = u.pn * HALF + wc * 32 + 8 * fq;
        f32x4 cv[2][2]; col_scales<IN>(cs, u, wc, fq, cv);
        constexpr float kg = FP8 ? F8_UP_INV : 1.0f, ku = kg * (OUT8 ? F8_SACT : 1.0f);
        float rsa[2][4];
#pragma unroll
        for (int ai = 0; ai < 2; ++ai)
#pragma unroll
            for (int m = 0; m < 4; ++m) { rsa[ai][m] = 1.f; if constexpr (I8) rsa[ai][m] = ((const GAS float*)rs)[u.pm * BM + wr * 64 + fr + ai * HALF + m * 16]; }
        if constexpr (I8) __builtin_amdgcn_sched_barrier(0);
#pragma unroll
        for (int ai = 0; ai < 2; ++ai)
#pragma unroll
            for (int m = 0; m < 4; ++m) {
                const float rsv = rsa[ai][m];
                float g[8], up[8], e[8], o[8];
#pragma unroll
                for (int n = 0; n < 2; ++n) { const f32x4 g4 = accv<IN>(acc[ai][0][m][n], rsv, cv[0][n]), u4 = accv<IN>(acc[ai][1][m][n], rsv, cv[1][n]);
#pragma unroll
                    for (int j = 0; j < 4; ++j) { g[n * 4 + j] = g4[j] * kg; up[n * 4 + j] = u4[j] * ku; } }
#pragma unroll
                for (int j = 0; j < 8; ++j) e[j] = __builtin_amdgcn_exp2f(g[j] * -1.44269504089f);
#pragma unroll
                for (int j = 0; j < 8; ++j) asm volatile("" : "+v"(e[j]));
#pragma unroll
                for (int j = 0; j < 8; ++j) e[j] = __builtin_amdgcn_rcpf(1.0f + e[j]);
#pragma unroll
                for (int j = 0; j < 8; ++j) asm volatile("" : "+v"(e[j]));
#pragma unroll
                for (int j = 0; j < 8; ++j) { o[j] = (g[j] * up[j]) * e[j]; if constexpr (OUT8) o[j] = clamp_f8(o[j]); }
                if constexpr (OUT8) { u32x2 w; w.x = pk4_f8(o[0], o[1], o[2], o[3]); w.y = pk4_f8(o[4], o[5], o[6], o[7]);
                    *(GAS u32x2*)((GAS uchar*)act + (size_t)(row0 + ai * HALF + m * 16) * FFP + col0) = w; }
                else { u32x4 w; w.x = pk2(o[0], o[1]); w.y = pk2(o[2], o[3]); w.z = pk2(o[4], o[5]); w.w = pk2(o[6], o[7]);
                    *(GAS u32x4*)(act + (size_t)(row0 + ai * HALF + m * 16) * FFP + col0) = w; } }
    }
};
}
struct Frame {
    LAS uchar* lds;
    int tid, lane, wave, G, bid;
    uchar* ws; unsigned* ctl;
    float* out;
};
#define CAS __attribute__((address_space(4)))
typedef const float* cfptr_t;
__device__ __forceinline__ const float* argp(int k) { const CAS char* kp = (const CAS char*)__builtin_amdgcn_kernarg_segment_ptr(); asm volatile("" : "+s"(kp)); const float* p_ = *(const CAS cfptr_t*)(kp + 8 * k); ASSUME_GLOBAL(p_); return p_; }

template <bool F8 = false> __device__ __forceinline__ void xpose64w(const float* src, int N, int k0, int n0, typename OutT<F8>::t* dst, int ldd, LAS float* scr, int lane, int hi_off = 0, float sc = 1.0f) {
    const GAS char* base = (const GAS char*)(src + (size_t)k0 * N + n0);
    unsigned voff = (unsigned)lane * 4u; const unsigned rstep = (unsigned)N * 4u;
    float v[64];
#pragma unroll
    for (int k = 0; k < 64; ++k) { asm volatile("" : "+v"(voff)); v[k] = *(const GAS float*)(base + voff); voff += rstep; }
#pragma unroll
    for (int k = 0; k < 64; ++k) scr[k * 65 + lane] = v[k];
    asm volatile("s_waitcnt lgkmcnt(0)" ::: "memory"); __builtin_amdgcn_wave_barrier();
    const int kc = lane & 7;
#pragma unroll
    for (int i = 0; i < 8; ++i) { const int n = (lane >> 3) + 8 * i; const LAS float* s = scr + (8 * kc) * 65 + n;
        if constexpr (F8) { u32x2 o; o.x = pk4_f8(s[0] * sc, s[65] * sc, s[2 * 65] * sc, s[3 * 65] * sc); o.y = pk4_f8(s[4 * 65] * sc, s[5 * 65] * sc, s[6 * 65] * sc, s[7 * 65] * sc);
            *(GAS u32x2*)(dst + (size_t)n * ldd + 8 * kc + (n >= 32 ? hi_off : 0)) = o; }
        else { u32x4 o; o.x = pk2(s[0], s[65]); o.y = pk2(s[2 * 65], s[3 * 65]); o.z = pk2(s[4 * 65], s[5 * 65]); o.w = pk2(s[6 * 65], s[7 * 65]);
            *(GAS u32x4*)(dst + (size_t)n * ldd + 8 * kc + (n >= 32 ? hi_off : 0)) = o; } }
    asm volatile("s_waitcnt lgkmcnt(0)" ::: "memory"); __builtin_amdgcn_wave_barrier();
}
#define WAVE_SCR(F) ((LAS float*)((F).lds) + (F).wave * (64 * 65))
__device__ __forceinline__ void conv_win(Frame& F, const float* w, bf16_t* wtok, bf16_t* wch) {
    LAS float* scr = WAVE_SCR(F);
    for (int t = F.bid * NWAVES + F.wave; t < 16 * 80; t += F.G * NWAVES) {
        const int kb = t / 80, nb = t % 80, n0 = nb * 64;
        bf16_t* dst; int hi = 0;
        if (n0 < 1536) dst = wch + (size_t)n0 * 1024;
        else if (n0 < 2560) { const int G = (n0 - 1536) >> 6; dst = wtok + (size_t)(256 * (G >> 2) + 32 * (G & 3)) * 1024; hi = (128 - 32) * 1024; }
        else if (n0 < 3072) dst = wch + (size_t)(1536 + n0 - 2560) * 1024;
        else if (n0 < 4096) { const int c = n0 - 3072; dst = wtok + (size_t)(256 * (4 + (c >> 7)) + (c & 127)) * 1024; }
        else { const int c = n0 - 4096; dst = wtok + (size_t)(256 * (4 + (c >> 7)) + 128 + (c & 127)) * 1024; }
        xpose64w(w, INW, kb * 64, n0, dst + kb * 64, 1024, scr, F.lane, hi);
    }
}
__device__ __forceinline__ void conv_plain(Frame& F, const float* w, int K, int N, bf16_t* dst, int ldd) {
    LAS float* scr = WAVE_SCR(F);
    const int nkb = K / 64, nnb = N / 64;
    for (int t = F.bid * NWAVES + F.wave; t < nkb * nnb; t += F.G * NWAVES) { const int kb = t / nnb, nb = t % nnb;
        xpose64w(w, N, kb * 64, nb * 64, dst + (size_t)(nb * 64) * ldd + kb * 64, ldd, scr, F.lane); }
}
template <bool F8, bool F8DN = F8> __device__ __forceinline__ void conv_ffn(Frame& F, const float* wg, const float* wu, const float* wd, typename OutT<F8>::t* wgu, typename OutT<F8DN>::t* wdt, int nexp) {
    LAS float* scr = WAVE_SCR(F);
    constexpr int GUP = F8 ? P8 : 1024;
    const int per = 16 * 43;
    for (int t = F.bid * NWAVES + F.wave; t < nexp * 3 * per; t += F.G * NWAVES) {
        const int e = t / (3 * per), r = t % (3 * per), which = r / per, q = r % per;
        if (which < 2) { const int kb = q / 43, nb = q % 43, n0 = nb * 64; const float* src = (which ? wu : wg) + (size_t)e * 1024 * DFF;
            const int drow = (n0 / 128) * 256 + which * 128 + (n0 % 128);
            xpose64w<F8>(src, DFF, kb * 64, n0, wgu + (size_t)e * 5632 * GUP + (size_t)drow * GUP + kb * 64, GUP, scr, F.lane, 0, F8_SWGU);
        } else { const int kb = q / 16, nb = q % 16; const float* src = wd + (size_t)e * DFF * 1024;
            xpose64w<F8DN>(src, 1024, kb * 64, nb * 64, wdt + (size_t)e * 1024 * FFP + (size_t)(nb * 64) * FFP + kb * 64, FFP, scr, F.lane, 0, F8_SWD); }
    }
    constexpr int EPC = F8 ? 16 : 8, CR = 1024 / EPC, EPD = F8DN ? 16 : 8, CD = 64 / EPD;
    const int gt = F.bid * NTHR + F.tid, GT = F.G * NTHR;
    for (int i = gt; i < nexp * 128 * CR; i += GT) { const int e = i / (128 * CR), r = (i / CR) % 128, c8 = i % CR;
        const int row = 256 * 21 + (r < 64 ? 64 + r : 192 + (r - 64));
        *(GAS u32x4*)(wgu + (size_t)e * 5632 * GUP + (size_t)row * GUP + c8 * EPC) = zero4(); }
    for (int i = gt; i < nexp * 1024 * CD; i += GT) { const int e = i / (1024 * CD), n = (i / CD) % 1024, c8 = i % CD;
        *(GAS u32x4*)(wdt + (size_t)e * 1024 * FFP + (size_t)n * FFP + DFF + c8 * EPD) = zero4(); }
}

__device__ __forceinline__ void rope_tables(Frame& F) {
    GAS bf16_t* ct = (GAS bf16_t*)(F.ws + WS_ROPE); GAS bf16_t* st = ct + SEQ * 32;
    const int gt = F.bid * NTHR + F.tid, GT = F.G * NTHR;
    for (int i = gt; i < SEQ * 32; i += GT) { const int l = i >> 5, j = i & 31;
        const float inv_rev = __builtin_amdgcn_exp2f(-(float)j * (13.287712379549449f / 32.0f)) * 0.15915494309f;
        const float rev = (float)l * inv_rev;
        ct[i] = (bf16_t)f2bf(cos_rev(rev)); st[i] = (bf16_t)f2bf(sin_rev(rev)); }
}

__device__ __forceinline__ void norm_row_load(const float* xrow, int lane, f32x4 (&v)[4]) {
    const GAS f32x4* xr = (const GAS f32x4*)xrow + lane;
#pragma unroll
    for (int j = 0; j < 4; ++j) v[j] = xr[64 * j];
}
template <int OM> __device__ __forceinline__ void norm_row(f32x4 (&v)[4], const float* g, typename OutT<(OM != 0)>::t* orow, float* srow, int lane) {
    const GAS f32x4* gr = (const GAS f32x4*)g + lane;
    float s = 0.f;
#pragma unroll
    for (int j = 0; j < 4; ++j) s += (v[j].x * v[j].x + v[j].y * v[j].y) + (v[j].z * v[j].z + v[j].w * v[j].w);
    const float r = __builtin_amdgcn_rsqf(wave_sum(s) * (1.0f / DM) + RMS_EPS);
    if constexpr (OM == 2) {
        float mx = 0.f;
#pragma unroll
        for (int j = 0; j < 4; ++j) { const f32x4 gg = gr[64 * j]; v[j].x *= r * gg.x; v[j].y *= r * gg.y; v[j].z *= r * gg.z; v[j].w *= r * gg.w;
            mx = fmaxf(fmaxf(mx, fmaxf(fabsf(v[j].x), fabsf(v[j].y))), fmaxf(fabsf(v[j].z), fabsf(v[j].w))); }
        mx = fmaxf(wave_max(mx), 1e-30f); const float inv = 127.0f * __builtin_amdgcn_rcpf(mx);
#pragma unroll
        for (int j = 0; j < 4; ++j) ((GAS unsigned*)orow + lane)[64 * j] = pk4_i8(v[j].x * inv, v[j].y * inv, v[j].z * inv, v[j].w * inv);
        if (lane == 0) *(GAS float*)srow = mx * (1.0f / 127.0f);
    } else {
        GAS u32x2* o8 = (GAS u32x2*)orow + lane;
#pragma unroll
        for (int j = 0; j < 4; ++j) { const f32x4 gg = gr[64 * j]; u32x2 w; w.x = pk2(v[j].x * r * gg.x, v[j].y * r * gg.y); w.y = pk2(v[j].z * r * gg.z, v[j].w * r * gg.w); o8[64 * j] = w; }
    }
}
template <int OM> __device__ __forceinline__ void norm_row_bf(const u32x4 (&xw)[2], const float* g, typename OutT<(OM != 0)>::t* orow, float* srow, int lane) {
    const GAS f32x4* gr = (const GAS f32x4*)g + 2 * lane;
    float v[2][8]; float s = 0.f;
#pragma unroll
    for (int j = 0; j < 2; ++j) { const u32x4 w = xw[j]; v[j][0] = bflo(w.x); v[j][1] = bfhi(w.x); v[j][2] = bflo(w.y); v[j][3] = bfhi(w.y); v[j][4] = bflo(w.z); v[j][5] = bfhi(w.z); v[j][6] = bflo(w.w); v[j][7] = bfhi(w.w);
#pragma unroll
        for (int e = 0; e < 8; ++e) s += v[j][e] * v[j][e]; }
    const float r = __builtin_amdgcn_rsqf(wave_sum(s) * (1.0f / DM) + RMS_EPS) * (OM == 1 ? F8_SH : 1.0f);
    if constexpr (OM == 2) {
        float mx = 0.f;
#pragma unroll
        for (int j = 0; j < 2; ++j) { const f32x4 ga = gr[128 * j], gb = gr[128 * j + 1];
            v[j][0] *= r * ga.x; v[j][1] *= r * ga.y; v[j][2] *= r * ga.z; v[j][3] *= r * ga.w; v[j][4] *= r * gb.x; v[j][5] *= r * gb.y; v[j][6] *= r * gb.z; v[j][7] *= r * gb.w;
#pragma unroll
            for (int e = 0; e < 8; ++e) mx = fmaxf(mx, fabsf(v[j][e])); }
        mx = fmaxf(wave_max(mx), 1e-30f); const float inv = 127.0f * __builtin_amdgcn_rcpf(mx);
#pragma unroll
        for (int j = 0; j < 2; ++j) ((GAS u32x2*)orow + lane)[64 * j] = (u32x2){pk4_i8(v[j][0] * inv, v[j][1] * inv, v[j][2] * inv, v[j][3] * inv), pk4_i8(v[j][4] * inv, v[j][5] * inv, v[j][6] * inv, v[j][7] * inv)};
        if (lane == 0) *(GAS float*)srow = mx * (1.0f / 127.0f);
    } else {
#pragma unroll
        for (int j = 0; j < 2; ++j) { const f32x4 ga = gr[128 * j], gb = gr[128 * j + 1];
            if constexpr (OM == 1) ((GAS u32x2*)orow + lane)[64 * j] = (u32x2){pk4_f8(v[j][0] * r * ga.x, v[j][1] * r * ga.y, v[j][2] * r * ga.z, v[j][3] * r * ga.w), pk4_f8(v[j][4] * r * gb.x, v[j][5] * r * gb.y, v[j][6] * r * gb.z, v[j][7] * r * gb.w)};
            else ((GAS u32x4*)orow + lane)[64 * j] = (u32x4){pk2(v[j][0] * r * ga.x, v[j][1] * r * ga.y), pk2(v[j][2] * r * ga.z, v[j][3] * r * ga.w), pk2(v[j][4] * r * gb.x, v[j][5] * r * gb.y), pk2(v[j][6] * r * gb.z, v[j][7] * r * gb.w)}; }
    }
}
template <int OM> __device__ __forceinline__ void phase_norm_bf(Frame& F, const bf16_t* xr, const float* g, typename OutT<(OM != 0)>::t* h, float* hs) {
    const int gw = F.bid * NWAVES + F.wave, NGW = F.G * NWAVES;
    u32x4 xw[2], nw[2];
    if (gw < NTOK) { xw[0] = ((const GAS u32x4*)(xr + (size_t)gw * XR_LD) + F.lane)[0]; xw[1] = ((const GAS u32x4*)(xr + (size_t)gw * XR_LD) + F.lane)[64]; }
    for (int m = gw; m < NTOK; m += NGW) { const int mn = m + NGW < NTOK ? m + NGW : m;
        nw[0] = ((const GAS u32x4*)(xr + (size_t)mn * XR_LD) + F.lane)[0]; nw[1] = ((const GAS u32x4*)(xr + (size_t)mn * XR_LD) + F.lane)[64];
        norm_row_bf<OM>(xw, g, h + (size_t)m * (OM == 2 ? P8 : DM), hs + m, F.lane);
        xw[0] = nw[0]; xw[1] = nw[1]; }
}
template <int OM> __device__ __forceinline__ void phase_norm(Frame& F, const float* x, const float* g, typename OutT<(OM != 0)>::t* h, float* hs) {
    const int gw = F.bid * NWAVES + F.wave, NGW = F.G * NWAVES;
    f32x4 v[4], nv[4];
    if (gw < NTOK) norm_row_load(x + (size_t)gw * DM, F.lane, v);
    for (int m = gw; m < NTOK; m += NGW) { const int mn = m + NGW < NTOK ? m + NGW : m;
        norm_row_load(x + (size_t)mn * DM, F.lane, nv);
        norm_row<OM>(v, g, h + (size_t)m * (OM == 2 ? P8 : DM), hs + m, F.lane);
#pragma unroll
        for (int j = 0; j < 4; ++j) v[j] = nv[j]; }
}
__device__ __forceinline__ void quant_rows(Frame& F, const bf16_t* src, uchar* dst, float* sc, int R) {
    const int gw = F.bid * NWAVES + F.wave, NGW = F.G * NWAVES;
    for (int r = gw; r < R; r += NGW) {
        const GAS u32x4* sp = (const GAS u32x4*)(src + (size_t)r * 1024) + 2 * F.lane;
        const u32x4 a = sp[0], b = sp[1];
        const unsigned w[8] = {a.x, a.y, a.z, a.w, b.x, b.y, b.z, b.w};
        float v[16]; float mx = 0.f;
#pragma unroll
        for (int e = 0; e < 8; ++e) { v[2 * e] = bflo(w[e]); v[2 * e + 1] = bfhi(w[e]); mx = fmaxf(mx, fmaxf(fabsf(v[2 * e]), fabsf(v[2 * e + 1]))); }
        mx = fmaxf(wave_max(mx), 1e-30f); const float inv = 127.0f * __builtin_amdgcn_rcpf(mx);
        *((GAS u32x4*)(dst + (size_t)r * P8) + F.lane) = (u32x4){pk4_i8(v[0] * inv, v[1] * inv, v[2] * inv, v[3] * inv), pk4_i8(v[4] * inv, v[5] * inv, v[6] * inv, v[7] * inv),
                                                                   pk4_i8(v[8] * inv, v[9] * inv, v[10] * inv, v[11] * inv), pk4_i8(v[12] * inv, v[13] * inv, v[14] * inv, v[15] * inv)};
        if (F.lane == 0) ((GAS float*)sc)[r] = mx * (1.0f / 127.0f);
    }
}

__device__ __forceinline__ void phase_hdn(Frame& F, int layer) {
    const GAS float* w1 = (const GAS float*)argp(4) + (size_t)layer * FEMB * FHID; const GAS float* b1 = (const GAS float*)argp(5) + layer * FHID; const GAS float* fr1 = (const GAS float*)argp(6) + layer * FHID;
    const GAS float* w2 = (const GAS float*)argp(7) + (size_t)layer * FHID * FHID; const GAS float* b2 = (const GAS float*)argp(8) + layer * FHID; const GAS float* fr2 = (const GAS float*)argp(9) + layer * FHID;
    GAS float* hdn = (GAS float*)(F.ws + WS_HDN) + (size_t)layer * SEQ * FHID;
    LAS float* scr = (LAS float*)(F.lds + 136 * 1024) + F.wave * 128;
    const int gw = F.bid * NWAVES + F.wave, NGW = F.G * NWAVES, j = F.lane;
    for (int l = gw; l < SEQ; l += NGW) {
        float z = 0.f;
        if (j == 0) z = (float)l * (1.0f / (float)(SEQ - 1));
        else if (j < FEMB) { const int i = (j - 1) & 15; const float f = 1e-4f + (float)i * ((15.0f - 1e-4f) / 15.0f);
            const float rev = f * ((float)l * (1.0f / (float)SEQ)); z = (j <= 16) ? cos_rev(rev) : -sin_rev(rev); }
        scr[j] = z;
        __builtin_amdgcn_wave_barrier(); asm volatile("s_waitcnt lgkmcnt(0)" ::: "memory");
        float a1 = b1[j];
        for (int i = 0; i < FEMB; ++i) a1 += scr[i] * w1[i * FHID + j];
        const float h1 = fast_sin(fr1[j] * a1);
        scr[64 + j] = h1;
        __builtin_amdgcn_wave_barrier(); asm volatile("s_waitcnt lgkmcnt(0)" ::: "memory");
        float a2 = b2[j];
        for (int i = 0; i < FHID; ++i) a2 += scr[64 + i] * w2[i * FHID + j];
        hdn[(size_t)l * FHID + j] = fast_sin(fr2[j] * a2);
        __builtin_amdgcn_wave_barrier(); asm volatile("s_waitcnt lgkmcnt(0)" ::: "memory");
    }
}

__device__ __forceinline__ void phase_fimg(Frame& F, int layer) {
    const GAS float* hdn = (const GAS float*)(F.ws + WS_HDN) + (size_t)layer * SEQ * FHID;
    const GAS float* w3 = (const GAS float*)argp(10) + (size_t)layer * FHID * 2048;
    GAS bf16_t* gimg = (GAS bf16_t*)(F.ws + WS_FIMG);
    const int gw = F.bid * NWAVES + F.wave, NGW = F.G * NWAVES;
    const float min_decay = -4.605170185988091f / 1.5f, max_decay = -4.605170185988091f / 0.3f;
    for (int it = gw; it < 32 * 64; it += NGW) {
        const int lbp = it >> 6, cb = it & 63;
        const int o = cb >> 5, dir = (cb >> 4) & 1;
        int l[2], u[2], lc[2];
#pragma unroll
        for (int h = 0; h < 2; ++h) { const int lb = 2 * lbp + h; l[h] = dir ? (64 * lb + 1 + F.lane) : (64 * lb + 63 - F.lane); u[h] = dir ? (4160 + 64 * lb + F.lane) : (4096 - 64 * lb + F.lane); lc[h] = l[h] < SEQ ? l[h] : SEQ - 1; }
        f32x2 hv[FHID];
        { const GAS f32x4* hp0 = (const GAS f32x4*)(hdn + (size_t)lc[0] * FHID); const GAS f32x4* hp1 = (const GAS f32x4*)(hdn + (size_t)lc[1] * FHID);
#pragma unroll
          for (int i = 0; i < 16; ++i) { const f32x4 a = hp0[i], b = hp1[i]; hv[4 * i] = (f32x2){a.x, b.x}; hv[4 * i + 1] = (f32x2){a.y, b.y}; hv[4 * i + 2] = (f32x2){a.z, b.z}; hv[4 * i + 3] = (f32x2){a.w, b.w}; } }
        LAS float* wt = (LAS float*)(F.lds) + F.wave * 2048;
        { const GAS f32x4* wp = (const GAS f32x4*)(w3 + (size_t)F.lane * 2048 + cb * 32);
#pragma unroll
          for (int q = 0; q < 8; ++q) { const f32x4 t = wp[q]; wt[(4 * q) * 64 + F.lane] = t.x; wt[(4 * q + 1) * 64 + F.lane] = t.y; wt[(4 * q + 2) * 64 + F.lane] = t.z; wt[(4 * q + 3) * 64 + F.lane] = t.w; } }
        asm volatile("s_waitcnt lgkmcnt(0)" ::: "memory"); __builtin_amdgcn_wave_barrier();
        const f32x2 tl = {(float)lc[0] * (1.0f / (float)(SEQ - 1)), (float)lc[1] * (1.0f / (float)(SEQ - 1))};
        for (int cc = 0; cc < 32; ++cc) {
            const int col = cb * 32 + cc, c = col & 511;
            f32x2 acc = {0.f, 0.f};
            const LAS f32x4* wc4 = (const LAS f32x4*)(wt + cc * 64);
#pragma unroll
            for (int i = 0; i < 16; ++i) { const f32x4 w4 = wc4[i];
                acc += hv[4 * i] * (f32x2){w4.x, w4.x}; acc += hv[4 * i + 1] * (f32x2){w4.y, w4.y}; acc += hv[4 * i + 2] * (f32x2){w4.z, w4.z}; acc += hv[4 * i + 3] * (f32x2){w4.w, w4.w}; }
            const float delta = fabsf(min_decay + (float)c * ((max_decay - min_decay) / 511.0f));
#pragma unroll
            for (int h = 0; h < 2; ++h) { const float val = l[h] < SEQ ? acc[h] * fast_exp(-tl[h] * delta) : 0.f;
                gimg[(size_t)(o * 512 + c) * GIMG_LEN + u[h]] = (unsigned short)f2bf(val); }
        }
        asm volatile("s_waitcnt lgkmcnt(0)" ::: "memory"); __builtin_amdgcn_wave_barrier();
    }
}

typedef short s16x4 __attribute__((ext_vector_type(4)));
__device__ __forceinline__ void phase_transpose_y(Frame& F) {
    const GAS bf16_t* yT = (const GAS bf16_t*)(F.ws + WS_YT); GAS bf16_t* yh = (GAS bf16_t*)(F.ws + WS_YCAT);
    constexpr int RB = 144;
    const int r = F.tid >> 3, c8 = F.tid & 7;
    const int w = F.wave, g = F.lane >> 4, i = F.lane & 15, q = i >> 2, p = i & 3;
    u32x4 nx = *(const GAS u32x4*)(yT + (size_t)((F.bid & 7) * 64 + r) * NTOK + (F.bid >> 3) * 64 + c8 * 8);
    int par = 0;
    for (int t = F.bid; t < 8 * 512; t += F.G) {
        const int cb = t & 7, tb = t >> 3;
        LAS uchar* buf = F.lds + par * (64 * RB); par ^= 1;
        *(LAS u32x4*)(buf + r * RB + c8 * 16) = nx;
        { const int tn = t + F.G < 8 * 512 ? t + F.G : t; nx = *(const GAS u32x4*)(yT + (size_t)((tn & 7) * 64 + r) * NTOK + (tn >> 3) * 64 + c8 * 8); }
        __syncthreads();
        const s16x4 va = __builtin_amdgcn_ds_read_tr16_b64_v4i16((LAS s16x4*)(buf + (8 * w + q) * RB + (16 * g + 4 * p) * 2));
        const s16x4 vb = __builtin_amdgcn_ds_read_tr16_b64_v4i16((LAS s16x4*)(buf + (8 * w + 4 + q) * RB + (16 * g + 4 * p) * 2));
        const bf16x8 o = __builtin_shufflevector(va, vb, 0, 1, 2, 3, 4, 5, 6, 7);
        *(GAS bf16x8*)(yh + (size_t)(tb * 64 + 16 * g + i) * 1024 + cb * 64 + 8 * w) = o;
    }
    __syncthreads();
}
constexpr int HY_F = 0, HY_V = FIMG_BYTES, HY_VROW = 144, HY_VROWS = 78 * 8;
static_assert(HY_V + HY_VROWS * HY_VROW <= LDS_MISC, "hyena LDS");

__device__ __forceinline__ void hy_load_fimg(Frame& F, const GAS bf16_t* g) {
    const GAS u32x4* src = (const GAS u32x4*)g;
    constexpr int NJ = FIMG_LEN / 8, NQ = (NJ + NTHR - 1) / NTHR;
    u32x4 av[NQ], bv[NQ];
#pragma unroll
    for (int q = 0; q < NQ; ++q) { const int j0 = F.tid + q * NTHR, j = j0 < NJ ? j0 : NJ - 1; av[q] = src[j + 7]; bv[q] = src[j + 8]; }
#pragma unroll
    for (int q = 0; q < NQ; ++q) { const int j = F.tid + q * NTHR; if (j < NJ) {
        const u32x4 a = av[q], b = bv[q];
        const unsigned d2 = a.z, d3 = a.w, d4 = b.x, d5 = b.y, d6 = b.z, d7 = b.w;
        LAS uchar* dst = F.lds + HY_F + j * 16;
        *(LAS u32x4*)(dst) = (u32x4){__builtin_amdgcn_alignbit(d4, d3, 16), __builtin_amdgcn_alignbit(d5, d4, 16), __builtin_amdgcn_alignbit(d6, d5, 16), __builtin_amdgcn_alignbit(d7, d6, 16)};
        *(LAS u32x4*)(dst + FIMG_LEN * 2) = (u32x4){d3, d4, d5, d6};
        *(LAS u32x4*)(dst + 2 * FIMG_LEN * 2) = (u32x4){__builtin_amdgcn_alignbit(d3, d2, 16), __builtin_amdgcn_alignbit(d4, d3, 16), __builtin_amdgcn_alignbit(d5, d4, 16), __builtin_amdgcn_alignbit(d6, d5, 16)};
        *(LAS u32x4*)(dst + 3 * FIMG_LEN * 2) = (u32x4){d2, d3, d4, d5}; } }
}
__device__ __forceinline__ bf16x8 hy_lda(const LAS uchar* p) { const bf16x4 lo = *(const volatile LAS bf16x4*)p; const bf16x4 hi = *(const volatile LAS bf16x4*)(p + 8); return __builtin_shufflevector(lo, hi, 0, 1, 2, 3, 4, 5, 6, 7); }
template <int N0, int N1> __device__ __forceinline__ void hy_step(const LAS uchar*& pA, const LAS uchar*& pB, bf16x8 (&a0)[4], bf16x8 (&a1)[4], bf16x8 (&b0)[4], bf16x8 (&b1)[4], f32x4 (&acc)[4][4]) {
#pragma unroll
    for (int r = 0; r < 4; ++r) { a1[r] = hy_lda(pA + r * (FIMG_LEN * 2) + 64); b1[r] = *(const LAS bf16x8*)(pB + r * (16 * HY_VROW) + 64);
#pragma unroll
        for (int nt = N0; nt < N1; ++nt) acc[r][nt] = __builtin_amdgcn_mfma_f32_16x16x32_bf16(a0[r], b0[nt], acc[r][nt], 0, 0, 0);
        __builtin_amdgcn_sched_barrier(0); }
#pragma unroll
    for (int r = 0; r < 4; ++r) { a0[r] = hy_lda(pA + r * (FIMG_LEN * 2) + 128); b0[r] = *(const LAS bf16x8*)(pB + r * (16 * HY_VROW) + 8 * HY_VROW);
#pragma unroll
        for (int nt = N0; nt < N1; ++nt) acc[r][nt] = __builtin_amdgcn_mfma_f32_16x16x32_bf16(a1[r], b1[nt], acc[r][nt], 0, 0, 0);
        __builtin_amdgcn_sched_barrier(0); }
    pA += 128; pB += 8 * HY_VROW;
}
__device__ __forceinline__ void hy_conv(Frame& F, f32x4 (&acc)[4][4]) {
    const int q = F.wave, i = F.lane & 15, g = F.lane >> 4;
#pragma unroll
    for (int r = 0; r < 4; ++r)
#pragma unroll
        for (int nt = 0; nt < 4; ++nt) acc[r][nt] = (f32x4){0.f, 0.f, 0.f, 0.f};
    const int dhi = 8 * q + 7;
    const LAS uchar* pA = F.lds + (unsigned)(HY_F + 8192 - 8 * i + 16 * g - 128 * dhi);
    const LAS uchar* pB = F.lds + (unsigned)(HY_V + ((8 * q + (i >> 3) + 7) * 8 + (i & 7)) * HY_VROW + 16 * g - 8 * HY_VROW * dhi);
    bf16x8 a0[4], a1[4], b0[4], b1[4];
#pragma unroll
    for (int r = 0; r < 4; ++r) { a0[r] = hy_lda(pA + r * (FIMG_LEN * 2)); b0[r] = *(const LAS bf16x8*)(pB + r * (16 * HY_VROW)); }
    hy_step<3, 4>(pA, pB, a0, a1, b0, b1, acc); hy_step<3, 4>(pA, pB, a0, a1, b0, b1, acc);
    hy_step<2, 4>(pA, pB, a0, a1, b0, b1, acc); hy_step<2, 4>(pA, pB, a0, a1, b0, b1, acc);
    hy_step<1, 4>(pA, pB, a0, a1, b0, b1, acc); hy_step<1, 4>(pA, pB, a0, a1, b0, b1, acc);
#pragma clang loop unroll(disable)
    for (int m = 6; m < 65; ++m) hy_step<0, 4>(pA, pB, a0, a1, b0, b1, acc);
    hy_step<0, 3>(pA, pB, a0, a1, b0, b1, acc); hy_step<0, 3>(pA, pB, a0, a1, b0, b1, acc);
    hy_step<0, 2>(pA, pB, a0, a1, b0, b1, acc); hy_step<0, 2>(pA, pB, a0, a1, b0, b1, acc);
    hy_step<0, 1>(pA, pB, a0, a1, b0, b1, acc); hy_step<0, 1>(pA, pB, a0, a1, b0, b1, acc);
}
__device__ __forceinline__ void conv8(const u32x4 u, float left, float right, float w0, float w1, float w2, float (&y)[8]) {
    float x[10]; x[0] = left; x[1] = bflo(u.x); x[2] = bfhi(u.x); x[3] = bflo(u.y); x[4] = bfhi(u.y); x[5] = bflo(u.z); x[6] = bfhi(u.z); x[7] = bflo(u.w); x[8] = bfhi(u.w); x[9] = right;
#pragma unroll
    for (int e = 0; e < 8; ++e) y[e] = w0 * x[e] + w1 * x[e + 1] + w2 * x[e + 2];
}
struct Run16 { u32x4 a, b; unsigned short l, r; };
__device__ __forceinline__ Run16 run16_load(const GAS bf16_t* p, int t) { Run16 x; x.a = *(const GAS u32x4*)(p + t); x.b = *(const GAS u32x4*)(p + t + 8); x.l = p[t > 0 ? t - 1 : t]; x.r = p[t + 16 < SEQ ? t + 16 : t]; return x; }
__device__ __forceinline__ void run16_conv(const Run16& x, int t, float w0, float w1, float w2, float (&y)[16]) {
    const float left = t > 0 ? bf2f(x.l) : 0.f, right = t + 16 < SEQ ? bf2f(x.r) : 0.f;
    float ya[8], yb[8];
    conv8(x.a, left, bflo(x.b.x), w0, w1, w2, ya); conv8(x.b, bfhi(x.a.w), right, w0, w1, w2, yb);
#pragma unroll
    for (int e = 0; e < 8; ++e) { y[e] = ya[e]; y[8 + e] = yb[e]; }
}
__device__ __forceinline__ void phase_hyena(Frame& F, int layer) {
    const GAS bf16_t* hy = (const GAS bf16_t*)(F.ws + WS_CHT);
    GAS bf16_t* yT = (GAS bf16_t*)(F.ws + WS_YT);
    const GAS bf16_t* fimg = (const GAS bf16_t*)(F.ws + WS_FIMG);
    const GAS float* hb = (const GAS float*)argp(11) + (size_t)layer * 2 * HW;
    const GAS float* cw = (const GAS float*)argp(3) + (size_t)layer * 3 * 1536;
    const int q = F.wave, n = F.lane & 15, g = F.lane >> 4;
    for (int c = F.bid; c < HW; c += F.G) {
        for (int i = F.tid; i < 112 * (HY_VROW / 16); i += NTHR) { const int r = i / (HY_VROW / 16), k = i % (HY_VROW / 16); const int row = r < 56 ? r : (71 * 8 + r - 56);
            *(LAS u32x4*)(F.lds + HY_V + row * HY_VROW + k * 16) = zero4(); }
        { const float w0 = cw[1024 + c], w1 = cw[1536 + 1024 + c], w2 = cw[2 * 1536 + 1024 + c];
          int tl = F.tid; asm volatile("" : "+v"(tl));
          const int k = tl & 7, b = (tl >> 3) & 7, sq = tl >> 6;
          const GAS char* pc = (const GAS char*)(hy + (size_t)(1024 + c) * NTOK); asm volatile("" : "+s"(pc));
          const unsigned ob = (unsigned)(b * SEQ + k * 8) * 2u;
#pragma unroll
          for (int jb = 0; jb < 8; jb += 4) {
          u32x4 uu[4]; unsigned short ll[4], rr[4];
#pragma unroll
          for (int j = 0; j < 4; ++j) { const int t = (sq + 8 * (jb + j)) * 64 + k * 8; const unsigned o = ob + (unsigned)(sq + 8 * (jb + j)) * 128u;
              uu[j] = *(const GAS u32x4*)(pc + o); ll[j] = *(const GAS unsigned short*)(pc + (t > 0 ? o - 2u : o)); rr[j] = *(const GAS unsigned short*)(pc + (t + 8 < SEQ ? o + 16u : o)); }
          __builtin_amdgcn_sched_barrier(0);
#pragma unroll
          for (int j = 0; j < 4; ++j) { const int s1 = sq + 8 * (jb + j), t = s1 * 64 + k * 8, r = s1 * 8 + b;
            const float left = t > 0 ? bf2f(ll[j]) : 0.f, right = t + 8 < SEQ ? bf2f(rr[j]) : 0.f;
            float y[8]; conv8(uu[j], left, right, w0, w1, w2, y);
            *(LAS u32x4*)(F.lds + HY_V + (r + 56) * HY_VROW + k * 16) = (u32x4){pk2(y[0], y[1]), pk2(y[2], y[3]), pk2(y[4], y[5]), pk2(y[6], y[7])}; }
          __builtin_amdgcn_sched_barrier(0);
          } }
        hy_load_fimg(F, fimg + (size_t)(0 * 512 + c) * GIMG_LEN);
        __syncthreads();
        f32x4 acc[4][4];
        Run16 xr[4];
        { const int b = n & 7;
#pragma unroll
          for (int nt = 0; nt < 4; ++nt) xr[nt] = run16_load(hy + (size_t)c * NTOK + b * SEQ, (8 * q + 2 * nt + (n >> 3)) * 64 + 16 * g); }
        hy_conv(F, acc);
        __syncthreads();
        {
            const float bias = hb[c]; const int b = n & 7;
            const float w0 = cw[c], w1 = cw[1536 + c], w2 = cw[2 * 1536 + c];
#pragma unroll
            for (int nt = 0; nt < 4; ++nt) {
                const int t1 = 8 * q + 2 * nt + (n >> 3), t0 = 16 * g;
                LAS u32x4* vp = (LAS u32x4*)(F.lds + HY_V + ((t1 + 7) * 8 + b) * HY_VROW + t0 * 2);
                float xv[16]; run16_conv(xr[nt], t1 * 64 + t0, w0, w1, w2, xv);
                const u32x4 v0 = vp[0], v1 = vp[1];
                const unsigned vw[8] = {v0.x, v0.y, v0.z, v0.w, v1.x, v1.y, v1.z, v1.w};
                unsigned ow[8];
#pragma unroll
                for (int p = 0; p < 8; ++p) {
                    const int e0 = 2 * p, e1 = 2 * p + 1;
                    const float z0 = xv[e0] * (acc[e0 & 3][nt][e0 >> 2] + bias * bflo(vw[p]));
                    const float z1 = xv[e1] * (acc[e1 & 3][nt][e1 >> 2] + bias * bfhi(vw[p]));
                    ow[p] = pk2(z0, z1); }
                vp[0] = (u32x4){ow[0], ow[1], ow[2], ow[3]}; vp[1] = (u32x4){ow[4], ow[5], ow[6], ow[7]};
            }
        }
        hy_load_fimg(F, fimg + (size_t)(1 * 512 + c) * GIMG_LEN);
        { const int b = n & 7;
#pragma unroll
          for (int nt = 0; nt < 4; ++nt) xr[nt] = run16_load(hy + (size_t)(512 + c) * NTOK + b * SEQ, (8 * q + 2 * nt + (n >> 3)) * 64 + 16 * g); }
        __syncthreads();
        hy_conv(F, acc);
        {
            const float bias = hb[HW + c]; const int b = n & 7;
            const float w0 = cw[512 + c], w1 = cw[1536 + 512 + c], w2 = cw[2 * 1536 + 512 + c];
#pragma unroll
            for (int nt = 0; nt < 4; ++nt) {
                const int t1 = 8 * q + 2 * nt + (n >> 3), t0 = 16 * g;
                const LAS u32x4* vp = (const LAS u32x4*)(F.lds + HY_V + ((t1 + 7) * 8 + b) * HY_VROW + t0 * 2);
                float xv[16]; run16_conv(xr[nt], t1 * 64 + t0, w0, w1, w2, xv);
                GAS u32x4* op = (GAS u32x4*)(yT + (size_t)c * NTOK + b * SEQ + t1 * 64 + t0);
                const u32x4 v0 = vp[0], v1 = vp[1];
                const unsigned vw[8] = {v0.x, v0.y, v0.z, v0.w, v1.x, v1.y, v1.z, v1.w};
                unsigned ow[8];
#pragma unroll
                for (int p = 0; p < 8; ++p) {
                    const int e0 = 2 * p, e1 = 2 * p + 1;
                    const float z0 = xv[e0] * (acc[e0 & 3][nt][e0 >> 2] + bias * bflo(vw[p]));
                    const float z1 = xv[e1] * (acc[e1 & 3][nt][e1 >> 2] + bias * bfhi(vw[p]));
                    ow[p] = pk2(z0, z1); }
                op[0] = (u32x4){ow[0], ow[1], ow[2], ow[3]}; op[1] = (u32x4){ow[4], ow[5], ow[6], ow[7]};
            }
        }
        __syncthreads();
    }
}

constexpr int AK_SLOT = 16384, AV_BASE = 65536, AV_SLOT = 16384;
constexpr int AT_X = 0, AT_XROW = 132 * 4, AT_Y = 4 * 32 * AT_XROW, AT_YROW = 272;
constexpr int AT_OFS = 131072;
static_assert(AT_Y + 128 * AT_YROW <= AT_OFS && AV_BASE + 4 * AV_SLOT <= AT_OFS && AT_OFS + 512 * 16 <= LDS_MISC, "attn LDS");
#define AT_SBAR() __builtin_amdgcn_sched_barrier(0)
#define AT_PIN(x) asm volatile("" : "+v"(x))
#define AT_MFMA(a_, b_, c_) __builtin_amdgcn_mfma_f32_32x32x16_bf16(a_, b_, c_, 0, 0, 0)
#define AT_LDK(slot_, mt_, kk_) (*(const LAS bf16x8*)(pk[kk_] + ((slot_) * AK_SLOT + (mt_) * 8192)))
#define AT_LDV(slot_, ks_, mv_) (*(const LAS bf16x8*)(pv[ks_] + ((slot_) * AV_SLOT + (mv_) * 4096)))
#define AT_QTR(SRC, SP, DST, KK0, CIN, KF0, KF1, VF0, VF1, VF2, VF3, PP, PC, NK0, NK1, NKS, NKM, NKK, NV0, NV1, NV2, NV3, NVS, NVK) do { \
        float e0_, e1_, e2_, e3_, e4_, e5_, e6_, e7_; unsigned w0_, w1_, w2_, w3_; \
        DST = AT_MFMA(KF0, qf[KK0], CIN); NK0 = AT_LDK(NKS, NKM, NKK); \
        e0_ = __builtin_amdgcn_exp2f(SRC[8 * (SP)]); e1_ = __builtin_amdgcn_exp2f(SRC[8 * (SP) + 1]); AT_PIN(e0_); AT_PIN(e1_); AT_SBAR(); \
        DST = AT_MFMA(KF1, qf[(KK0) + 1], DST); NK1 = AT_LDK(NKS, NKM, (NKK) + 1); \
        e2_ = __builtin_amdgcn_exp2f(SRC[8 * (SP) + 2]); e3_ = __builtin_amdgcn_exp2f(SRC[8 * (SP) + 3]); lsum += e0_; lsum += e1_; AT_PIN(e2_); AT_PIN(e3_); AT_PIN(lsum); AT_SBAR(); \
        o[0] = AT_MFMA(VF0, PP, o[0]); NV0 = AT_LDV(NVS, NVK, 0); \
        e4_ = __builtin_amdgcn_exp2f(SRC[8 * (SP) + 4]); e5_ = __builtin_amdgcn_exp2f(SRC[8 * (SP) + 5]); lsum += e2_; lsum += e3_; AT_PIN(e4_); AT_PIN(e5_); AT_PIN(lsum); AT_SBAR(); \
        o[1] = AT_MFMA(VF1, PP, o[1]); NV1 = AT_LDV(NVS, NVK, 1); \
        e6_ = __builtin_amdgcn_exp2f(SRC[8 * (SP) + 6]); e7_ = __builtin_amdgcn_exp2f(SRC[8 * (SP) + 7]); lsum += e4_; lsum += e5_; AT_PIN(e6_); AT_PIN(e7_); AT_PIN(lsum); AT_SBAR(); \
        o[2] = AT_MFMA(VF2, PP, o[2]); NV2 = AT_LDV(NVS, NVK, 2); \
        w0_ = pk2(e0_, e1_); w1_ = pk2(e2_, e3_); lsum += e6_; lsum += e7_; AT_PIN(w0_); AT_PIN(w1_); AT_PIN(lsum); AT_SBAR(); \
        o[3] = AT_MFMA(VF3, PP, o[3]); NV3 = AT_LDV(NVS, NVK, 3); \
        w2_ = pk2(e4_, e5_); w3_ = pk2(e6_, e7_); AT_PIN(w2_); AT_PIN(w3_); AT_SBAR(); \
        PC = __builtin_bit_cast(bf16x8, (u32x4){w0_, w1_, w2_, w3_}); } while (0)

__device__ __forceinline__ void phase_attn(Frame& F, int layer) {
    const GAS bf16_t* qk = (const GAS bf16_t*)(F.ws + WS_QK); const GAS bf16_t* vT = (const GAS bf16_t*)(F.ws + WS_CHT) + (size_t)1536 * NTOK;
    GAS bf16_t* ya = (GAS bf16_t*)(F.ws + WS_YCAT) + 512;
    const float lambda_init = 0.8f - 0.6f * fast_exp(-0.3f * (float)layer);
    float lam;
    {
        const GAS float* q1 = (const GAS float*)argp(14) + layer * HD; const GAS float* k1 = (const GAS float*)argp(15) + layer * HD; const GAS float* q2 = (const GAS float*)argp(16) + layer * HD; const GAS float* k2 = (const GAS float*)argp(17) + layer * HD;
        float s1 = 0.f, s2 = 0.f;
        for (int i = 0; i < HD; ++i) { s1 += q1[i] * k1[i]; s2 += q2[i] * k2[i]; }
        lam = fast_exp(s1) - fast_exp(s2) + lambda_init;
    }
    const GAS float* subg = (const GAS float*)argp(18) + layer * DV;
    const int w = F.wave, comp = w >> 2, qs = w & 3, i = F.lane & 31, hh = F.lane >> 5;
    const int pi_i = i ^ ((((i >> 2) ^ (i >> 3)) & 1) * 12);
    {
        u32x4 ofs;
        { const int key0 = 8 * w + (F.lane >> 4), key1 = key0 + 4; ofs.x = (unsigned)(key0 * 2048 + (((F.lane & 15) ^ (key0 & 15)) << 4)); ofs.y = (unsigned)(key1 * 2048 + (((F.lane & 15) ^ (key1 & 15)) << 4));
          const int dv0 = 16 * w + (F.lane >> 3), dv1 = dv0 + 8; ofs.z = (unsigned)dv0 * (unsigned)(NTOK * 2) + (unsigned)((((F.lane & 7) ^ ((dv0 >> 1) & 7))) << 4); ofs.w = (unsigned)dv1 * (unsigned)(NTOK * 2) + (unsigned)((((F.lane & 7) ^ ((dv1 >> 1) & 7))) << 4); }
        *(LAS u32x4*)(F.lds + AT_OFS + F.tid * 16) = ofs;
    }
    const LAS uchar* pk[4]; const LAS uchar* pv[4];
#pragma unroll
    for (int kk = 0; kk < 4; ++kk) { const int ch = comp * 8 + 2 * kk + hh; pk[kk] = F.lds + (unsigned)(pi_i * 256 + ((ch ^ (pi_i & 15)) << 4)); }
#pragma unroll
    for (int ks = 0; ks < 4; ++ks) { const int cv = 2 * ks + hh; pv[ks] = F.lds + (unsigned)(AV_BASE + i * 128 + ((cv ^ ((i >> 1) & 7)) << 4)); }
    const f32x16 negMv = {0.f, 0.f, 0.f, 0.f, 0.f, 0.f, 0.f, 0.f, 0.f, 0.f, 0.f, 0.f, 0.f, 0.f, 0.f, 0.f};
#define AT_ISSUE_KV(tk_, tv_) do { const int tk2_ = (tk_) < 64 ? (tk_) : 63, tv2_ = (tv_) < 64 ? (tv_) : 63; \
        const GAS char* kb_ = kbase + (size_t)tk2_ * 131072; const GAS char* vb_ = vbase + (size_t)tv2_ * 128; asm volatile("" : "+s"(kb_), "+s"(vb_));     \
        __builtin_amdgcn_global_load_lds((const GAS unsigned*)(kb_ + ofs.x), (LAS unsigned*)(F.lds + ((tk_) & 3) * AK_SLOT + (2 * w) * 1024), 16, 0, 0); \
        __builtin_amdgcn_global_load_lds((const GAS unsigned*)(kb_ + ofs.y), (LAS unsigned*)(F.lds + ((tk_) & 3) * AK_SLOT + (2 * w + 1) * 1024), 16, 0, 0); \
        __builtin_amdgcn_global_load_lds((const GAS unsigned*)(vb_ + ofs.z), (LAS unsigned*)(F.lds + AV_BASE + ((tv_) & 3) * AV_SLOT + (2 * w) * 1024), 16, 0, 0); \
        __builtin_amdgcn_global_load_lds((const GAS unsigned*)(vb_ + ofs.w), (LAS unsigned*)(F.lds + AV_BASE + ((tv_) & 3) * AV_SLOT + (2 * w + 1) * 1024), 16, 0, 0); } while (0)
#define AT_LOAD_OFS() (ofs = *(const LAS u32x4*)(F.lds + AT_OFS + F.tid * 16))
#define AT_ISSUE_K(t_) do { const int tt_ = (t_) < 64 ? (t_) : 63; const u32x2 ofs_ = *(const LAS u32x2*)(F.lds + AT_OFS + F.tid * 16); \
        __builtin_amdgcn_global_load_lds((const GAS unsigned*)(kbase + (size_t)tt_ * 131072 + ofs_.x), (LAS unsigned*)(F.lds + ((t_) & 3) * AK_SLOT + (2 * w) * 1024), 16, 0, 0); \
        __builtin_amdgcn_global_load_lds((const GAS unsigned*)(kbase + (size_t)tt_ * 131072 + ofs_.y), (LAS unsigned*)(F.lds + ((t_) & 3) * AK_SLOT + (2 * w + 1) * 1024), 16, 0, 0); } while (0)
#define AT_ISSUE_V(t_) do { const int tt_ = (t_) < 64 ? (t_) : 63; const u32x2 ofs_ = *(const LAS u32x2*)(F.lds + AT_OFS + F.tid * 16 + 8); \
        __builtin_amdgcn_global_load_lds((const GAS unsigned*)(vbase + (size_t)tt_ * 128 + ofs_.x), (LAS unsigned*)(F.lds + AV_BASE + ((t_) & 3) * AV_SLOT + (2 * w) * 1024), 16, 0, 0); \
        __builtin_amdgcn_global_load_lds((const GAS unsigned*)(vbase + (size_t)tt_ * 128 + ofs_.y), (LAS unsigned*)(F.lds + AV_BASE + ((t_) & 3) * AV_SLOT + (2 * w + 1) * 1024), 16, 0, 0); } while (0)
#define AT_TILE(t_, S_, N_) do { \
        if ((t_) > 0) { asm volatile("s_waitcnt vmcnt(4)\n\ts_barrier" ::: "memory"); } \
        AT_ISSUE_KV((t_) + 3, (t_) + 2); \
          \
        AT_QTR(sA, 0, sB, 0, negMv, kx0, kx1, vx0, vx1, vx2, vx3, pp, pc, ky0, ky1, S_, 1, 2, vy0, vy1, vy2, vy3, S_, 0); \
          \
        AT_QTR(sA, 1, sB, 2, sB, ky0, ky1, vy0, vy1, vy2, vy3, pc, pp, kx0, kx1, N_, 0, 0, vx0, vx1, vx2, vx3, S_, 1); \
          \
        AT_QTR(sB, 0, sA, 0, negMv, kx0, kx1, vx0, vx1, vx2, vx3, pp, pc, ky0, ky1, N_, 0, 2, vy0, vy1, vy2, vy3, S_, 2); \
          \
        AT_QTR(sB, 1, sA, 2, sA, ky0, ky1, vy0, vy1, vy2, vy3, pc, pp, kx0, kx1, N_, 1, 0, vx0, vx1, vx2, vx3, S_, 3); \
        AT_LOAD_OFS();        \
    } while (0)
    for (int r = 0; r < 4; ++r) {
        int bh, qb;
        if (F.G == 256) { bh = (F.bid & 7) + 8 * r; qb = F.bid >> 3; }
        else { const int u = F.bid + r * F.G; if (u >= 1024) break; bh = u >> 5; qb = u & 31; }
        const int b = bh >> 2, h = bh & 3;
        const size_t row0 = (size_t)b * SEQ;
        const GAS char* kbase = (const GAS char*)(qk + row0 * 1024 + 512 + h * 128);
        const GAS char* vbase = (const GAS char*)(vT + (size_t)(h * 128) * NTOK + row0);
        AT_ISSUE_K(0); AT_ISSUE_K(1); AT_ISSUE_V(0); AT_ISSUE_K(2); AT_ISSUE_V(1);
        bf16x8 qf[4];
        { const GAS bf16_t* qp = qk + (row0 + qb * 128 + qs * 32 + i) * 1024 + h * 128 + comp * 64 + 8 * hh;
#pragma unroll
          for (int kk = 0; kk < 4; ++kk) qf[kk] = *(const GAS bf16x8*)(qp + 16 * kk); }
        f32x16 o[4];
#pragma unroll
        for (int m = 0; m < 4; ++m)
#pragma unroll
            for (int e = 0; e < 16; ++e) o[m][e] = 0.f;
        float lsum = 0.f;
        asm volatile("s_waitcnt vmcnt(0)\n\ts_barrier" ::: "memory");
        f32x16 sA, sB;
        bf16x8 kx0, kx1, vx0, vx1, vx2, vx3, ky0, ky1, vy0, vy1, vy2, vy3, pp, pc;
        sA = negMv;
#pragma unroll
        for (int kk = 0; kk < 4; ++kk) sA = AT_MFMA(AT_LDK(0, 0, kk), qf[kk], sA);
        kx0 = AT_LDK(0, 1, 0); kx1 = AT_LDK(0, 1, 1);
        vx0 = AT_LDV(0, 3, 0); vx1 = AT_LDV(0, 3, 1); vx2 = AT_LDV(0, 3, 2); vx3 = AT_LDV(0, 3, 3);
        pp = __builtin_bit_cast(bf16x8, zero4()); pc = pp; sB = negMv;
        u32x4 ofs; AT_LOAD_OFS();
        for (int t = 0; t < 64; t += 4) {
            AT_TILE(t, 0, 1); AT_TILE(t + 1, 1, 2); AT_TILE(t + 2, 2, 3); AT_TILE(t + 3, 3, 0);
        }
        o[0] = AT_MFMA(vx0, pp, o[0]); o[1] = AT_MFMA(vx1, pp, o[1]); o[2] = AT_MFMA(vx2, pp, o[2]); o[3] = AT_MFMA(vx3, pp, o[3]);
        asm volatile("s_waitcnt vmcnt(0)\n\ts_barrier" ::: "memory");
        const float ltot = lsum + xor32(lsum);
        const float inv = (comp ? lam : 1.0f) * __builtin_amdgcn_rcpf(ltot);
        if (comp == 1) {
#pragma unroll
            for (int mv = 0; mv < 4; ++mv)
#pragma unroll
                for (int g = 0; g < 4; ++g) { const int dv = 32 * mv + 8 * g + 4 * hh;
                    *(LAS f32x4*)(F.lds + AT_X + (qs * 32 + i) * AT_XROW + dv * 4) = (f32x4){o[mv][4 * g] * inv, o[mv][4 * g + 1] * inv, o[mv][4 * g + 2] * inv, o[mv][4 * g + 3] * inv}; }
        }
        __syncthreads();
        if (comp == 0) {
            float ss = 0.f;
#pragma unroll
            for (int mv = 0; mv < 4; ++mv)
#pragma unroll
                for (int g = 0; g < 4; ++g) { const int dv = 32 * mv + 8 * g + 4 * hh;
                    const f32x4 x = *(const LAS f32x4*)(F.lds + AT_X + (qs * 32 + i) * AT_XROW + dv * 4);
#pragma unroll
                    for (int j = 0; j < 4; ++j) { const float v = o[mv][4 * g + j] * inv - x[j]; o[mv][4 * g + j] = v; ss += v * v; } }
            ss += xor32(ss);
            const float rn = (1.0f - lambda_init) * __builtin_amdgcn_rsqf(ss * (1.0f / DV) + RMS_EPS);
#pragma unroll
            for (int mv = 0; mv < 4; ++mv)
#pragma unroll
                for (int g = 0; g < 4; ++g) { const int dv = 32 * mv + 8 * g + 4 * hh; const f32x4 gg = *(const GAS f32x4*)(subg + dv);
                    u32x2 wv; wv.x = pk2(o[mv][4 * g] * rn * gg.x, o[mv][4 * g + 1] * rn * gg.y); wv.y = pk2(o[mv][4 * g + 2] * rn * gg.z, o[mv][4 * g + 3] * rn * gg.w);
                    *(LAS u32x2*)(F.lds + AT_Y + (qs * 32 + i) * AT_YROW + dv * 2) = wv; }
        }
        __syncthreads();
#pragma unroll
        for (int p2 = 0; p2 < 4; ++p2) { const int p = F.tid + 512 * p2, qq = p >> 4, c8 = p & 15;
            *(GAS u32x4*)(ya + (row0 + qb * 128 + qq) * 1024 + h * 128 + c8 * 8) = *(const LAS u32x4*)(F.lds + AT_Y + qq * AT_YROW + c8 * 16); }
        __syncthreads();
    }
#undef AT_ISSUE_K
#undef AT_ISSUE_KV
#undef AT_LOAD_OFS
#undef AT_ISSUE_V
#undef AT_TILE
}
template <bool F8> __device__ __forceinline__ void phase_norm_router(Frame& F, const bf16_t* x, const float* g, typename OutT<F8>::t* h2) {
    const GAS float* wr = (const GAS float*)argp(26);
    GAS int* topi = (GAS int*)(F.ws + WS_TOPI); GAS float* topw = (GAS float*)(F.ws + WS_TOPW); GAS int* counts = (GAS int*)(F.ws + WS_COUNTS);
    LAS int* hist = (LAS int*)(F.lds + 65536);
    for (int rb = F.bid; rb < 256; rb += F.G) {
        if (F.tid < 8) hist[F.tid] = 0;
        __syncthreads();
        int ln = F.lane; asm volatile("" : "+v"(ln));
        f32x4 wreg[2][8][2], gg[2][2];
#pragma unroll
        for (int j = 0; j < 2; ++j) { gg[j][0] = ((const GAS f32x4*)g)[2 * ln + 128 * j]; gg[j][1] = ((const GAS f32x4*)g)[2 * ln + 128 * j + 1];
#pragma unroll
            for (int t = 0; t < 8; ++t) { const GAS f32x4* wp = (const GAS f32x4*)(wr + (size_t)(512 * j + 8 * ln + t) * 8); wreg[j][t][0] = wp[0]; wreg[j][t][1] = wp[1]; } }
        const bool b0 = (ln & 1) != 0, b1 = (ln & 2) != 0, b2 = (ln & 4) != 0;
        const int m0 = rb * 128 + F.wave * 16;
        u32x4 nx[2];
#pragma unroll
        for (int j = 0; j < 2; ++j) nx[j] = ((const GAS u32x4*)(x + (size_t)m0 * XR_LD) + ln)[64 * j];
#pragma clang loop unroll(disable)
        for (int rr = 0; rr < 16; ++rr) {
            const int m = m0 + rr, mn = m + (rr < 15 ? 1 : 0);
            const u32x4 cw[2] = {nx[0], nx[1]};
#pragma unroll
            for (int j = 0; j < 2; ++j) nx[j] = ((const GAS u32x4*)(x + (size_t)mn * XR_LD) + ln)[64 * j];
            float v[2][8]; float s = 0.f;
#pragma unroll
            for (int j = 0; j < 2; ++j) { const u32x4 w = cw[j]; v[j][0] = bflo(w.x); v[j][1] = bfhi(w.x); v[j][2] = bflo(w.y); v[j][3] = bfhi(w.y); v[j][4] = bflo(w.z); v[j][5] = bfhi(w.z); v[j][6] = bflo(w.w); v[j][7] = bfhi(w.w);
#pragma unroll
                for (int e = 0; e < 8; ++e) s += v[j][e] * v[j][e]; }
            const float r = __builtin_amdgcn_rsqf(wave_sum(s) * (1.0f / DM) + RMS_EPS);
            float lg[8];
#pragma unroll
            for (int e = 0; e < 8; ++e) lg[e] = 0.f;
            typename OutT<F8>::t* o8 = h2 + (size_t)m * (F8 ? P8 : DM);
#pragma unroll
            for (int j = 0; j < 2; ++j) { const f32x4 ga = gg[j][0], gb = gg[j][1]; float hv[8];
                hv[0] = v[j][0] * r * ga.x; hv[1] = v[j][1] * r * ga.y; hv[2] = v[j][2] * r * ga.z; hv[3] = v[j][3] * r * ga.w; hv[4] = v[j][4] * r * gb.x; hv[5] = v[j][5] * r * gb.y; hv[6] = v[j][6] * r * gb.z; hv[7] = v[j][7] * r * gb.w;
                if constexpr (F8) ((GAS u32x2*)o8 + ln)[64 * j] = (u32x2){pk4_f8(clamp_f8(hv[0] * F8_SH), clamp_f8(hv[1] * F8_SH), clamp_f8(hv[2] * F8_SH), clamp_f8(hv[3] * F8_SH)), pk4_f8(clamp_f8(hv[4] * F8_SH), clamp_f8(hv[5] * F8_SH), clamp_f8(hv[6] * F8_SH), clamp_f8(hv[7] * F8_SH))};
                else ((GAS u32x4*)o8 + ln)[64 * j] = (u32x4){pk2(hv[0], hv[1]), pk2(hv[2], hv[3]), pk2(hv[4], hv[5]), pk2(hv[6], hv[7])};
#pragma unroll
                for (int t = 0; t < 8; ++t) { const f32x4 wa = wreg[j][t][0], wb = wreg[j][t][1]; const float hx = hv[t];
                    lg[0] += hx * wa.x; lg[1] += hx * wa.y; lg[2] += hx * wa.z; lg[3] += hx * wa.w; lg[4] += hx * wb.x; lg[5] += hx * wb.y; lg[6] += hx * wb.z; lg[7] += hx * wb.w; } }
            float q4[4], q2[2], q1;
#pragma unroll
            for (int i = 0; i < 4; ++i) { const float keep = b0 ? lg[i + 4] : lg[i], send = b0 ? lg[i] : lg[i + 4]; q4[i] = keep + xor_swz<1>(send); }
#pragma unroll
            for (int i = 0; i < 2; ++i) { const float keep = b1 ? q4[i + 2] : q4[i], send = b1 ? q4[i] : q4[i + 2]; q2[i] = keep + xor_swz<2>(send); }
            { const float keep = b2 ? q2[1] : q2[0], send = b2 ? q2[0] : q2[1]; q1 = keep + xor_swz<4>(send); }
            q1 += xor_swz<8>(q1); q1 += xor_swz<16>(q1); q1 += xor32(q1);
#pragma unroll
            for (int e = 0; e < 8; ++e) lg[e] = __builtin_bit_cast(float, __builtin_amdgcn_readlane(__builtin_bit_cast(int, q1), ((e >> 2) & 1) | (((e >> 1) & 1) << 1) | ((e & 1) << 2)));
            int i0 = 0; float v0 = lg[0];
#pragma unroll
            for (int e = 1; e < 8; ++e) if (lg[e] > v0) { v0 = lg[e]; i0 = e; }
            int i1 = -1; float v1 = -3.0e38f;
#pragma unroll
            for (int e = 0; e < 8; ++e) if (e != i0 && lg[e] > v1) { v1 = lg[e]; i1 = e; }
            if (ln == 0) { const float e1 = fast_exp(v1 - v0), w0 = __builtin_amdgcn_rcpf(1.0f + e1);
                topi[2 * m] = i0; topi[2 * m + 1] = i1; topw[2 * m] = w0; topw[2 * m + 1] = e1 * w0;
                atomicAdd((int*)&hist[i0], 1); atomicAdd((int*)&hist[i1], 1); }
        }
        __syncthreads();
        if (F.tid < 8) counts[rb * 8 + F.tid] = hist[F.tid];
        __syncthreads();
    }
    GAS int* tokof = (GAS int*)(F.ws + WS_TOKOF);
    for (int i = F.bid * NTHR + F.tid; i < PSLOTS; i += F.G * NTHR) tokof[i] = -1;
}
constexpr int MOE_TAB = 140000, MOE_TOKL = 144 * 1024;
static_assert(MOE_TOKL + 12 * 1024 <= LDS_MISC, "moe lds");
__device__ __forceinline__ void moe_tables(Frame& F) {
    const GAS int* counts = (const GAS int*)(F.ws + WS_COUNTS);
    LAS int* tab = (LAS int*)(F.lds + MOE_TAB);
    __syncthreads();
    if (F.tid < 8) tab[F.tid] = 0;
    __syncthreads();
    for (int i = F.tid; i < 2048; i += NTHR) atomicAdd((int*)&tab[i & 7], counts[i]);
    __syncthreads();
    if (F.tid == 0) { int off = 0; for (int e = 0; e < 8; ++e) { tab[8 + e] = off; const int np = (tab[e] + 255) >> 8;
_Pragma("clang loop vectorize(disable) unroll(disable)")
            for (int p = 0; p < np; ++p) tab[32 + (off >> 8) + p] = e; off += np << 8; } tab[16] = off >> 8; }
    __syncthreads();
}
__device__ __forceinline__ void phase_moe_assign(Frame& F) {
    const GAS int* counts = (const GAS int*)(F.ws + WS_COUNTS); const GAS int* topi = (const GAS int*)(F.ws + WS_TOPI);
    GAS int* slotof = (GAS int*)(F.ws + WS_SLOT); GAS int* tokof = (GAS int*)(F.ws + WS_TOKOF);
    moe_tables(F);
    LAS int* tab = (LAS int*)(F.lds + MOE_TAB);
    LAS int* sc = (LAS int*)(F.lds + 65536);
    for (int rb = F.bid; rb < 256; rb += F.G) {
        if (F.tid < 8) sc[F.tid] = tab[8 + F.tid];
        __syncthreads();
        for (int i2 = F.tid; i2 < rb * 8; i2 += NTHR) atomicAdd((int*)&sc[i2 & 7], counts[i2]);
        int e = -1, rank = 0;
        if (F.tid < 256) { e = topi[rb * 256 + F.tid];
            for (int ee = 0; ee < 8; ++ee) { const unsigned long long mk = __ballot(e == ee); if (e == ee) rank = __popcll(mk & ((1ull << F.lane) - 1ull)); if (F.lane == 0) sc[8 + F.wave * 8 + ee] = __popcll(mk); } }
        __syncthreads();
        if (F.tid < 256) { int pre = 0; for (int w2 = 0; w2 < F.wave; ++w2) pre += sc[8 + w2 * 8 + e];
            const int slot = sc[e] + pre + rank; const int tok = rb * 128 + (F.tid >> 1);
            slotof[rb * 256 + F.tid] = slot; tokof[slot] = tok; }
        __syncthreads();
    }
}
constexpr int REM_SLOT0 = 256 * 256;
__device__ __forceinline__ void phase_moe_combine(Frame& F, int bid0) {
    const GAS int* slotof = (const GAS int*)(F.ws + WS_SLOT); const GAS float* topw = (const GAS float*)(F.ws + WS_TOPW); const GAS bf16_t* yp = (const GAS bf16_t*)(F.ws + WS_XP);
    const int gw = (F.bid - bid0) * NWAVES + F.wave, NGW = (F.G - bid0) * NWAVES;
    int sa0, sa1; float wa0, wa1;
    u32x4 x0, x1, a0, a1, b0, b1; float w0 = 0.f, w1 = 0.f;
#define CMB_A(tok_) do { const int t_ = (tok_) < NTOK ? (tok_) : NTOK - 1; sa0 = slotof[2 * t_]; sa1 = slotof[2 * t_ + 1]; wa0 = topw[2 * t_]; wa1 = topw[2 * t_ + 1]; } while (0)
#define CMB_B(tok_) do { const int t_ = (tok_) < NTOK ? (tok_) : NTOK - 1; const int r0 = sa0 < REM_SLOT0 ? sa0 : 0, r1 = sa1 < REM_SLOT0 ? sa1 : 0;        \
        w0 = sa0 < REM_SLOT0 ? wa0 : 0.f; w1 = sa1 < REM_SLOT0 ? wa1 : 0.f; \
        const GAS u32x4* xp = (const GAS u32x4*)((const GAS bf16_t*)F.out + (size_t)t_ * XR_LD) + 2 * F.lane;       \
        const GAS u32x4* ap = (const GAS u32x4*)(yp + (size_t)r0 * DM) + 2 * F.lane; const GAS u32x4* bp = (const GAS u32x4*)(yp + (size_t)r1 * DM) + 2 * F.lane; \
        x0 = xp[0]; x1 = xp[1]; a0 = ap[0]; a1 = ap[1]; b0 = bp[0]; b1 = bp[1]; } while (0)
    if (gw >= NTOK) return;
    CMB_A(gw); CMB_B(gw); CMB_A(gw + NGW);
    for (int tok = gw; tok < NTOK; tok += NGW) {
        const unsigned xw[8] = {x0.x, x0.y, x0.z, x0.w, x1.x, x1.y, x1.z, x1.w}, aw[8] = {a0.x, a0.y, a0.z, a0.w, a1.x, a1.y, a1.z, a1.w}, bw[8] = {b0.x, b0.y, b0.z, b0.w, b1.x, b1.y, b1.z, b1.w};
        float o[16];
#pragma unroll
        for (int p = 0; p < 8; ++p) { o[2 * p] = bflo(xw[p]) + w0 * bflo(aw[p]) + w1 * bflo(bw[p]); o[2 * p + 1] = bfhi(xw[p]) + w0 * bfhi(aw[p]) + w1 * bfhi(bw[p]); }
        __builtin_amdgcn_sched_barrier(0);
        CMB_B(tok + NGW);
        CMB_A(tok + 2 * NGW);
        __builtin_amdgcn_sched_barrier(0);
        GAS f32x4* op = (GAS f32x4*)(F.out + (size_t)tok * DM) + 4 * F.lane;
#pragma unroll
        for (int p = 0; p < 4; ++p) op[p] = (f32x4){o[4 * p], o[4 * p + 1], o[4 * p + 2], o[4 * p + 3]};
    }
#undef CMB_A
#undef CMB_B
}
__device__ __forceinline__ void phase_moe_fixup(Frame& F, int np) {
    const GAS int* slotof = (const GAS int*)(F.ws + WS_SLOT); const GAS int* tokof = (const GAS int*)(F.ws + WS_TOKOF); const GAS float* topw = (const GAS float*)(F.ws + WS_TOPW); const GAS bf16_t* yp = (const GAS bf16_t*)(F.ws + WS_XP);
    const int gw = F.bid * NWAVES + F.wave, NGW = F.G * NWAVES;
    for (int s = REM_SLOT0 + gw; s < np * 256; s += NGW) {
        const int tok = tokof[s]; if (tok < 0) continue;
        const int sa = slotof[2 * tok], sb = slotof[2 * tok + 1]; const int k = (sa == s) ? 0 : 1; const int other = k ? sa : sb;
        if (other >= REM_SLOT0 && other < s) continue;
        const float wk = topw[2 * tok + k], wo = other >= REM_SLOT0 ? topw[2 * tok + 1 - k] : 0.f; const int ro = other >= REM_SLOT0 ? other : s;
        const GAS u32x4* ap = (const GAS u32x4*)(yp + (size_t)s * DM) + 2 * F.lane; const GAS u32x4* bp = (const GAS u32x4*)(yp + (size_t)ro * DM) + 2 * F.lane;
        const u32x4 a0 = ap[0], a1 = ap[1], b0 = bp[0], b1 = bp[1];
        const unsigned aw[8] = {a0.x, a0.y, a0.z, a0.w, a1.x, a1.y, a1.z, a1.w}, bw[8] = {b0.x, b0.y, b0.z, b0.w, b1.x, b1.y, b1.z, b1.w};
        GAS f32x4* op = (GAS f32x4*)(F.out + (size_t)tok * DM) + 4 * F.lane;
#pragma unroll
        for (int p = 0; p < 4; ++p) { f32x4 o = op[p];
            o.x += wk * bflo(aw[2 * p]) + wo * bflo(bw[2 * p]); o.y += wk * bfhi(aw[2 * p]) + wo * bfhi(bw[2 * p]); o.z += wk * bflo(aw[2 * p + 1]) + wo * bflo(bw[2 * p + 1]); o.w += wk * bfhi(aw[2 * p + 1]) + wo * bfhi(bw[2 * p + 1]);
            op[p] = o; }
    }
}
constexpr int NPL = 16, NPHASE = 2 * NPL;
constexpr bool F8M = FP8_MOE != 0;
constexpr int MOE_DMK = F8M ? DM / 2 : DM, MOE_FFK = F8M ? FFP / 2 : FFP, MOE_EB = F8M ? 1 : 2;
constexpr int INP = I8_INPROJ ? 2 : 0;
constexpr int DUP = I8_DENSE_UP ? 2 : (FP8_DENSE ? 1 : 0);
constexpr bool DDN8 = FP8_DENSE != 0;
constexpr int INP_DMK = INP ? DM / 2 : DM, DUP_DMK = DUP ? DM / 2 : DM, DDN_FFK = DDN8 ? FFP / 2 : FFP;
static_assert(!(I8_INPROJ || I8_DENSE_UP) || FP8_MOE, "the int8 weights live where the bf16 MoE activations would end");
typedef OutT<F8M>::t moe_t; typedef OutT<(DUP == 1)>::t dgu_t; typedef OutT<DDN8>::t ddn_t;
struct Args { const float* in[30]; float* out; uchar* ws; int ph_lo, ph_hi, li, use_bar; };

__global__ void __launch_bounds__(NTHR, 2) mk_fwd(Args args) {
    extern __shared__ __attribute__((aligned(16))) uchar lds_raw[];
    Frame F;
    F.lds = (LAS uchar*)lds_raw;
    F.tid = threadIdx.x; F.lane = F.tid & 63; F.wave = __builtin_amdgcn_readfirstlane(F.tid >> 6);
    const int wave_s = F.wave;
    F.G = gridDim.x; F.bid = blockIdx.x;
    F.ws = args.ws; F.ctl = (unsigned*)(args.ws + WS_CTL); F.out = args.out;
    volatile LAS unsigned* misc = (volatile LAS unsigned*)(F.lds + LDS_MISC);
    if (F.tid < 64) misc[F.tid] = 0u;
    __syncthreads();
    XcdBarrier bar; bar.bar = F.ctl + CW_BAR + args.li * XCD_BAR_WORDS; bar.x = 0; bar.st = misc + 8;
    if (args.use_bar) bar = xcd_barrier_post(F.ctl + CW_BAR + args.li * XCD_BAR_WORDS, misc + 8);
    const int lo = args.ph_lo, hi = args.ph_hi;
    bool started = false;
#define PH_BEGIN(id) if (lo <= (id) && (id) < hi) { if (started) xcd_barrier(bar); started = true; \
    { int ws_ = wave_s; asm volatile("" : "+s"(ws_)); int ln_; asm volatile("v_mbcnt_lo_u32_b32 %0, -1, 0\n\tv_mbcnt_hi_u32_b32 %0, -1, %0" : "=v"(ln_));     F.lane = ln_; F.wave = ws_; F.tid = ws_ * 64 + ln_; \
      int b_ = blockIdx.x, g_ = gridDim.x; uchar* w_ = args.ws; float* o_ = args.out; asm volatile("" : "+s"(b_), "+s"(g_), "+s"(w_), "+s"(o_)); ASSUME_GLOBAL(w_); ASSUME_GLOBAL(o_); F.bid = b_; F.G = g_; F.ws = w_; F.out = o_; F.ctl = (unsigned*)w_; }
#define PH_END }
#define RELOAD_ID() do { int ws_ = wave_s; asm volatile("" : "+s"(ws_)); int ln_; asm volatile("v_mbcnt_lo_u32_b32 %0, -1, 0\n\tv_mbcnt_hi_u32_b32 %0, -1, %0" : "=v"(ln_));     F.lane = ln_; F.wave = ws_; F.tid = ws_ * 64 + ln_; } while (0)
#ifndef REP_ID
#define REP_ID -1
#endif
#ifndef REP_N
#define REP_N 1
#endif
#define REPEAT(id) RELOAD_ID(); for (int rep_ = 0; rep_ < ((id) == REP_ID ? REP_N : 1); ++rep_)
#define SITE(id, ...) { RELOAD_ID(); __VA_ARGS__ } if (REP_ID >= 0 && REP_ID == (id)) { { __VA_ARGS__ } { __VA_ARGS__ } }
#if DBG_CHECKS
#define CHK(x) x
#else
#define CHK(x)
#endif

    for (int layer = 0; layer < 2; ++layer) {
        const int pb = layer * NPL;
#define WSM (F.ws + WS_WSMALL + (size_t)layer * WSMALL_STRIDE)
#define WtokT ((bf16_t*)(WSM + OFF_WTOK))
#define WchT ((bf16_t*)(WSM + OFF_WCH))
#define PhT ((bf16_t*)(WSM + OFF_PH))
#define PaT ((bf16_t*)(WSM + OFF_PA))
#define WoutT ((bf16_t*)(WSM + OFF_WOUT))
#define hbuf ((bf16_t*)(F.ws + WS_H))
#define XR ((bf16_t*)F.out)
        const bool moe = (layer & 1) != 0;

        PH_BEGIN(pb + 0)
            CHK(if (layer == 1) chk_dense_down(F, 12); xcd_barrier(bar);)
            if (layer == 0) {
                for (int l2 = 0; l2 < 2; ++l2) { uchar* w2 = F.ws + WS_WSMALL + (size_t)l2 * WSMALL_STRIDE;
                    conv_win(F, argp(2) + (size_t)l2 * DM * INW, (bf16_t*)(w2 + OFF_WTOK), (bf16_t*)(w2 + OFF_WCH));
                    conv_plain(F, argp(19) + (size_t)l2 * HW * DM, HW, DM, (bf16_t*)(w2 + OFF_PH), DM);
                    conv_plain(F, argp(20) + (size_t)l2 * HW * DM, HW, DM, (bf16_t*)(w2 + OFF_PH) + HW, DM);
                    conv_plain(F, argp(21) + (size_t)l2 * DM * DM, DM, DM, (bf16_t*)(w2 + OFF_WOUT), DM); }
                conv_ffn<(DUP == 1), DDN8>(F, argp(23), argp(24), argp(25), (dgu_t*)(F.ws + WS_WGU), (ddn_t*)(F.ws + WS_WD), 1);
                rope_tables(F);
            }
            if (layer == 0) phase_norm<INP>(F, argp(0), argp(1) + layer * DM, (OutT<(INP != 0)>::t*)(F.ws + WS_H), (float*)(F.ws + WS_SH));
            else phase_norm_bf<INP>(F, XR, argp(1) + layer * DM, (OutT<(INP != 0)>::t*)(F.ws + WS_H), (float*)(F.ws + WS_SH));
            phase_hdn(F, layer);
        PH_END
        if (layer == 0 && (INP == 2 || DUP == 2)) {
            PH_BEGIN(pb + 1)
                if (INP == 2) for (int l2 = 0; l2 < 2; ++l2) { uchar* w2 = F.ws + WS_WSMALL + (size_t)l2 * WSMALL_STRIDE;
                    quant_rows(F, (const bf16_t*)(w2 + OFF_WTOK), F.ws + WS_I8W + l2 * I8W_LAYER, (float*)(F.ws + WS_SW) + l2 * SW_LAYER, 3072);
                    quant_rows(F, (const bf16_t*)(w2 + OFF_WCH), F.ws + WS_I8W + l2 * I8W_LAYER + I8W_CH, (float*)(F.ws + WS_SW) + l2 * SW_LAYER + 3072, 2048); }
                if (DUP == 2) quant_rows(F, (const bf16_t*)(F.ws + WS_WGU), F.ws + WS_I8W + I8W_DENSE, (float*)(F.ws + WS_SW) + SW_DENSE, 5632);
            PH_END
        }
        PH_BEGIN(pb + 2)
            CHK(if (layer == 0) chk_norm(F, argp(0), argp(1) + layer * DM, hbuf, layer * 13 + 1); xcd_barrier(bar);)
            SITE(pb + 1, const bf16_t* wtk = INP == 2 ? (const bf16_t*)(F.ws + WS_I8W + layer * I8W_LAYER) : WtokT; const float* sw = (const float*)(F.ws + WS_SW) + layer * SW_LAYER;
              pg8::Gemm g{hbuf, wtk, NTOK, 3072, INP_DMK, INP == 2 ? P8 : 0, INP == 2 ? P8 : 0}; pg8::StaticOrderT<TOK_WGM> S; S.init(NTOK, 3072, F.G, F.bid);
              pg8::EpiTok<INP> E{(bf16_t*)(F.ws + WS_QK), (uchar*)(F.ws + WS_GATES), argp(12) + layer * HD, argp(13) + layer * HD, (const bf16_t*)(F.ws + WS_ROPE), (const bf16_t*)(F.ws + WS_ROPE) + SEQ * 32, (const float*)(F.ws + WS_SH), sw};
              pg8::gemm_phase(F.lds, g, S, E, F.tid);)
            SITE(300 + pb + 1, const bf16_t* wch = INP == 2 ? (const bf16_t*)(F.ws + WS_I8W + layer * I8W_LAYER + I8W_CH) : WchT; const float* sw = (const float*)(F.ws + WS_SW) + layer * SW_LAYER + 3072;
              pg8::Gemm g{wch, hbuf, 2048, NTOK, INP_DMK, INP == 2 ? P8 : 0, INP == 2 ? P8 : 0}; pg8::StaticOrderT<CH_WGM> S; S.init(2048, NTOK, F.G, F.bid);
              pg8::EpiBf16<INP> E{(bf16_t*)(F.ws + WS_CHT), NTOK, 0, 1.0f, sw, (const float*)(F.ws + WS_SH)};
              pg8::gemm_phase(F.lds, g, S, E, F.tid);)
            REPEAT(pb + 2) phase_fimg(F, layer);
        PH_END
        PH_BEGIN(pb + 3)
            CHK(chk_inproj(F, layer, layer * 13 + 2); chk_qkprep(F, layer, layer * 13 + 3); chk_fimg(F, layer, layer * 13 + 5); xcd_barrier(bar);)
            REPEAT(100 + pb + 3) phase_hyena(F, layer);
            REPEAT(200 + pb + 3) phase_attn(F, layer);
        PH_END
        PH_BEGIN(pb + 4)
            CHK(chk_hyena(F, layer, layer * 13 + 6); chk_attn(F, layer, layer * 13 + 7); xcd_barrier(bar);)
            REPEAT(pb + 4) phase_transpose_y(F);
        PH_END
        PH_BEGIN(pb + 5)
            CHK(chk_transpose(F, layer * 13 + 8); xcd_barrier(bar);)
            SITE(pb + 5, pg8::Gemm g{(const bf16_t*)(F.ws + WS_YCAT), PhT, NTOK, DM, DM}; pg8::StaticOrder S; S.init(NTOK, DM, F.G, F.bid);
              pg8::EpiMergeF E{(bf16_t*)(F.ws + WS_MERGED), (const uchar*)(F.ws + WS_GATES)};
              pg8::gemm_phase(F.lds, g, S, E, F.tid);)
        PH_END
        PH_BEGIN(pb + 6)
            CHK(chk_merge(F, layer, layer * 13 + 9); xcd_barrier(bar);)
            SITE(pb + 6, pg8::Gemm g{(const bf16_t*)(F.ws + WS_MERGED), WoutT, NTOK, DM, DM}; pg8::StaticOrder S; S.init(NTOK, DM, F.G, F.bid);
              if (layer == 0) { pg8::EpiRes<true> E{argp(0), XR, 1.0f}; pg8::gemm_phase(F.lds, g, S, E, F.tid); }
              else { pg8::EpiRes<false> E{nullptr, XR, 1.0f}; pg8::gemm_phase(F.lds, g, S, E, F.tid); })
        PH_END
        PH_BEGIN(pb + 7)
            CHK(if (layer == 0) chk_outproj(F, layer, 10); xcd_barrier(bar);)
            if (!moe) phase_norm_bf<DUP>(F, XR, argp(22) + layer * DM, (OutT<(DUP != 0)>::t*)(F.ws + WS_H), (float*)(F.ws + WS_SH));
            else {
                phase_norm_router<F8M>(F, XR, argp(22) + layer * DM, (moe_t*)(F.ws + WS_H2_MOE));
                REPEAT(pb + 7) conv_ffn<F8M>(F, argp(27), argp(28), argp(29), (moe_t*)(F.ws + WS_MOE_WGU), (moe_t*)(F.ws + WS_MOE_WD), NEXP);
            }
        PH_END
        if (!moe) {
            PH_BEGIN(pb + 9)
                SITE(pb + 9, pg8::Gemm g{hbuf, (const bf16_t*)(F.ws + (DUP == 2 ? WS_I8W + I8W_DENSE : WS_WGU)), NTOK, 5632, DUP_DMK, DUP == 2 ? P8 : 0, DUP == 2 ? P8 : 0}; pg8::StaticOrderT<UP_WGM> S; S.init(NTOK, 5632, F.G, F.bid);
                  pg8::EpiSwiglu<DUP, DDN8> E{(bf16_t*)(F.ws + WS_ACT_DENSE), 0, (const float*)(F.ws + WS_SH), (const float*)(F.ws + WS_SW) + SW_DENSE};
                  pg8::gemm_phase(F.lds, g, S, E, F.tid);)
            PH_END
            PH_BEGIN(pb + 10)
                CHK(chk_dense_up(F, 11); xcd_barrier(bar);)
                { pg8::Gemm g{(const bf16_t*)(F.ws + WS_ACT_DENSE), (const bf16_t*)(F.ws + WS_WD), NTOK, DM, DDN_FFK}; pg8::StaticOrder S; S.init(NTOK, DM, F.G, F.bid);
                  pg8::EpiRes<false, DDN8> E{nullptr, XR, F8_DN_INV};
                  pg8::gemm_phase(F.lds, g, S, E, F.tid); }
            PH_END
        } else {
            PH_BEGIN(pb + 8)
                CHK(chk_router(F, 13 + 11); xcd_barrier(bar);)
                phase_moe_assign(F);
            PH_END
            for (int chunk = 0; chunk < 2; ++chunk) {
                PH_BEGIN(pb + 9 + 2 * chunk)
                    CHK(if (chunk == 0) chk_assign(F, 13 + 12); xcd_barrier(bar);)
                    SITE(pb + 9 + 2 * chunk, const LAS int* tab = (const LAS int*)(F.lds + MOE_TAB); const int p0 = chunk * 128;
                      pg8::Gemm g{(const bf16_t*)(F.ws + WS_H2_MOE), (const bf16_t*)(F.ws + WS_MOE_WGU), 128 * 256, 5632, MOE_DMK, F8M ? P8 : 0, F8M ? P8 : 0};
                      pg8::MoeGatherOrder S; S.init(128 * 256, 5632, F.G, F.bid); S.p0 = p0; S.pexp = tab + 32; S.estride = F8M ? (long)5632 * P8 : (long)5632 * DM * 2; S.tokof = (const int*)(F.ws + WS_TOKOF); S.fill_tokl((LAS int*)(F.lds + MOE_TOKL), F.tid);
                      pg8::EpiSwiglu<(F8M ? 1 : 0), F8M> E{(bf16_t*)(F.ws + WS_ACT_MOE), p0, nullptr, nullptr};
                      pg8::gemm_phase(F.lds, g, S, E, F.tid);)
                    if (chunk == 1) {
                      SITE(pb + 14, const LAS int* tab = (const LAS int*)(F.lds + MOE_TAB); const int np = tab[16], nm = np - 256;
                        pg8::Gemm g{(const bf16_t*)(F.ws + WS_H2_MOE), (const bf16_t*)(F.ws + WS_MOE_WGU), nm * 256, 5632, MOE_DMK, F8M ? P8 : 0, F8M ? P8 : 0};
                        pg8::MoeGatherOrder S; S.init(nm * 256, 5632, F.G, F.bid); S.p0 = 256; S.pexp = tab + 32; S.estride = F8M ? (long)5632 * P8 : (long)5632 * DM * 2; S.tokof = (const int*)(F.ws + WS_TOKOF); S.fill_tokl((LAS int*)(F.lds + MOE_TOKL), F.tid);
                        pg8::EpiSwiglu<(F8M ? 1 : 0), F8M> E{(bf16_t*)(F.ws + WS_ACT_MOE), 128, nullptr, nullptr};
                        pg8::gemm_phase(F.lds, g, S, E, F.tid);)
                    }
                PH_END
                PH_BEGIN(pb + 10 + 2 * chunk)
                    SITE(pb + 10 + 2 * chunk, const LAS int* tab = (const LAS int*)(F.lds + MOE_TAB); const int p0 = chunk * 128;
                      pg8::Gemm g{(const bf16_t*)(F.ws + WS_ACT_MOE) - (size_t)p0 * 256 * MOE_FFK, (const bf16_t*)(F.ws + WS_MOE_WD), 128 * 256, DM, MOE_FFK};
                      pg8::MoeOrder S; S.init(128 * 256, DM, F.G, F.bid); S.p0 = p0; S.pexp = tab + 32; S.estride = (long)DM * FFP * MOE_EB;
                      pg8::EpiBf16<(F8M ? 1 : 0)> E{(bf16_t*)(F.ws + WS_XP), DM, 0, F8_DN_INV, nullptr, nullptr};
                      pg8::gemm_phase(F.lds, g, S, E, F.tid);)
                PH_END
            }
            PH_BEGIN(pb + 13)
                CHK(chk_moe_ffn(F, 13 + 13); xcd_barrier(bar);)
                if (F.G >= 64 && F.bid < 32) {
                    SITE(pb + 13, const LAS int* tab = (const LAS int*)(F.lds + MOE_TAB); const int np = tab[16], nm = np - 256;
                      pg8::Gemm g{(const bf16_t*)(F.ws + WS_ACT_MOE) - (size_t)128 * 256 * MOE_FFK, (const bf16_t*)(F.ws + WS_MOE_WD), nm * 256, DM, MOE_FFK};
                      pg8::MoeOrder S; S.init(nm * 256, DM, 32, F.bid); S.p0 = 256; S.pexp = tab + 32; S.estride = (long)DM * FFP * MOE_EB;
                      pg8::EpiBf16<(F8M ? 1 : 0)> E{(bf16_t*)(F.ws + WS_XP), DM, 0, F8_DN_INV, nullptr, nullptr};
                      pg8::gemm_phase(F.lds, g, S, E, F.tid);)
                } else if (F.G >= 64) phase_moe_combine(F, 32);
                else {
                    { const LAS int* tab = (const LAS int*)(F.lds + MOE_TAB); const int np = tab[16], nm = np - 256;
                      pg8::Gemm g{(const bf16_t*)(F.ws + WS_ACT_MOE) - (size_t)128 * 256 * MOE_FFK, (const bf16_t*)(F.ws + WS_MOE_WD), nm * 256, DM, MOE_FFK};
                      pg8::MoeOrder S; S.init(nm * 256, DM, F.G, F.bid); S.p0 = 256; S.pexp = tab + 32; S.estride = (long)DM * FFP * MOE_EB;
                      pg8::EpiBf16<(F8M ? 1 : 0)> E{(bf16_t*)(F.ws + WS_XP), DM, 0, F8_DN_INV, nullptr, nullptr};
                      pg8::gemm_phase(F.lds, g, S, E, F.tid); }
                    phase_moe_combine(F, 0);
                }
            PH_END
            PH_BEGIN(pb + 15)
                { const LAS int* tab = (const LAS int*)(F.lds + MOE_TAB); phase_moe_fixup(F, tab[16]); }
            PH_END
        }
    }
#if DBG_CHECKS
    if (hi == NPHASE) { if (started) xcd_barrier(bar); dbg_report(F); }
#endif
#undef PH_BEGIN
#undef PH_END
#undef WSM
#undef WtokT
#undef WchT
#undef PhT
#undef PaT
#undef WoutT
#undef hbuf
#undef XR
}

#ifndef MK_SPLIT
#define MK_SPLIT 0
#endif
extern "C" void kernel_launch(void* const* d_in, const int* in_sizes, int n_in, void* d_out, int out_size, void* d_ws, size_t ws_size, hipStream_t stream) {
    static int grid = 0;
    if (grid == 0) {
        if (n_in != 30 || out_size != NTOK * DM || ws_size < WS_NEED) { fprintf(stderr, "kernel_launch: unexpected sizes n_in %d out %d ws %zu\n", n_in, out_size, ws_size); grid = -1; return; }
        int dev = 0, cus = 0, per_cu = 0;
        if (hipGetDevice(&dev) != hipSuccess || hipDeviceGetAttribute(&cus, hipDeviceAttributeMultiprocessorCount, dev) != hipSuccess) { grid = -1; return; }
        if (hipFuncSetAttribute((const void*)mk_fwd, hipFuncAttributeMaxDynamicSharedMemorySize, LDS_BYTES) != hipSuccess) { fprintf(stderr, "kernel_launch: hipFuncSetAttribute failed\n"); grid = -1; return; }
        if (hipOccupancyMaxActiveBlocksPerMultiprocessor(&per_cu, (const void*)mk_fwd, NTHR, LDS_BYTES) != hipSuccess || per_cu < 1) { fprintf(stderr, "kernel_launch: occupancy query says %d\n", per_cu); }
        (void)hipGetLastError();
        grid = cus;
    }
    if (grid < 0) return;
    (void)hipMemsetAsync((char*)d_ws + WS_CTL, 0, CTL_ZERO_BYTES, stream);
    Args a{};
    for (int i = 0; i < 30; ++i) a.in[i] = (const float*)d_in[i];
    a.out = (float*)d_out; a.ws = (uchar*)d_ws;
#if MK_SPLIT
    int li = 0;
    for (int p = 0; p < NPHASE; ++p) { a.ph_lo = p; a.ph_hi = p + 1; a.li = 0; a.use_bar = 0; (void)li;
        hipLaunchKernelGGL(mk_fwd, dim3(grid), dim3(NTHR), LDS_BYTES, stream, a); }
#else
    a.ph_lo = 0; a.ph_hi = NPHASE; a.li = 0; a.use_bar = 1;
    hipLaunchKernelGGL(mk_fwd, dim3(grid), dim3(NTHR), LDS_BYTES, stream, a);
#endif
}
```
